# Optimizing an MI355X kernel written in HIP

```python
import math
import jax, jax.numpy as jnp
from jax import lax
import numpy as np

D_MODEL = 1024
BATCH = 8
SEQ = 4096
DEPTH = 1

RET_HEADS = 4
RET_DK = 128
RET_DV = 256
RET_CHUNK = 128
DIFF_HEADS = 4
DIFF_DK = 128
DIFF_DV = 256
Q_BLOCK = 128
ROPE_THETA = 10000.0
N_GROUPS = 4
EXPERTS_PER_GROUP = 8
N_EXPERTS = 32
TOP_K = 2
D_EXPERT = 512
MOE_BLOCK = 128
EPS = 1e-6

RET_QK = 512
RET_V = 1024
DIFF_QK = 1024
DIFF_V = 1024
IN_OFFSETS = (512, 1024, 2048, 3072, 4096, 5120, 6144, 7168)
D_IN = 8192

kernel_name = "hybrid_retention_diffattn_hmoe_block"


def rmsnorm(x, g):
    xf = x.astype(jnp.float32)
    y = xf * lax.rsqrt(jnp.mean(xf * xf, axis=-1, keepdims=True) + EPS)
    return (y * g.astype(jnp.float32)).astype(x.dtype)


def head_rms(o):
    of = o.astype(jnp.float32)
    return of * lax.rsqrt(jnp.mean(of * of, axis=-1, keepdims=True) + EPS)


def apply_rope(t, positions):
    d = t.shape[-1]
    inv = ROPE_THETA ** (-jnp.arange(0, d, 2, dtype=jnp.float32) / d)
    ang = positions.astype(jnp.float32)[:, :, None] * inv
    cos = jnp.cos(ang)[:, :, None, :]
    sin = jnp.sin(ang)[:, :, None, :]
    tf = t.astype(jnp.float32)
    t1, t2 = tf[..., : d // 2], tf[..., d // 2:]
    return jnp.concatenate([t1 * cos - t2 * sin, t2 * cos + t1 * sin], axis=-1).astype(t.dtype)


def retention(q, k, v):
    B, S, H, dk = q.shape
    dv = v.shape[-1]
    C = RET_CHUNK
    N = S // C
    gamma = 1.0 - jnp.exp2(-5.0 - jnp.arange(H, dtype=jnp.float32))
    log_g = jnp.log(gamma)
    idx = jnp.arange(C, dtype=jnp.float32)
    rel = idx[:, None] - idx[None, :]
    dmask = jnp.where(rel >= 0, jnp.exp(log_g[:, None, None] * jnp.maximum(rel, 0.0)), 0.0)
    zeta = jnp.exp(log_g[:, None] * (C - 1 - idx)).T
    xi = jnp.exp(log_g[:, None] * (idx + 1)).T
    chunk_decay = jnp.exp(log_g * C)
    qc = q.astype(jnp.float32).reshape(B, N, C, H, dk)
    kc = k.astype(jnp.float32).reshape(B, N, C, H, dk) * (dk ** -0.5)
    vc = v.astype(jnp.float32).reshape(B, N, C, H, dv)
    s = jnp.einsum('bnihd,bnjhd->bnhij', qc, kc) * dmask
    o_in = jnp.einsum('bnhij,bnjhe->bnihe', s, vc)
    kv = jnp.einsum('bnjhd,bnjhe->bnhde', kc * zeta[None, None, :, :, None], vc)

    def step(state, kv_n):
        return chunk_decay[None, :, None, None] * state + kv_n, state

    _, state_prev = lax.scan(step, jnp.zeros((B, H, dk, dv), jnp.float32), jnp.swapaxes(kv, 0, 1))
    o_cross = jnp.einsum('bnihd,nbhde->bnihe', qc * xi[None, None, :, :, None], state_prev)
    return (o_in + o_cross).reshape(B, S, H, dv)


def diff_attention(q, k, v, lam):
    B, S, H, _, dk = q.shape
    dv = v.shape[-1]
    nq = S // Q_BLOCK
    qb = jnp.moveaxis(q.reshape(B, nq, Q_BLOCK, H, 2, dk), 1, 0)
    kpos = jnp.arange(S)
    scale = dk ** -0.5
    neg = jnp.finfo(jnp.float32).min

    def block(args):
        i, qi = args
        s = jnp.einsum('bqhcd,bkhcd->bhcqk', qi, k).astype(jnp.float32) * scale
        qpos = i * Q_BLOCK + jnp.arange(Q_BLOCK)
        s = jnp.where(kpos[None, :] <= qpos[:, None], s, neg)
        p = jax.nn.softmax(s, axis=-1)
        a = p[:, :, 0] - lam * p[:, :, 1]
        return jnp.einsum('bhqk,bkhe->bqhe', a.astype(v.dtype), v)

    o = lax.map(block, (jnp.arange(nq), qb))
    return jnp.moveaxis(o, 0, 1).reshape(B, S, H, dv)


def hierarchical_moe(h, w_rg, b_rg, w_re, b_re, w1, w3, w2):
    T, D = h.shape
    gp = jax.nn.softmax(jnp.dot(h, w_rg).astype(jnp.float32) + b_rg, axis=-1)
    g_top, g_idx = lax.top_k(gp, 1)
    el_all = (jnp.dot(h, w_re).astype(jnp.float32) + b_re).reshape(T, N_GROUPS, EXPERTS_PER_GROUP)
    el = jnp.take_along_axis(el_all, g_idx[:, :, None], axis=1)[:, 0]
    e_val, e_idx = lax.top_k(el, TOP_K)
    weights = (g_top * jax.nn.softmax(e_val, axis=-1)).astype(h.dtype)
    expert = g_idx * EXPERTS_PER_GROUP + e_idx

    flat_e = expert.reshape(-1)
    A = flat_e.shape[0]
    order = jnp.argsort(flat_e)
    sorted_e = flat_e[order]
    counts = jnp.bincount(flat_e, length=N_EXPERTS)
    starts = jnp.cumsum(counts) - counts
    padded = ((counts + MOE_BLOCK - 1) // MOE_BLOCK) * MOE_BLOCK
    pad_ends = jnp.cumsum(padded)
    pad_starts = pad_ends - padded
    dest = pad_starts[sorted_e] + (jnp.arange(A) - starts[sorted_e])
    n_blocks = -(-A // MOE_BLOCK) + N_EXPERTS
    P = n_blocks * MOE_BLOCK
    row_token = jnp.full((P,), T, jnp.int32).at[dest].set((order // TOP_K).astype(jnp.int32))
    block_e = jnp.minimum(jnp.searchsorted(pad_ends, jnp.arange(n_blocks) * MOE_BLOCK, side='right'),
                          N_EXPERTS - 1)
    h_pad = jnp.concatenate([h, jnp.zeros((1, D), h.dtype)], axis=0)[row_token]
    h_pad = h_pad.reshape(n_blocks, MOE_BLOCK, D)

    def expert_block(args):
        xb, e = args
        return jnp.dot(jax.nn.silu(jnp.dot(xb, w1[e])) * jnp.dot(xb, w3[e]), w2[e])

    y_pad = lax.map(expert_block, (h_pad, block_e)).reshape(P, D)
    dest_of_flat = jnp.zeros((A,), jnp.int32).at[order].set(dest.astype(jnp.int32))
    y_assign = y_pad[dest_of_flat].reshape(T, TOP_K, D)
    return jnp.sum(y_assign * weights[:, :, None], axis=1)


def setup_inputs(seed: int = 0) -> dict:
    key = jax.random.key(seed)
    ks = jax.random.split(key, 24)
    f32 = jnp.float32
    D = D_MODEL

    def nrm(k, shape, scale):
        return jax.random.normal(k, shape, f32) * scale

    return {
        "x": nrm(ks[0], (BATCH, SEQ, D), 1.0),
        "c": nrm(ks[1], (BATCH, D), 1.0),
        "positions": jnp.broadcast_to(jnp.arange(SEQ, dtype=jnp.int32)[None, :], (BATCH, SEQ)),
        "w_ada": nrm(ks[2], (DEPTH, D, 6 * D), D ** -0.5),
        "b_ada": nrm(ks[3], (DEPTH, 6 * D), 0.02),
        "norm_mix": 1.0 + nrm(ks[4], (DEPTH, D), 0.02),
        "w_in": nrm(ks[5], (DEPTH, D, D_IN), D ** -0.5),
        "w_ret_o": nrm(ks[6], (DEPTH, RET_V, D), RET_V ** -0.5),
        "w_diff_o": nrm(ks[7], (DEPTH, DIFF_V, D), DIFF_V ** -0.5),
        "lam_q1": nrm(ks[8], (DEPTH, DIFF_DK), 0.1),
        "lam_k1": nrm(ks[9], (DEPTH, DIFF_DK), 0.1),
        "lam_q2": nrm(ks[10], (DEPTH, DIFF_DK), 0.1),
        "lam_k2": nrm(ks[11], (DEPTH, DIFF_DK), 0.1),
        "diff_norm": 1.0 + nrm(ks[12], (DEPTH, DIFF_DV), 0.02),
        "w_out": nrm(ks[13], (DEPTH, D, D), D ** -0.5),
        "norm_ffn": 1.0 + nrm(ks[14], (DEPTH, D), 0.02),
        "w_router_group": nrm(ks[15], (DEPTH, D, N_GROUPS), D ** -0.5),
        "b_router_group": nrm(ks[16], (DEPTH, N_GROUPS), 0.01),
        "w_router_expert": nrm(ks[17], (DEPTH, D, N_GROUPS * EXPERTS_PER_GROUP), D ** -0.5),
        "b_router_expert": nrm(ks[18], (DEPTH, N_GROUPS * EXPERTS_PER_GROUP), 0.01),
        "w_exp_gate": nrm(ks[19], (DEPTH, N_EXPERTS, D, D_EXPERT), D ** -0.5),
        "w_exp_up": nrm(ks[20], (DEPTH, N_EXPERTS, D, D_EXPERT), D ** -0.5),
        "w_exp_down": nrm(ks[21], (DEPTH, N_EXPERTS, D_EXPERT, D), D_EXPERT ** -0.5),
        "norm_final": 1.0 + nrm(ks[22], (D,), 0.02),
    }


def reference(x, c, positions, w_ada, b_ada, norm_mix, w_in, w_ret_o, w_diff_o,
              lam_q1, lam_k1, lam_q2, lam_k2, diff_norm, w_out, norm_ffn,
              w_router_group, b_router_group, w_router_expert, b_router_expert,
              w_exp_gate, w_exp_up, w_exp_down, norm_final):
    B, S, D = x.shape
    for l in range(DEPTH):
        lambda_init = 0.8 - 0.6 * math.exp(-0.3 * l)
        mod = (jnp.dot(jax.nn.silu(c), w_ada[l]) + b_ada[l])[:, None, :]
        sh1, sc1, g1, sh2, sc2, g2 = jnp.split(mod, 6, axis=-1)

        h = rmsnorm(x, norm_mix[l]) * (1.0 + sc1) + sh1
        proj = jnp.dot(h, w_in[l])
        rq, rk, rv, rg, dq, dk, dv, gate_r, gate_d = jnp.split(proj, list(IN_OFFSETS), axis=-1)

        rq = apply_rope(rq.reshape(B, S, RET_HEADS, RET_DK), positions)
        rk = apply_rope(rk.reshape(B, S, RET_HEADS, RET_DK), positions)
        ro = retention(rq, rk, rv.reshape(B, S, RET_HEADS, RET_DV))
        ro = head_rms(ro).reshape(B, S, RET_V).astype(x.dtype) * jax.nn.silu(rg)
        ret_out = jnp.dot(ro, w_ret_o[l])

        dq = apply_rope(dq.reshape(B, S, 2 * DIFF_HEADS, DIFF_DK), positions).reshape(B, S, DIFF_HEADS, 2, DIFF_DK)
        dk = apply_rope(dk.reshape(B, S, 2 * DIFF_HEADS, DIFF_DK), positions).reshape(B, S, DIFF_HEADS, 2, DIFF_DK)
        lam = (jnp.exp(jnp.sum(lam_q1[l].astype(jnp.float32) * lam_k1[l].astype(jnp.float32)))
               - jnp.exp(jnp.sum(lam_q2[l].astype(jnp.float32) * lam_k2[l].astype(jnp.float32)))
               + lambda_init)
        do = diff_attention(dq, dk, dv.reshape(B, S, DIFF_HEADS, DIFF_DV), lam)
        do = head_rms(do) * diff_norm[l].astype(jnp.float32) * (1.0 - lambda_init)
        diff_out = jnp.dot(do.reshape(B, S, DIFF_V).astype(x.dtype), w_diff_o[l])

        merged = jax.nn.sigmoid(gate_r) * ret_out + jax.nn.sigmoid(gate_d) * diff_out
        x = x + g1 * jnp.dot(merged, w_out[l])

        h2 = rmsnorm(x, norm_ffn[l]) * (1.0 + sc2) + sh2
        y = hierarchical_moe(h2.reshape(B * S, D), w_router_group[l], b_router_group[l],
                             w_router_expert[l], b_router_expert[l],
                             w_exp_gate[l], w_exp_up[l], w_exp_down[l]).reshape(B, S, D)
        x = x + g2 * y
    return rmsnorm(x, norm_final)
```

```cpp
#include <hip/hip_runtime.h>
#include <cstdio>
#include <cstdint>

#define GAS __attribute__((address_space(1)))
#define LAS __attribute__((address_space(3)))
typedef unsigned short bf16_t;
typedef short bf16x8 __attribute__((ext_vector_type(8)));
typedef short s16x4 __attribute__((ext_vector_type(4)));
typedef float f32x4 __attribute__((ext_vector_type(4)));
typedef float f32x2 __attribute__((ext_vector_type(2)));
typedef float f32x16 __attribute__((ext_vector_type(16)));
typedef unsigned u32x4 __attribute__((ext_vector_type(4)));
typedef unsigned u32x2 __attribute__((ext_vector_type(2)));

constexpr int T = 32768, D = 1024, SEQ = 4096, NB = 8, DIN = 8192, TH = 16384, NWAVES = 8, NTHR = 512;
constexpr int NEXP = 32, DEXP = 512;
constexpr float EPS = 1e-6f;
constexpr int PROW_MAX = 65536 + NEXP * 256;

constexpr size_t MiB = 1u << 20;
constexpr size_t WS_CTL = 0, CTL_ZERO_BYTES = 64 * 1024;
constexpr size_t WS_MOD = 1 * MiB;
constexpr size_t WS_COS = 2 * MiB, WS_SIN = 10 * MiB;
constexpr size_t WS_WIN = 18 * MiB;
constexpr size_t WS_WMIX = 34 * MiB;
constexpr size_t WS_WOUT = 38 * MiB;
constexpr size_t WS_WGU = 40 * MiB;
constexpr size_t WS_WDN = 104 * MiB;
constexpr size_t WS_H = 136 * MiB;
constexpr size_t WS_ACT = 168 * MiB;
constexpr size_t WS_PROJ = 232 * MiB;
constexpr size_t WS_H2 = 168 * MiB;
constexpr size_t WS_EACT = 232 * MiB;
constexpr size_t WS_Y = 304 * MiB;
constexpr size_t WS_ROUT = 488 * MiB;
constexpr size_t WS_SSQ = 494 * MiB;
constexpr size_t WS_DELTA_A = 72 * MiB, WS_DELTA_B = 120 * MiB, WS_DELTA_C = 496 * MiB;
constexpr size_t WS_END = 512 * MiB;
constexpr int CW_BAR = 0;
constexpr int CW_CNT = 4096;
constexpr int CW_Q = 4224;

constexpr int RING_BYTES = 131072;
constexpr int LDSCTL_OFF = RING_BYTES;
constexpr int LDS_BYTES = 147456;

__device__ __forceinline__ unsigned cvt_pk_bf16(float lo, float hi) { unsigned r; asm("v_cvt_pk_bf16_f32 %0, %1, %2" : "=v"(r) : "v"(lo), "v"(hi)); return r; }
__device__ __forceinline__ unsigned pk4_fp8(float a, float b, float c, float d) {
    a = __builtin_amdgcn_fmed3f(a, -448.f, 448.f); b = __builtin_amdgcn_fmed3f(b, -448.f, 448.f); c = __builtin_amdgcn_fmed3f(c, -448.f, 448.f); d = __builtin_amdgcn_fmed3f(d, -448.f, 448.f);
    int w = __builtin_amdgcn_cvt_pk_fp8_f32(a, b, 0, false); w = __builtin_amdgcn_cvt_pk_fp8_f32(c, d, w, true); return (unsigned)w;
}
__device__ __forceinline__ float bf_lo(unsigned w) { return __uint_as_float(w << 16); }
__device__ __forceinline__ float bf_hi(unsigned w) { return __uint_as_float(w & 0xffff0000u); }
__device__ __forceinline__ float xor32_sum(float v) { const unsigned u = __builtin_bit_cast(unsigned, v); const auto r = __builtin_amdgcn_permlane32_swap(u, u, false, false);
    return __builtin_bit_cast(float, (unsigned)r[0]) + __builtin_bit_cast(float, (unsigned)r[1]); }
__device__ __forceinline__ float xor32_max(float v) { const unsigned u = __builtin_bit_cast(unsigned, v); const auto r = __builtin_amdgcn_permlane32_swap(u, u, false, false);
    return fmaxf(__builtin_bit_cast(float, (unsigned)r[0]), __builtin_bit_cast(float, (unsigned)r[1])); }
template <int O> __device__ __forceinline__ float swz_xor(float v) { return __builtin_bit_cast(float, __builtin_amdgcn_ds_swizzle(__builtin_bit_cast(int, v), 0x1F | (O << 10))); }
__device__ __forceinline__ float wave_sum(float v) { v += swz_xor<1>(v); v += swz_xor<2>(v); v += swz_xor<4>(v); v += swz_xor<8>(v); v += swz_xor<16>(v); return xor32_sum(v); }
__device__ __forceinline__ size_t delta_off(int t) { return (t < 16384) ? WS_DELTA_A + (size_t)t * 2048 : (t < 24576) ? WS_DELTA_B + (size_t)(t - 16384) * 2048 : WS_DELTA_C + (size_t)(t - 24576) * 2048; }
__device__ __forceinline__ float fast_sigmoid(float v) { return __builtin_amdgcn_rcpf(1.0f + __builtin_amdgcn_exp2f(-1.4426950408889634f * v)); }
__device__ __forceinline__ int launder_i(int v) { asm volatile("" : "+v"(v)); return v; }
__device__ __forceinline__ int launder_s(int v) { asm volatile("" : "+s"(v)); return v; }
__device__ __forceinline__ int lane_now() { int l; asm volatile("v_mbcnt_lo_u32_b32 %0, -1, 0\n\tv_mbcnt_hi_u32_b32 %0, -1, %0" : "=v"(l)); return l; }
__device__ __forceinline__ int tid_now(int wave) { return wave * 64 + lane_now(); }
#define LDS_WAIT() asm volatile("s_waitcnt lgkmcnt(0)" ::: "memory")
#define VM_WAIT() asm volatile("s_waitcnt vmcnt(0)" ::: "memory")

#define XB_TMO      128
#define XB_XCNT(j)  (256  + 64 * (j))
#define XB_XSUB(j)  (1280 + 64 * (j))
#define XB_XGEN(j)  (2304 + 64 * (j))
#define XB_TOP      3328
#define XB_TOPGEN   3392
#define XCD_BAR_WORDS 3456
#define XB_SPIN_CAP (1u << 18)
__device__ __forceinline__ unsigned xb_ld(unsigned* p)              { return __hip_atomic_load(p, __ATOMIC_RELAXED, __HIP_MEMORY_SCOPE_AGENT); }
__device__ __forceinline__ unsigned xb_add(unsigned* p, unsigned v) { return __hip_atomic_fetch_add(p, v, __ATOMIC_RELAXED, __HIP_MEMORY_SCOPE_AGENT); }
__device__ __forceinline__ unsigned xb_xcc_id() { return (unsigned)__builtin_amdgcn_s_getreg((3 << 11) | 20) & 0xFu; }
#define XB_SPIN(cond, bar) do { unsigned _sp = 0; while (cond) { __builtin_amdgcn_s_sleep(1); \
    if ((++_sp & 255u) == 0u) { if (xb_ld(&(bar)[XB_TMO])) break; if (_sp > XB_SPIN_CAP) { atomicAdd(&(bar)[XB_TMO], 1u); break; } } } } while (0)
struct XcdBarrier { unsigned* bar; unsigned x; volatile LAS unsigned* st; int wave; };
__device__ __forceinline__ XcdBarrier xcd_barrier_post(unsigned* bar, volatile LAS unsigned* st) {
    XcdBarrier b; b.bar = bar; b.x = xb_xcc_id(); b.st = st; b.wave = 0;
    if (threadIdx.x == 0) (void)xb_add(&bar[XB_XCNT(b.x)], 1u);
    return b;
}
__device__ __forceinline__ void xcd_barrier_complete(unsigned* bar, unsigned x, unsigned& nloc, unsigned& nx) {
    const unsigned G = gridDim.x * gridDim.y * gridDim.z;
    unsigned sum, cnt, mine, sp = 0u;
    for (;;) {
        sum = 0u; cnt = 0u; mine = 0u;
#pragma unroll
        for (unsigned j = 0; j < 16; ++j) { const unsigned c = xb_ld(&bar[XB_XCNT(j)]); sum += c; cnt += (c > 0u) ? 1u : 0u; mine = (j == x) ? c : mine; }
        if (sum == G) break;
        __builtin_amdgcn_s_sleep(1);
        if ((++sp & 255u) == 0u) { if (xb_ld(&bar[XB_TMO])) break; if (sp > XB_SPIN_CAP) { atomicAdd(&bar[XB_TMO], 1u); break; } }
    }
    nloc = mine > 0u ? mine : 1u; nx = cnt > 0u ? cnt : 1u;
}
__device__ __forceinline__ void xcd_barrier(const XcdBarrier& b) {
    asm volatile("s_waitcnt vmcnt(0)" ::: "memory");
    __syncthreads();
    if (b.wave == 0 && lane_now() == 0) {
        unsigned* bar = b.bar;
        __builtin_amdgcn_s_waitcnt(0);
        unsigned nloc = b.st[0], nx = b.st[1];
        if (nloc == 0u) { xcd_barrier_complete(bar, b.x, nloc, nx); b.st[0] = nloc; b.st[1] = nx; }
        const unsigned old = xb_add(&bar[XB_XSUB(b.x)], 1u);
        const unsigned gen = old / nloc;
        if (old + 1u == (gen + 1u) * nloc) {
            __builtin_amdgcn_fence(__ATOMIC_RELEASE, "agent");
            asm volatile("s_waitcnt vmcnt(0)" ::: "memory");
            const unsigned og = xb_add(&bar[XB_TOP], 1u);
            const unsigned tg = og / nx;
            if (og + 1u == (tg + 1u) * nx) xb_add(&bar[XB_TOPGEN], 1u);
            else XB_SPIN(xb_ld(&bar[XB_TOPGEN]) == tg, bar);
            __builtin_amdgcn_fence(__ATOMIC_ACQUIRE, "agent");
            xb_add(&bar[XB_XGEN(b.x)], 1u);
            asm volatile("s_waitcnt vmcnt(0)" ::: "memory");
        } else {
            XB_SPIN(xb_ld(&bar[XB_XGEN(b.x)]) == gen, bar);
            __builtin_amdgcn_fence(__ATOMIC_ACQUIRE, "agent");
            asm volatile("s_waitcnt vmcnt(0)" ::: "memory");
        }
    }
    __syncthreads();
}

namespace pg8 {
constexpr int BM = 256, BK = 64, HALF = 128, HTB = HALF * BK * 2, STAGE_BYTES = 8 * HTB, NXCD = 8, WGM = 8;
__host__ __device__ __forceinline__ int lds_byte(int r, int c) { const int st = (r >> 4) * 2 + (c >> 5), rr = r & 15, cc = c & 31, ob = rr * 64 + cc * 2; return st * 1024 + (ob ^ (((ob >> 9) & 1) << 5)); }
__host__ __device__ __forceinline__ void stage_rc(int b, int& R, int& C) { const int st = b / 1024, sb = b % 1024, swz = sb ^ (((sb >> 9) & 1) << 5); R = (st >> 1) * 16 + swz / 64; C = (st & 1) * 32 + (swz % 64) / 2; }
__host__ __device__ __forceinline__ int perm32(int rho) { const int n = rho >> 4, i = rho & 15; return 8 * (i >> 2) + 4 * n + (i & 3); }

struct Unit { int pm, pn, e, rb, idx; const char* A; const char* B; };

struct StaticOrder {
    int nM, nN, nwg, G, c, K; const char* A; const char* Bt;
    __device__ __forceinline__ void init(const void* A_, const void* Bt_, int M, int N, int K_, int G_, int c_) { A = (const char*)A_; Bt = (const char*)Bt_; K = K_; nM = M / BM; nN = N / BM; nwg = nM * nN; G = G_; c = c_; }
    __device__ __forceinline__ bool next(int i, Unit& u) const {
        const int L = i * G + c; if (L >= nwg) return false;
        int wgid = L; { const int q = nwg / NXCD, r = nwg % NXCD, xcd = wgid % NXCD, off = wgid / NXCD; wgid = (xcd < r ? xcd * (q + 1) : r * (q + 1) + (xcd - r) * q) + off; }
        const int nig = WGM * nN, gid = wgid / nig, fm = gid * WGM, gsz = (nM - fm) < WGM ? (nM - fm) : WGM;
        u.pm = fm + ((wgid % nig) % gsz); u.pn = (wgid % nig) / gsz; u.e = 0; u.rb = 0; u.idx = i;
        u.A = A + (size_t)u.pm * BM * K * 2; u.B = Bt + (size_t)u.pn * BM * K * 2; return true;
    }
    __device__ __forceinline__ int tok(const Unit&, int) const { return 0; }
};
template <class Sched> struct OneUnit {
    const Sched& S; int i;
    __device__ __forceinline__ bool next(int j, Unit& u) const { return j == 0 ? S.next(i, u) : false; }
    __device__ __forceinline__ int tok(const Unit& u, int r) const { return S.tok(u, r); }
};
struct MoeOrder {
    int G, vcu, K, nunits, gather; const LAS int* rbs; const LAS unsigned short* tokl; const char* A; const char* Bt; size_t bstride;
    __device__ __forceinline__ bool next(int i, Unit& u) const {
        const int L = i * G + vcu; if (L >= nunits) return false;
        const int rbi = L >> 2; const int e = __builtin_amdgcn_readfirstlane(rbs[128 + rbi]);
        u.pm = rbi; u.pn = L & 3; u.e = e; u.rb = rbi - __builtin_amdgcn_readfirstlane(rbs[e]); u.idx = i;
        u.A = gather ? A : A + (size_t)rbi * BM * K * 2; u.B = Bt + (size_t)e * bstride + (size_t)u.pn * BM * K * 2; return true;
    }
    __device__ __forceinline__ int tok(const Unit& u, int r) const { return (int)tokl[u.idx * 256 + r]; }
};

typedef f32x4 Acc[2][2][4][2];
typedef int v8i32 __attribute__((ext_vector_type(8)));
__device__ __forceinline__ v8i32 cat8(const bf16x8& a, const bf16x8& b) { const u32x4 x = __builtin_bit_cast(u32x4, a), y = __builtin_bit_cast(u32x4, b); return (v8i32){(int)x.x, (int)x.y, (int)x.z, (int)x.w, (int)y.x, (int)y.y, (int)y.z, (int)y.w}; }

template <class Epi, class Sched, bool ALIGN_EPI, bool GATHER, bool F8 = false>
__device__ __forceinline__ void gemm_phase(LAS unsigned char* lds, const int wid, const int K, const Sched& S, const Epi& E) {
    const int lane = lane_now(), tid = wid * 64 + lane, wr = wid >> 2, wc = wid & 3, fr = lane & 15, fq = lane >> 4;
    const int nt = K / BK;
    unsigned voffA[2], voffB[2];
#pragma unroll
    for (int i = 0; i < 2; ++i) { int R, C; stage_rc(tid * 16 + i * 8192, R, C); const int Rb = (R & ~31) + perm32(R & 31);
        voffA[i] = GATHER ? (unsigned)(C * 2) : (unsigned)(R * K + C) * 2u; voffB[i] = (unsigned)(Rb * K + C) * 2u; }
    unsigned gAc[2] = {0u, 0u};
    const unsigned K2 = (unsigned)(K * 2);
    const size_t kstep = (size_t)(BK * 2);
    const size_t hstep = (size_t)HALF * K * 2;
    const unsigned ldsw = (unsigned)wid * 1024u;
    const int aoff = lds_byte(wr * 64 + fr, fq * 8), boff = lds_byte(wc * 32 + fr, fq * 8);
    const LAS unsigned char* ldsB = lds + 4 * HTB + boff; asm volatile("" : "+v"(ldsB));
#define PG8_SA(b, h) (((b) * 2 + (h)) * HTB)
#define PG8_SB(b, h) ((4 + (b) * 2 + (h)) * HTB)
#define PG8_STAGEB(bufoff, gbase) do { _Pragma("unroll") for (int _i = 0; _i < 2; ++_i) { asm volatile("" : "+v"(voffB[_i])); \
        __builtin_amdgcn_global_load_lds((const unsigned*)((const char*)(gbase) + voffB[_i]), (LAS unsigned*)(lds + (bufoff) + ldsw + _i * 8192), 16, 0, 0); } } while (0)
#define PG8_STAGEA(bufoff, gbase, h, nx) do { _Pragma("unroll") for (int _i = 0; _i < 2; ++_i) { \
        unsigned _o; if constexpr (GATHER) { unsigned _pk = gAc[h]; asm volatile("" : "+v"(_pk)); _o = __umul24((_pk >> (16 * _i)) & 0xffffu, K2) + voffA[0]; } else { asm volatile("" : "+v"(voffA[_i])); _o = voffA[_i]; } \
        const char* _p = GATHER ? (const char*)(gbase) + _o : (const char*)(gbase) + (h) * hstep + _o; \
        __builtin_amdgcn_global_load_lds((const unsigned*)_p, (LAS unsigned*)(lds + (bufoff) + ldsw + _i * 8192), 16, 0, 0); } } while (0)
#define PG8_LDA(dst, b, h) do { _Pragma("unroll") for (int m = 0; m < 4; ++m) { \
        if constexpr (F8) { const u32x4 x_ = *(const LAS u32x4*)(lds + PG8_SA(b, h) + aoff + m * 2048), y_ = *(const LAS u32x4*)(lds + PG8_SA(b, h) + aoff + m * 2048 + 1024); \
            dst##8[m] = (v8i32){(int)x_.x, (int)x_.y, (int)x_.z, (int)x_.w, (int)y_.x, (int)y_.y, (int)y_.z, (int)y_.w}; } \
        else { _Pragma("unroll") for (int k = 0; k < 2; ++k) dst[m][k] = *(const LAS bf16x8*)(lds + PG8_SA(b, h) + aoff + m * 2048 + k * 1024); } } } while (0)
#define PG8_LDB(dst, b, h) do { _Pragma("unroll") for (int n = 0; n < 2; ++n) { \
        if constexpr (F8) { const u32x4 x_ = *(const LAS u32x4*)(ldsB + (PG8_SB(b, h) - 4 * HTB) + n * 2048), y_ = *(const LAS u32x4*)(ldsB + (PG8_SB(b, h) - 4 * HTB) + n * 2048 + 1024); \
            dst##8[n] = (v8i32){(int)x_.x, (int)x_.y, (int)x_.z, (int)x_.w, (int)y_.x, (int)y_.y, (int)y_.z, (int)y_.w}; } \
        else { _Pragma("unroll") for (int k = 0; k < 2; ++k) dst[n][k] = *(const LAS bf16x8*)(ldsB + (PG8_SB(b, h) - 4 * HTB) + n * 2048 + k * 1024); } } } while (0)
#define PG8_MMA(ai, bj, At, Bt) do { __builtin_amdgcn_s_setprio(1); \
        if constexpr (F8) { _Pragma("unroll") for (int m = 0; m < 4; ++m) _Pragma("unroll") for (int n = 0; n < 2; ++n) \
            acc[ai][bj][m][n] = __builtin_amdgcn_mfma_scale_f32_16x16x128_f8f6f4(Bt##8[n], At##8[m], acc[ai][bj][m][n], 0, 0, 0, 0x7F7F7F7F, 0, 0x7F7F7F7F); } \
        else { _Pragma("unroll") for (int m = 0; m < 4; ++m) _Pragma("unroll") for (int n = 0; n < 2; ++n) _Pragma("unroll") for (int k = 0; k < 2; ++k) \
            acc[ai][bj][m][n] = __builtin_amdgcn_mfma_f32_16x16x32_bf16(Bt[n][k], At[m][k], acc[ai][bj][m][n], 0, 0, 0); } __builtin_amdgcn_s_setprio(0); } while (0)
#define PG8_WAIT_V(n) asm volatile("s_waitcnt vmcnt(" #n ")" ::: "memory")
#define PG8_WAIT_L(n) asm volatile("s_waitcnt lgkmcnt(" #n ")" ::: "memory")
#define PG8_BAR __builtin_amdgcn_s_barrier()
#define PG8_SCHED __builtin_amdgcn_sched_barrier(0)
    Unit cur, nxt; int ui = 0;
    if (!S.next(0, cur)) return;
    if constexpr (GATHER) {
        int R0, C0; stage_rc(tid * 16, R0, C0);
#pragma unroll
        for (int h = 0; h < 2; ++h) gAc[h] = (unsigned)S.tok(cur, h * HALF + R0) | ((unsigned)S.tok(cur, h * HALF + R0 + 64) << 16);
    }
    Acc acc;
#pragma unroll
    for (int a = 0; a < 2; ++a)
#pragma unroll
        for (int b = 0; b < 2; ++b)
#pragma unroll
            for (int m = 0; m < 4; ++m)
#pragma unroll
                for (int n = 0; n < 2; ++n) acc[a][b][m][n] = (f32x4){0.f, 0.f, 0.f, 0.f};
    bf16x8 At[4][2], B0[2][2], B1[2][2]; v8i32 At8[4], B08[2], B18[2];
    const char* cA = cur.A; const char* cB = cur.B;
    PG8_STAGEB(PG8_SB(0, 0), cB); PG8_STAGEB(PG8_SB(0, 1), cB + hstep); PG8_STAGEA(PG8_SA(0, 0), cA, 0, false); PG8_STAGEA(PG8_SA(0, 1), cA, 1, false);
    if (wr == 1) PG8_BAR;
    PG8_WAIT_V(2); PG8_BAR;
    PG8_STAGEB(PG8_SB(1, 0), cB + kstep); PG8_STAGEA(PG8_SA(1, 0), cA + kstep, 0, false); PG8_STAGEB(PG8_SB(1, 1), cB + hstep + kstep);
    PG8_WAIT_V(6); PG8_BAR;
    for (;;) {
        const bool has_next = S.next(ui + 1, nxt);
        const char* nA = has_next ? nxt.A : cA; const char* nB = has_next ? nxt.B : cB;
        for (int t = 0; t < nt; t += 2) {
            const bool last = (t == nt - 2);
            if constexpr (Epi::MID) { if (E.mid_at(t)) { const int l_ = lane_now(); E.mid(acc, cur, t, wr, wc, l_ & 15, l_ >> 4); } }
            const char* a1 = cA + (size_t)(t + 1) * kstep;
            const char* a2 = last ? nA : cA + (size_t)(t + 2) * kstep; const char* b2 = last ? nB : cB + (size_t)(t + 2) * kstep;
            const char* a3 = a2 + kstep; const char* b3 = b2 + kstep;
            PG8_LDB(B0, 0, 0); PG8_LDB(B1, 0, 1); PG8_SCHED; PG8_LDA(At, 0, 0); PG8_STAGEA(PG8_SA(1, 1), a1, 1, false);
            if constexpr (GATHER) { if (last && has_next) {
                int R0, C0; stage_rc((wid * 64 + lane_now()) * 16, R0, C0);
#pragma unroll
                for (int h = 0; h < 2; ++h) gAc[h] = (unsigned)S.tok(nxt, h * HALF + R0) | ((unsigned)S.tok(nxt, h * HALF + R0 + 64) << 16); } }
            PG8_WAIT_V(8); PG8_WAIT_L(0); PG8_BAR; PG8_MMA(0, 0, At, B0); PG8_MMA(0, 1, At, B1); PG8_BAR; PG8_SCHED;
            PG8_LDA(At, 0, 1); PG8_STAGEB(PG8_SB(0, 0), b2); PG8_STAGEB(PG8_SB(0, 1), b2 + hstep); PG8_STAGEA(PG8_SA(0, 0), a2, 0, last);
            PG8_WAIT_V(8); PG8_WAIT_L(0); PG8_BAR; PG8_MMA(1, 0, At, B0); PG8_MMA(1, 1, At, B1); PG8_BAR; PG8_SCHED;
            PG8_LDB(B0, 1, 0); PG8_LDB(B1, 1, 1); PG8_SCHED; PG8_LDA(At, 1, 0); PG8_STAGEA(PG8_SA(0, 1), a2, 1, last);
            PG8_WAIT_V(8); PG8_WAIT_L(0); PG8_BAR; PG8_MMA(0, 0, At, B0); PG8_MMA(0, 1, At, B1); PG8_BAR; PG8_SCHED;
            PG8_LDA(At, 1, 1); PG8_STAGEB(PG8_SB(1, 0), b3); PG8_STAGEB(PG8_SB(1, 1), b3 + hstep); PG8_STAGEA(PG8_SA(1, 0), a3, 0, last);
            PG8_WAIT_V(8); PG8_WAIT_L(0); PG8_BAR; PG8_MMA(1, 0, At, B0); PG8_MMA(1, 1, At, B1); PG8_BAR; PG8_SCHED;
        }
        if constexpr (ALIGN_EPI) { if (wr == 0) PG8_BAR; }
        { const int l_ = lane_now(); E(acc, cur, wr, wc, l_ & 15, l_ >> 4); }
        if (!has_next) break;
#pragma unroll
        for (int a = 0; a < 2; ++a)
#pragma unroll
            for (int b = 0; b < 2; ++b)
#pragma unroll
                for (int m = 0; m < 4; ++m)
#pragma unroll
                    for (int n = 0; n < 2; ++n) acc[a][b][m][n] = (f32x4){0.f, 0.f, 0.f, 0.f};
        cur = nxt; cA = nA; cB = nB; ++ui;
        if constexpr (ALIGN_EPI) { if (wr == 1) PG8_BAR; }
    }
    PG8_WAIT_V(0);
    if constexpr (!ALIGN_EPI) { if (wr == 0) PG8_BAR; }
    PG8_BAR;
#undef PG8_SA
#undef PG8_SB
#undef PG8_STAGEA
#undef PG8_STAGEB
#undef PG8_LDA
#undef PG8_LDB
#undef PG8_MMA
#undef PG8_WAIT_V
#undef PG8_WAIT_L
#undef PG8_BAR
#undef PG8_SCHED
}

__device__ __forceinline__ void store8(bf16_t* p, const f32x4& v0, const f32x4& v1) {
    u32x4 w; w.x = cvt_pk_bf16(v0[0], v0[1]); w.y = cvt_pk_bf16(v0[2], v0[3]); w.z = cvt_pk_bf16(v1[0], v1[1]); w.w = cvt_pk_bf16(v1[2], v1[3]);
    *(u32x4*)p = w;
}
struct EpiProj {
    static constexpr bool MID = false;
    bf16_t* O; const float* cosT; const float* sinT; int pmode;
    __device__ __forceinline__ bool mid_at(int) const { return false; }
    __device__ __forceinline__ void mid(Acc&, const Unit&, int, int, int, int, int) const {}
    __device__ __forceinline__ void operator()(Acc& acc, const Unit& u, int wr, int wc, int fr, int fq) const {
        if (pmode == 3) return;
        const int pn = u.pn; fr = launder_i(fr); fq = launder_i(fq);
        const int mode = (pn < 4) ? 1 : (pn < 8) ? 0 : (pn < 12) ? 2 : (pn < 20) ? 1 : (pn < 24) ? 0 : 3;
        const int row0 = u.pm * BM + wr * 64 + fr, col0 = pn * BM + wc * 32 + 8 * fq;
        if (mode == 1) {
            const int q4 = 4 * (4 * wc + fq);
            f32x4 cs[2][4], sn[2][4];
#pragma unroll
            for (int ai = 0; ai < 2; ++ai)
#pragma unroll
                for (int m = 0; m < 4; ++m) { const size_t ro = (size_t)(row0 + ai * HALF + m * 16) * 64 + q4; cs[ai][m] = *(const f32x4*)(cosT + ro); sn[ai][m] = *(const f32x4*)(sinT + ro); }
            asm volatile("" ::: "memory");
#pragma unroll
            for (int ai = 0; ai < 2; ++ai)
#pragma unroll
                for (int m = 0; m < 4; ++m) {
                    bf16_t* rowp = O + (size_t)(row0 + ai * HALF + m * 16) * DIN + col0;
                    const int ic = (wr * 64 + m * 16 + fr) & 127;
#pragma unroll
                    for (int bj = 0; bj < 2; ++bj) {
                        float f = 1.f;
                        if (pn < 4) { const int hd = (2 * pn + bj) & 3; const float lg = __builtin_amdgcn_logf(1.0f - __builtin_amdgcn_exp2f(-5.0f - (float)hd));
                            f = __builtin_amdgcn_exp2f(lg * (pn < 2 ? (float)(ic + 1) : (float)(127 - ic))); }
                        const f32x4 t1 = acc[ai][bj][m][0], t2 = acc[ai][bj][m][1];
                        const f32x4 o1 = (t1 * cs[ai][m] - t2 * sn[ai][m]) * f, o2 = (t2 * cs[ai][m] + t1 * sn[ai][m]) * f;
                        if (pmode != 1) store8(rowp + bj * HALF, o1, o2);
                    }
                }
        } else {
#pragma unroll
            for (int ai = 0; ai < 2; ++ai)
#pragma unroll
                for (int m = 0; m < 4; ++m) {
                    bf16_t* rowp = O + (size_t)(row0 + ai * HALF + m * 16) * DIN + col0;
#pragma unroll
                    for (int bj = 0; bj < 2; ++bj) {
                        f32x4 v0 = acc[ai][bj][m][0], v1 = acc[ai][bj][m][1];
                        if (mode == 2) {
#pragma unroll
                            for (int e = 0; e < 4; ++e) { v0[e] = v0[e] * fast_sigmoid(v0[e]); v1[e] = v1[e] * fast_sigmoid(v1[e]); }
                        } else if (mode == 3) {
#pragma unroll
                            for (int e = 0; e < 4; ++e) { v0[e] = fast_sigmoid(v0[e]); v1[e] = fast_sigmoid(v1[e]); }
                        }
                        if (pmode != 1) store8(rowp + bj * HALF, v0, v1);
                    }
                }
        }
        asm volatile("" ::: "memory");
    }
};
struct EpiMerged {
    static constexpr bool MID = true;
    const bf16_t* proj; bf16_t* O; const LAS float* rst;
    __device__ __forceinline__ bool mid_at(int t) const { return t == 4 || t == 8 || t == 12 || t == 16; }
    __device__ __forceinline__ void mid(Acc& acc, const Unit& u, int t, int wr, int wc, int fr, int fq) const {
        fr = launder_i(fr); fq = launder_i(fq);
        const LAS float* rq = (const LAS float*)rst + ((t >> 2) - 1) * 256 + wr * 64 + fr;
#pragma unroll
        for (int ai = 0; ai < 2; ++ai)
#pragma unroll
            for (int m = 0; m < 4; ++m) {
                const float f = rq[ai * HALF + m * 16];
#pragma unroll
                for (int bj = 0; bj < 2; ++bj) { acc[ai][bj][m][0] = acc[ai][bj][m][0] * f; acc[ai][bj][m][1] = acc[ai][bj][m][1] * f; }
            }
        if (t == 16) {
            const int row0 = u.pm * BM + wr * 64 + fr, col0 = u.pn * BM + wc * 32 + 8 * fq;
#pragma unroll
            for (int ai = 0; ai < 2; ++ai) {
                u32x4 g[4][2], d[4][2];
#pragma unroll
                for (int m = 0; m < 4; ++m) { const bf16_t* gp = proj + (size_t)(row0 + ai * HALF + m * 16) * DIN + 6144 + col0;
#pragma unroll
                    for (int bj = 0; bj < 2; ++bj) { g[m][bj] = *(const u32x4*)(gp + bj * HALF); d[m][bj] = *(const u32x4*)(gp + 1024 + bj * HALF); } }
                asm volatile("" ::: "memory");
#pragma unroll
                for (int m = 0; m < 4; ++m)
#pragma unroll
                    for (int bj = 0; bj < 2; ++bj) {
                        const u32x4 gg = g[m][bj], dd = d[m][bj];
                        f32x4 q0, q1;
                        q0[0] = bf_lo(gg.x) * __builtin_amdgcn_rcpf(bf_lo(dd.x)); q0[1] = bf_hi(gg.x) * __builtin_amdgcn_rcpf(bf_hi(dd.x));
                        q0[2] = bf_lo(gg.y) * __builtin_amdgcn_rcpf(bf_lo(dd.y)); q0[3] = bf_hi(gg.y) * __builtin_amdgcn_rcpf(bf_hi(dd.y));
                        q1[0] = bf_lo(gg.z) * __builtin_amdgcn_rcpf(bf_lo(dd.z)); q1[1] = bf_hi(gg.z) * __builtin_amdgcn_rcpf(bf_hi(dd.z));
                        q1[2] = bf_lo(gg.w) * __builtin_amdgcn_rcpf(bf_lo(dd.w)); q1[3] = bf_hi(gg.w) * __builtin_amdgcn_rcpf(bf_hi(dd.w));
                        acc[ai][bj][m][0] = acc[ai][bj][m][0] * q0; acc[ai][bj][m][1] = acc[ai][bj][m][1] * q1;
                    }
                asm volatile("" ::: "memory");
            }
        }
    }
    __device__ __forceinline__ void operator()(Acc& acc, const Unit& u, int wr, int wc, int fr, int fq) const {
        fr = launder_i(fr); fq = launder_i(fq);
        const int row0 = u.pm * BM + wr * 64 + fr, col0 = u.pn * BM + wc * 32 + 8 * fq;
        u32x4 d[2][4][2];
#pragma unroll
        for (int ai = 0; ai < 2; ++ai)
#pragma unroll
            for (int m = 0; m < 4; ++m) { const bf16_t* gp = proj + (size_t)(row0 + ai * HALF + m * 16) * DIN + 7168 + col0;
#pragma unroll
                for (int bj = 0; bj < 2; ++bj) d[ai][m][bj] = *(const u32x4*)(gp + bj * HALF); }
        asm volatile("" ::: "memory");
#pragma unroll
        for (int ai = 0; ai < 2; ++ai)
#pragma unroll
            for (int m = 0; m < 4; ++m) {
                const int row = row0 + ai * HALF + m * 16;
#pragma unroll
                for (int bj = 0; bj < 2; ++bj) {
                    const u32x4 dd = d[ai][m][bj];
                    f32x4 s0, s1; s0[0] = bf_lo(dd.x); s0[1] = bf_hi(dd.x); s0[2] = bf_lo(dd.y); s0[3] = bf_hi(dd.y); s1[0] = bf_lo(dd.z); s1[1] = bf_hi(dd.z); s1[2] = bf_lo(dd.w); s1[3] = bf_hi(dd.w);
                    store8(O + (size_t)row * D + col0 + bj * HALF, acc[ai][bj][m][0] * s0, acc[ai][bj][m][1] * s1);
                }
            }
        asm volatile("" ::: "memory");
    }
};
struct EpiWout {
    static constexpr bool MID = false;
    unsigned char* ws; const float* mod; int tbase;
    __device__ __forceinline__ bool mid_at(int) const { return false; }
    __device__ __forceinline__ void mid(Acc&, const Unit&, int, int, int, int, int) const {}
    __device__ __forceinline__ void operator()(Acc& acc, const Unit& u, int wr, int wc, int fr, int fq) const {
        fr = launder_i(fr); fq = launder_i(fq);
        const int row0 = tbase + u.pm * BM + wr * 64 + fr, col0 = u.pn * BM + wc * 32 + 8 * fq;
        const float* g1 = mod + (size_t)(row0 >> 12) * 6144 + 2048 + col0;
        f32x4 g[2][2];
#pragma unroll
        for (int bj = 0; bj < 2; ++bj) { g[bj][0] = *(const f32x4*)(g1 + bj * HALF); g[bj][1] = *(const f32x4*)(g1 + bj * HALF + 4); }
        bf16_t* base = (bf16_t*)(ws + delta_off(tbase + u.pm * BM)) + (size_t)(wr * 64 + fr) * D + col0;
#pragma unroll
        for (int ai = 0; ai < 2; ++ai)
#pragma unroll
            for (int m = 0; m < 4; ++m) {
                bf16_t* rowp = base + (size_t)(ai * HALF + m * 16) * D;
#pragma unroll
                for (int bj = 0; bj < 2; ++bj) store8(rowp + bj * HALF, g[bj][0] * acc[ai][bj][m][0], g[bj][1] * acc[ai][bj][m][1]);
            }
        asm volatile("" ::: "memory");
    }
};
struct EpiGU {
    static constexpr bool MID = false;
    unsigned char* act;
    __device__ __forceinline__ bool mid_at(int) const { return false; }
    __device__ __forceinline__ void mid(Acc&, const Unit&, int, int, int, int, int) const {}
    __device__ __forceinline__ void operator()(Acc& acc, const Unit& u, int wr, int wc, int fr, int fq) const {
        fr = launder_i(fr); fq = launder_i(fq);
        const int row0 = u.pm * BM + wr * 64 + fr, col0 = u.pn * 128 + wc * 16 + 4 * fq;
#pragma unroll
        for (int ai = 0; ai < 2; ++ai)
#pragma unroll
            for (int m = 0; m < 4; ++m) {
                unsigned char* rowp = act + (size_t)(row0 + ai * HALF + m * 16) * DEXP + col0;
#pragma unroll
                for (int bj = 0; bj < 2; ++bj) {
                    const f32x4 gt = acc[ai][bj][m][0] * 0.03125f, up = acc[ai][bj][m][1] * 0.03125f; f32x4 a;
#pragma unroll
                    for (int e = 0; e < 4; ++e) a[e] = gt[e] * fast_sigmoid(gt[e]) * up[e];
                    *(unsigned*)(rowp + bj * 64) = pk4_fp8(a[0], a[1], a[2], a[3]);
                }
            }
        asm volatile("" ::: "memory");
    }
};
struct EpiDown {
    static constexpr bool MID = false;
    unsigned char* y; const LAS float* wl;
    __device__ __forceinline__ bool mid_at(int) const { return false; }
    __device__ __forceinline__ void mid(Acc&, const Unit&, int, int, int, int, int) const {}
    __device__ __forceinline__ void operator()(Acc& acc, const Unit& u, int wr, int wc, int fr, int fq) const {
        fr = launder_i(fr); fq = launder_i(fq);
        const int r0 = wr * 64 + fr, col0 = u.pn * BM + wc * 32 + 8 * fq;
        const int colw = u.pn * BM + wc * 32 + 16 * (fq >> 1), odd = fq & 1;
#pragma unroll
        for (int ai = 0; ai < 2; ++ai)
#pragma unroll
            for (int mp = 0; mp < 2; ++mp) {
                unsigned char* rowp = y + (size_t)(u.pm * BM + r0 + ai * HALF + (2 * mp + odd) * 16) * D + colw;
                const float wA = wl[u.idx * 256 + r0 + ai * HALF + (2 * mp) * 16], wB = wl[u.idx * 256 + r0 + ai * HALF + (2 * mp + 1) * 16];
#pragma unroll
                for (int bj = 0; bj < 2; ++bj) {
                    u32x2 pa, pb;
                    { const int m = 2 * mp; const f32x4 v0 = acc[ai][bj][m][0] * wA, v1 = acc[ai][bj][m][1] * wA; pa.x = pk4_fp8(v0[0], v0[1], v0[2], v0[3]); pa.y = pk4_fp8(v1[0], v1[1], v1[2], v1[3]); }
                    { const int m = 2 * mp + 1; const f32x4 v0 = acc[ai][bj][m][0] * wB, v1 = acc[ai][bj][m][1] * wB; pb.x = pk4_fp8(v0[0], v0[1], v0[2], v0[3]); pb.y = pk4_fp8(v1[0], v1[1], v1[2], v1[3]); }
                    const auto sx = __builtin_amdgcn_permlane16_swap(pa.x, pb.x, false, false), sy = __builtin_amdgcn_permlane16_swap(pa.y, pb.y, false, false);
                    *(u32x4*)(rowp + bj * HALF) = (u32x4){(unsigned)sx[0], (unsigned)sy[0], (unsigned)sx[1], (unsigned)sy[1]};
                    asm volatile("" ::: "memory");
                }
            }
        asm volatile("" ::: "memory");
    }
};
}

__device__ __forceinline__ unsigned off_b(unsigned row, unsigned ch) { return 256u * row + 16u * (ch ^ (((row & 3u) << 2) | ((row >> 2) & 3u))); }
__device__ __forceinline__ int lds_addr(const LAS unsigned char* p) { return (int)(unsigned)(size_t)p; }
__device__ __forceinline__ int crow(int r, int hi) { return (r & 3) + 8 * (r >> 2) + 4 * hi; }
__device__ __forceinline__ s16x4 tr_read(const LAS unsigned char* p) { return __builtin_amdgcn_ds_read_tr16_b64_v4i16((LAS s16x4*)p); }
__device__ __forceinline__ bf16x8 tr_frag(const LAS unsigned char* tile, int r0, int r1, int c, int lane) {
    const int blk = (lane >> 4) & 1, q = (lane & 15) >> 2, p = lane & 3;
    const s16x4 a = tr_read(tile + off_b(r0 + q, 4 * c + 2 * blk + (p >> 1)) + 8 * (p & 1));
    const s16x4 b = tr_read(tile + off_b(r1 + q, 4 * c + 2 * blk + (p >> 1)) + 8 * (p & 1));
    return (bf16x8){a[0], a[1], a[2], a[3], b[0], b[1], b[2], b[3]};
}
__device__ __forceinline__ bf16x8 pack8(const f32x16& v, int base) {
    u32x4 w; w.x = cvt_pk_bf16(v[base + 0], v[base + 1]); w.y = cvt_pk_bf16(v[base + 2], v[base + 3]); w.z = cvt_pk_bf16(v[base + 4], v[base + 5]); w.w = cvt_pk_bf16(v[base + 6], v[base + 7]);
    return __builtin_bit_cast(bf16x8, w);
}
__device__ __forceinline__ int launder(int v) { asm volatile("" : "+v"(v)); return v; }
#define MFMA32(a, b, c) __builtin_amdgcn_mfma_f32_32x32x16_bf16(a, b, c, 0, 0, 0)

struct MixArgs { const bf16_t* proj; bf16_t* act; const float* diff_norm; float lam; float* ssq; };

template <int IMM> __device__ __forceinline__ void tr8_issue(s16x4 (&x)[8], const int (&ad)[8]) {
    asm volatile("ds_read_b64_tr_b16 %0, %8 offset:%16\n\tds_read_b64_tr_b16 %1, %9 offset:%16\n\tds_read_b64_tr_b16 %2, %10 offset:%16\n\tds_read_b64_tr_b16 %3, %11 offset:%16\n\t"
                 "ds_read_b64_tr_b16 %4, %12 offset:%16\n\tds_read_b64_tr_b16 %5, %13 offset:%16\n\tds_read_b64_tr_b16 %6, %14 offset:%16\n\tds_read_b64_tr_b16 %7, %15 offset:%16"
                 : "=&v"(x[0]), "=&v"(x[1]), "=&v"(x[2]), "=&v"(x[3]), "=&v"(x[4]), "=&v"(x[5]), "=&v"(x[6]), "=&v"(x[7])
                 : "v"(ad[0]), "v"(ad[1]), "v"(ad[2]), "v"(ad[3]), "v"(ad[4]), "v"(ad[5]), "v"(ad[6]), "v"(ad[7]), "n"(IMM) : "memory");
}
__device__ __forceinline__ void tr8_wait(s16x4 (&x)[8]) {
    asm volatile("s_waitcnt lgkmcnt(0)" : "+v"(x[0]), "+v"(x[1]), "+v"(x[2]), "+v"(x[3]), "+v"(x[4]), "+v"(x[5]), "+v"(x[6]), "+v"(x[7]) :: "memory");
}
template <int N> __device__ __forceinline__ void tr8_wait_n(s16x4 (&x)[8]) {
    asm volatile("s_waitcnt lgkmcnt(%8)" : "+v"(x[0]), "+v"(x[1]), "+v"(x[2]), "+v"(x[3]), "+v"(x[4]), "+v"(x[5]), "+v"(x[6]), "+v"(x[7]) : "n"(N) : "memory");
}
__device__ __forceinline__ void pv_mma(f32x16 (&O)[8], int ob, const s16x4 (&x)[8], const bf16x8& pf) {
    __builtin_amdgcn_s_setprio(2);
#pragma unroll
    for (int c = 0; c < 4; ++c) { const bf16x8 vf = {x[2 * c][0], x[2 * c][1], x[2 * c][2], x[2 * c][3], x[2 * c + 1][0], x[2 * c + 1][1], x[2 * c + 1][2], x[2 * c + 1][3]}; O[ob + c] = MFMA32(vf, pf, O[ob + c]); }
    __builtin_amdgcn_s_setprio(1);
}
template <int IMM> __device__ __forceinline__ void k4_issue(bf16x8 (&k)[4], int a0, int a1, int a2, int a3) {
    asm volatile("ds_read_b128 %0, %4 offset:%8\n\tds_read_b128 %1, %5 offset:%8\n\tds_read_b128 %2, %6 offset:%8\n\tds_read_b128 %3, %7 offset:%8"
                 : "=&v"(k[0]), "=&v"(k[1]), "=&v"(k[2]), "=&v"(k[3]) : "v"(a0), "v"(a1), "v"(a2), "v"(a3), "n"(IMM) : "memory");
}
__device__ __forceinline__ void tr4_issue(s16x4 (&x)[4], int a0, int a1, int a2, int a3) {
    asm volatile("ds_read_b64_tr_b16 %0, %4\n\tds_read_b64_tr_b16 %1, %5\n\tds_read_b64_tr_b16 %2, %6\n\tds_read_b64_tr_b16 %3, %7"
                 : "=&v"(x[0]), "=&v"(x[1]), "=&v"(x[2]), "=&v"(x[3]) : "v"(a0), "v"(a1), "v"(a2), "v"(a3) : "memory");
}
__device__ __forceinline__ void tr4_wait(s16x4 (&x)[4]) { asm volatile("s_waitcnt lgkmcnt(0)" : "+v"(x[0]), "+v"(x[1]), "+v"(x[2]), "+v"(x[3]) :: "memory"); }
__device__ __forceinline__ int tr_addr(const LAS unsigned char* tile, int r, int c, int lane) {
    const int blk = (lane >> 4) & 1, q = (lane & 15) >> 2, p = lane & 3;
    return lds_addr(tile) + (int)off_b(r + q, 4 * c + 2 * blk + (p >> 1)) + 8 * (p & 1);
}
__device__ __forceinline__ bf16x8 cat4(const s16x4& a, const s16x4& b) { return (bf16x8){a[0], a[1], a[2], a[3], b[0], b[1], b[2], b[3]}; }
template <int N> __device__ __forceinline__ void k4_wait(bf16x8 (&k)[4]) {
    asm volatile("s_waitcnt lgkmcnt(%4)" : "+v"(k[0]), "+v"(k[1]), "+v"(k[2]), "+v"(k[3]) : "n"(N) : "memory");
}
#define FENCE() __builtin_amdgcn_sched_barrier(0)
__device__ __forceinline__ bf16x8 lds_b128(int addr) { return *(const LAS bf16x8*)(size_t)(unsigned)addr; }
__device__ __forceinline__ s16x4 lds_tr(int addr) { return __builtin_amdgcn_ds_read_tr16_b64_v4i16((LAS s16x4*)(size_t)(unsigned)addr); }
template <int IMM> __device__ __forceinline__ s16x4 lds_tr_i(int addr) { return __builtin_amdgcn_ds_read_tr16_b64_v4i16((LAS s16x4*)((LAS unsigned char*)(size_t)(unsigned)addr + IMM)); }
__device__ __forceinline__ void dma16(const void* gptr, unsigned lds_base) {
    asm volatile("s_mov_b32 m0, %1\n\ts_nop 0\n\tglobal_load_lds_dwordx4 %0, off" :: "v"(gptr), "s"(lds_base) : "memory", "m0");
}
__device__ __forceinline__ void dma16s(unsigned long long sbase, unsigned voff, unsigned lds_base) {
    asm volatile("s_mov_b32 m0, %2\n\ts_nop 0\n\tglobal_load_lds_dwordx4 %0, %1" :: "v"(voff), "s"(sbase), "s"(lds_base) : "memory", "m0");
}
__device__ __forceinline__ unsigned attn_voff(int lane) { const int r4 = lane >> 4; return (unsigned)(r4 * DIN * 2 + (((lane & 15) ^ (r4 << 2)) * 16)); }
__device__ __forceinline__ void attn_issue(LAS unsigned char* buf, const bf16_t* proj, size_t trow0, int kcol0, int vcol0, int wid, unsigned voff0) {
    const int ti = wid >> 1;
    const int col = (ti < 2) ? kcol0 + ti * 128 : vcol0 + (ti - 2) * 128;
    const unsigned long long sb = (unsigned long long)(size_t)(proj + (trow0 + 32 * (wid & 1)) * DIN + col);
#pragma unroll
    for (int i = 0; i < 8; ++i)
        dma16s(sb + (unsigned long long)(4 * i) * DIN * 2, voff0 ^ (unsigned)(16 * (i & 3)), (unsigned)__builtin_amdgcn_readfirstlane(lds_addr(buf) + ti * 16384 + ((wid & 1) * 8 + i) * 1024));
}
__device__ __forceinline__ void attn_unit(LAS unsigned char* lds, const int wid, const MixArgs& A, int bl, int h, int qb, int pre, volatile LAS int* bcn) {
    const int lane0 = lane_now(), comp = wid >> 2, ri = wid & 3;
    const size_t tb = (size_t)bl * SEQ;
    const int kcol0 = 4096 + (2 * h) * 128, vcol0 = 5120 + h * 256;
    const int ntiles = 2 * (qb + 1);
    f32x16 O[8]; float mrun = -1e30f, lrun = 0.f;
    {
    const int lane = lane0, hh = lane >> 5, li = lane & 31;
    const unsigned voff0 = attn_voff(lane);
    attn_issue(lds, A.proj, tb, kcol0, vcol0, wid, voff0);
    const bf16_t* qrow = A.proj + (tb + qb * 128 + ri * 32 + li) * DIN + 3072 + (2 * h + comp) * 128;
    bf16x8 qf[8];
#pragma unroll
    for (int s = 0; s < 8; ++s) qf[s] = *(const bf16x8*)(qrow + 16 * s + 8 * hh);
    asm volatile("s_waitcnt vmcnt(0)" : "+v"(qf[0]), "+v"(qf[1]), "+v"(qf[2]), "+v"(qf[3]), "+v"(qf[4]), "+v"(qf[5]), "+v"(qf[6]), "+v"(qf[7]), "+v"(pre) :: "memory");
    if (wid == 0 && lane == 0) bcn[0] = pre;
#pragma unroll
    for (int i = 0; i < 8; ++i)
#pragma unroll
        for (int r = 0; r < 16; ++r) O[i][r] = 0.f;
    const int kadr = 256 * li + 16 * (hh ^ (((li & 3) << 2) | ((li >> 2) & 3)));
    const int blk = (lane >> 4) & 1, q = (lane & 15) >> 2, p = lane & 3, lo1 = (2 * blk + (p >> 1)) ^ hh;
    const int vb1 = 256 * (4 * hh + q) + 64 * q + 16 * lo1 + 8 * (p & 1), vb2 = 256 * (4 * hh + q + 8) + 64 * q + 16 * (lo1 ^ 2) + 8 * (p & 1);
    for (int kt = 0; kt < ntiles; ++kt) {
        asm volatile("s_waitcnt vmcnt(0)" ::: "memory");
        __builtin_amdgcn_s_barrier();
        asm volatile("" ::: "memory");
        if (kt + 1 < ntiles) attn_issue(lds + ((kt + 1) & 1) * 65536, A.proj, tb + (size_t)(kt + 1) * 64, kcol0, vcol0, wid, voff0);
        const int krel0 = (kt - 2 * qb) * 64;
        if (krel0 > ri * 32 + 31) continue;
        const LAS unsigned char* Kt = lds + (kt & 1) * 65536 + comp * 16384;
        const LAS unsigned char* Vt = lds + (kt & 1) * 65536 + 32768;
        f32x16 sc[2];
#pragma unroll
        for (int kb = 0; kb < 2; ++kb)
#pragma unroll
            for (int r = 0; r < 16; ++r) sc[kb][r] = 0.f;
        __builtin_amdgcn_s_setprio(1);
        {
            const int kbase = lds_addr(Kt);
            bf16x8 ka[2][4];
#pragma unroll
            for (int s = 0; s < 4; ++s) ka[0][s] = lds_b128(kbase + (kadr ^ (32 * s)));
#pragma unroll
            for (int grp = 0; grp < 4; ++grp) {
                const int s0 = 4 * (grp >> 1), kb = grp & 1;
                if (grp + 1 < 4) { const int s1 = 4 * ((grp + 1) >> 1), kb1 = (grp + 1) & 1;
#pragma unroll
                    for (int s = 0; s < 4; ++s) ka[(grp + 1) & 1][s] = lds_b128(kbase + 8192 * kb1 + (kadr ^ (32 * (s1 + s)))); }
                FENCE();
                __builtin_amdgcn_s_setprio(2);
#pragma unroll
                for (int s = 0; s < 4; ++s) sc[kb] = MFMA32(ka[grp & 1][s], qf[s0 + s], sc[kb]);
                __builtin_amdgcn_s_setprio(1);
                FENCE();
            }
        }
        __builtin_amdgcn_s_setprio(0);
        if (krel0 >= 0) {
            const int qrel = ri * 32 + li;
#pragma unroll
            for (int kb = 0; kb < 2; ++kb)
#pragma unroll
                for (int r = 0; r < 16; ++r) if (krel0 + 32 * kb + crow(r, hh) > qrel) sc[kb][r] = -INFINITY;
        }
        float pmax = sc[0][0];
#pragma unroll
        for (int r = 1; r < 16; ++r) pmax = fmaxf(pmax, sc[0][r]);
#pragma unroll
        for (int r = 0; r < 16; ++r) pmax = fmaxf(pmax, sc[1][r]);
        pmax = xor32_max(pmax);
        if (!__all(pmax <= mrun + 11.0f)) {
            const float mn = fmaxf(mrun, pmax), alpha = __builtin_amdgcn_exp2f(mrun - mn);
            mrun = mn; lrun *= alpha;
#pragma unroll
            for (int i = 0; i < 8; ++i)
#pragma unroll
                for (int r = 0; r < 16; ++r) O[i][r] *= alpha;
        }
        float ps = 0.f;
#pragma unroll
        for (int kb = 0; kb < 2; ++kb)
#pragma unroll
            for (int r = 0; r < 16; ++r) { const float pe = __builtin_amdgcn_exp2f(sc[kb][r] - mrun); sc[kb][r] = pe; ps += pe; }
        lrun += ps;
        {
            const int vbase = (int)(unsigned)(size_t)Vt;
            int ad[8];
#pragma unroll
            for (int c = 0; c < 4; ++c) { ad[2 * c] = vbase + (vb1 ^ (64 * c)); ad[2 * c + 1] = vbase + (vb2 ^ (64 * c)); }
            const bf16x8 pf0 = pack8(sc[0], 0), pf1 = pack8(sc[0], 8), pf2 = pack8(sc[1], 0), pf3 = pack8(sc[1], 8);
            s16x4 xa[8], xb[8];
            __builtin_amdgcn_s_setprio(1);
#define PV_LOAD(x, IMM) do { _Pragma("unroll") for (int c = 0; c < 8; ++c) x[c] = lds_tr_i<(IMM)>(ad[c]); } while (0)
            PV_LOAD(xa, 256 * 0);
            PV_LOAD(xb, 256 * 0 + 16384);  FENCE(); pv_mma(O, 0, xa, pf0); FENCE();
            PV_LOAD(xa, 256 * 16);         FENCE(); pv_mma(O, 4, xb, pf0); FENCE();
            PV_LOAD(xb, 256 * 16 + 16384); FENCE(); pv_mma(O, 0, xa, pf1); FENCE();
            PV_LOAD(xa, 256 * 32);         FENCE(); pv_mma(O, 4, xb, pf1); FENCE();
            PV_LOAD(xb, 256 * 32 + 16384); FENCE(); pv_mma(O, 0, xa, pf2); FENCE();
            PV_LOAD(xa, 256 * 48);         FENCE(); pv_mma(O, 4, xb, pf2); FENCE();
            PV_LOAD(xb, 256 * 48 + 16384); FENCE(); pv_mma(O, 0, xa, pf3); FENCE();
                                                    pv_mma(O, 4, xb, pf3);
            __builtin_amdgcn_s_setprio(0);
#undef PV_LOAD
        }
    }
    }
    __syncthreads();
    const float inv = 1.0f / xor32_sum(lrun);
    LAS f32x4* X = (LAS f32x4*)lds;
    const int lane = lane_now(), hh = lane >> 5, li = lane & 31;
    if (comp == 1) {
#pragma unroll
        for (int dvb = 0; dvb < 8; ++dvb)
#pragma unroll
            for (int g = 0; g < 4; ++g) X[((ri * 8 + dvb) * 4 + g) * 64 + lane] = (f32x4){O[dvb][4 * g] * inv, O[dvb][4 * g + 1] * inv, O[dvb][4 * g + 2] * inv, O[dvb][4 * g + 3] * inv};
    }
    __syncthreads();
    if (comp == 0) {
        float ss = 0.f;
#pragma unroll
        for (int dvb = 0; dvb < 8; ++dvb)
#pragma unroll
            for (int g = 0; g < 4; ++g) {
                const f32x4 o2 = X[((ri * 8 + dvb) * 4 + g) * 64 + lane];
#pragma unroll
                for (int e = 0; e < 4; ++e) { float d = O[dvb][4 * g + e] * inv - A.lam * o2[e]; asm volatile("" : "+v"(d)); O[dvb][4 * g + e] = d; ss += d * d; }
            }
        ss = xor32_sum(ss);
        const float rstd = 0.8f / sqrtf(ss * (1.0f / 256.0f) + EPS);
        LAS unsigned char* stg = lds + ri * 32768;
        const LAS float* dnl = (const LAS float*)(lds + LDSCTL_OFF + 12288);
#pragma unroll
        for (int dvb = 0; dvb < 8; ++dvb)
#pragma unroll
            for (int g = 0; g < 4; ++g) {
                const f32x4 gn = *(const LAS f32x4*)(dnl + 32 * dvb + 8 * g + 4 * hh);
                u32x2 w; w.x = cvt_pk_bf16(O[dvb][4 * g] * rstd * gn[0], O[dvb][4 * g + 1] * rstd * gn[1]); w.y = cvt_pk_bf16(O[dvb][4 * g + 2] * rstd * gn[2], O[dvb][4 * g + 3] * rstd * gn[3]);
                *(LAS u32x2*)(stg + li * 528 + 64 * dvb + 16 * g + 8 * hh) = w;
            }
        asm volatile("s_waitcnt lgkmcnt(0)" ::: "memory");
        bf16_t* obase = A.act + (tb + qb * 128 + ri * 32 + hh) * 2048 + 1024 + h * 256 + 8 * li;
#pragma unroll
        for (int i4 = 0; i4 < 4; ++i4) {
            u32x4 v[4];
#pragma unroll
            for (int q = 0; q < 4; ++q) v[q] = *(const LAS u32x4*)(stg + (2 * (4 * i4 + q) + hh) * 528 + 16 * li);
#pragma unroll
            for (int q = 0; q < 4; ++q) *(u32x4*)(obase + (size_t)(2 * (4 * i4 + q)) * 2048) = v[q];
        }
    }
    __syncthreads();
}

#define MFMA_DEP(acc, zs) (__builtin_amdgcn_readfirstlane(__float_as_int((acc)[15])) & (zs))
#define MFMA_DEP2(a, b, zs) ((__builtin_amdgcn_readfirstlane(__float_as_int((a)[15])) | __builtin_amdgcn_readfirstlane(__float_as_int((b)[15]))) & (zs))
#define MFMA_DEP4(a, b, c, d, zs) ((__builtin_amdgcn_readfirstlane(__float_as_int((a)[15])) | __builtin_amdgcn_readfirstlane(__float_as_int((b)[15])) | __builtin_amdgcn_readfirstlane(__float_as_int((c)[15])) | __builtin_amdgcn_readfirstlane(__float_as_int((d)[15]))) & (zs))
#define RET_BAR() do { asm volatile("s_waitcnt lgkmcnt(0)" ::: "memory"); __builtin_amdgcn_s_barrier(); asm volatile("" ::: "memory"); } while (0)
template <int J2> __device__ __forceinline__ void ret_step34(f32x16 (&Oa)[2], f32x16 (&St)[2], const int (&tv)[2], const int (&tk)[2][2], int pa0, int pa1, int pb0, int pb1, int ib0, int ib1) {
    constexpr int R = 256 * 32 * J2;
    s16x4 xv[4], xk0[4], xk1[4]; bf16x8 pp[4];
    xv[0] = lds_tr_i<R>(tv[0]); xv[1] = lds_tr_i<R + 1024>(tv[1]); xv[2] = lds_tr_i<R + 4096>(tv[0]); xv[3] = lds_tr_i<R + 5120>(tv[1]);
    xk0[0] = lds_tr_i<R>(tk[0][0]); xk0[1] = lds_tr_i<R + 1024>(tk[0][1]); xk0[2] = lds_tr_i<R + 4096>(tk[0][0]); xk0[3] = lds_tr_i<R + 5120>(tk[0][1]);
    xk1[0] = lds_tr_i<R>(tk[1][0]); xk1[1] = lds_tr_i<R + 1024>(tk[1][1]); xk1[2] = lds_tr_i<R + 4096>(tk[1][0]); xk1[3] = lds_tr_i<R + 5120>(tk[1][1]);
    pp[0] = lds_b128(pa0); pp[1] = lds_b128(pb0); pp[2] = lds_b128(pa1); pp[3] = lds_b128(pb1);
    FENCE();
    const bf16x8 z = {0, 0, 0, 0, 0, 0, 0, 0};
#pragma unroll
    for (int q = 0; q < 2; ++q) {
        const bf16x8 vf = cat4(xv[2 * q], xv[2 * q + 1]);
        Oa[0] = MFMA32(vf, (J2 <= ib0) ? pp[2 * q] : z, Oa[0]); Oa[1] = MFMA32(vf, (J2 <= ib1) ? pp[2 * q + 1] : z, Oa[1]);
        St[0] = MFMA32(cat4(xk0[2 * q], xk0[2 * q + 1]), vf, St[0]); St[1] = MFMA32(cat4(xk1[2 * q], xk1[2 * q + 1]), vf, St[1]);
    }
    FENCE();
}
__device__ __forceinline__ void ret_unit(LAS unsigned char* lds, const int wid, const MixArgs& A, int bl, int h, int dvh) {
    const int lane = lane_now(), tid = wid * 64 + lane, eb = wid & 3, hf = wid >> 2;
    const int ib0 = hf ? 1 : 0, ib1 = hf ? 2 : 3, li = lane & 31, hh = lane >> 5;
    const size_t tb = (size_t)bl * SEQ;
    const float gamma = 1.0f - __builtin_amdgcn_exp2f(-5.0f - (float)h), lg = __builtin_amdgcn_logf(gamma);
    const float cdecay = __builtin_amdgcn_exp2f(128.0f * lg), cinv = __builtin_amdgcn_exp2f(-128.0f * lg);
    const int L0 = lds_addr(lds), X = ((li & 3) << 2) | ((li >> 2) & 3);
    int rb[8];
#pragma unroll
    for (int s = 0; s < 8; ++s) rb[s] = L0 + 256 * li + 16 * ((2 * s + hh) ^ X);
    int wb[4];
#pragma unroll
    for (int g = 0; g < 4; ++g) wb[g] = L0 + 256 * li + 16 * (g ^ (X & 3)) + 8 * hh;
    const int xh = X >> 2;
    const int tq = (lane & 15) >> 2, tp = lane & 3, tblk = (lane >> 4) & 1;
    int tv[2], tk[2][2];
#pragma unroll
    for (int t = 0; t < 2; ++t) {
        const int lp = 2048 * hh + 256 * tq + 16 * ((2 * tblk + (tp >> 1)) ^ (2 * hh + t)) + 8 * (tp & 1);
        tv[t] = L0 + 65536 + lp + 64 * (eb ^ tq);
#pragma unroll
        for (int k = 0; k < 2; ++k) tk[k][t] = L0 + 32768 + lp + 64 * ((2 * hf + k) ^ tq);
    }
    const int sS0 = 98304 + 8192 * eb, sA0 = 8192 * ib0, sB0 = 8192 * ib1;
    const int sw = 256 * (tid >> 4) + 16 * ((tid & 15) ^ ((((tid >> 4) & 3) << 2) | ((tid >> 6) & 3)));
    const unsigned gq = (unsigned)(((tid >> 4) * DIN + (tid & 15) * 8) * 2);
    const unsigned colb[3] = {(unsigned)(h * 128 * 2), (unsigned)((512 + h * 128) * 2), (unsigned)((1024 + h * 256 + dvh * 128) * 2)};
    const unsigned go0 = (unsigned)(((32 * ib0 + li) * DIN + 4 * hh) * 2), go1 = (unsigned)(((32 * ib1 + li) * DIN + 4 * hh) * 2);
    const unsigned oo0 = (unsigned)(((32 * ib0 + li) * 2048 + 4 * hh) * 2), oo1 = (unsigned)(((32 * ib1 + li) * 2048 + 4 * hh) * 2);
    f32x16 St[2];
#pragma unroll
    for (int i = 0; i < 2; ++i)
#pragma unroll
        for (int r = 0; r < 16; ++r) St[i][r] = 0.f;
    u32x4 pre[12];
    {
        const char* cb = (const char*)(A.proj + tb * DIN);
#pragma unroll
        for (int i = 0; i < 12; ++i) pre[i] = *(const u32x4*)(cb + (size_t)(i & 3) * 32 * DIN * 2 + (gq + colb[i >> 2]));
#pragma unroll
        for (int i = 0; i < 12; ++i) *(LAS u32x4*)(lds + (i >> 2) * 32768 + (i & 3) * 8192 + sw) = pre[i];
    }
    RET_BAR();
    for (int n = 0; n < 32; ++n) {
        const size_t t0 = tb + (size_t)n * 128;
        int sS = sS0, sA = sA0, sB = sB0, wl = wid;
        asm volatile("" : "+s"(sS), "+s"(sA), "+s"(sB), "+s"(wl));
        if (n + 1 < 32) {
            const char* cb = (const char*)(A.proj + (t0 + 128) * DIN);
#pragma unroll
            for (int i = 0; i < 12; ++i) pre[i] = *(const u32x4*)(cb + (size_t)(i & 3) * 32 * DIN * 2 + (gq + colb[i >> 2]));
        }
        f32x16 Oa[2];
#pragma unroll
        for (int i = 0; i < 2; ++i)
#pragma unroll
            for (int r = 0; r < 16; ++r) Oa[i][r] = 0.f;
        if (n > 0) {
#pragma unroll
            for (int s4 = 0; s4 < 2; ++s4) {
                bf16x8 sa[4], qa[4], qb[4];
#pragma unroll
                for (int s = 0; s < 4; ++s) { sa[s] = lds_b128(rb[4 * s4 + s] + sS); qa[s] = lds_b128(rb[4 * s4 + s] + sA); qb[s] = lds_b128(rb[4 * s4 + s] + sB); }
                FENCE();
#pragma unroll
                for (int s = 0; s < 4; ++s) { Oa[0] = MFMA32(sa[s], qa[s], Oa[0]); Oa[1] = MFMA32(sa[s], qb[s], Oa[1]); }
                FENCE();
            }
        }
        f32x16 sb[2]; int jbs[2], ibs[2];
#pragma unroll
        for (int u = 0; u < 2; ++u) {
            const int id = wl + 8 * u;
            const int ib = (id >= 6) ? 3 : (id >= 3) ? 2 : (id >= 1) ? 1 : 0, jb = id - (ib * (ib + 1)) / 2;
            ibs[u] = ib; jbs[u] = jb;
#pragma unroll
            for (int r = 0; r < 16; ++r) sb[u][r] = 0.f;
            if (id < 10) {
                bf16x8 fa[4], fb[4];
                const int ok = 32768 + 8192 * jb, oq = 8192 * ib;
#pragma unroll
                for (int h2 = 0; h2 < 2; ++h2) {
#pragma unroll
                    for (int s = 0; s < 4; ++s) { fa[s] = lds_b128(rb[4 * h2 + s] + ok); fb[s] = lds_b128(rb[4 * h2 + s] + oq); }
                    FENCE();
#pragma unroll
                    for (int s = 0; s < 4; ++s) sb[u] = MFMA32(fa[s], fb[s], sb[u]);
                    FENCE();
                }
            }
        }
        RET_BAR();
#pragma unroll
        for (int u = 0; u < 2; ++u) {
            const int id = wl + 8 * u;
            if (id < 10) {
                const int ib = ibs[u], jb = jbs[u], wo = 8192 * ib + 64 * (jb ^ xh);
#pragma unroll
                for (int g = 0; g < 4; ++g) {
                    float p[4];
#pragma unroll
                    for (int e = 0; e < 4; ++e) { const int j = 8 * g + 4 * hh + e; p[e] = (ib == jb && j > li) ? 0.f : sb[u][4 * g + e] * cinv; }
                    u32x2 w; w.x = cvt_pk_bf16(p[0], p[1]); w.y = cvt_pk_bf16(p[2], p[3]);
                    *(LAS u32x2*)(size_t)(unsigned)(wb[g] + wo) = w;
                }
            }
        }
        RET_BAR();
        u32x2 gg[2][4];
        { const char* gbp = (const char*)(A.proj + t0 * DIN + 2048 + h * 256 + dvh * 128 + 32 * eb);
#pragma unroll
          for (int g = 0; g < 4; ++g) { gg[0][g] = *(const u32x2*)(gbp + go0 + 16 * g); gg[1][g] = *(const u32x2*)(gbp + go1 + 16 * g); } }
#pragma unroll
        for (int k = 0; k < 2; ++k)
#pragma unroll
            for (int r = 0; r < 16; ++r) St[k][r] *= cdecay;
        ret_step34<0>(Oa, St, tv, tk, rb[0] + sA, rb[1] + sA, rb[0] + sB, rb[1] + sB, ib0, ib1);
        ret_step34<1>(Oa, St, tv, tk, rb[2] + sA, rb[3] + sA, rb[2] + sB, rb[3] + sB, ib0, ib1);
        ret_step34<2>(Oa, St, tv, tk, rb[4] + sA, rb[5] + sA, rb[4] + sB, rb[5] + sB, ib0, ib1);
        ret_step34<3>(Oa, St, tv, tk, rb[6] + sA, rb[7] + sA, rb[6] + sB, rb[7] + sB, ib0, ib1);
        RET_BAR();
#pragma unroll
        for (int k = 0; k < 2; ++k) {
            const int so = sS + 64 * ((2 * (wl >> 2) + k) ^ xh);
#pragma unroll
            for (int g = 0; g < 4; ++g) {
                u32x2 w; w.x = cvt_pk_bf16(St[k][4 * g], St[k][4 * g + 1]); w.y = cvt_pk_bf16(St[k][4 * g + 2], St[k][4 * g + 3]);
                *(LAS u32x2*)(size_t)(unsigned)(wb[g] + so) = w;
            }
        }
        if (n + 1 < 32) {
#pragma unroll
            for (int i = 0; i < 12; ++i) *(LAS u32x4*)(lds + (i >> 2) * 32768 + (i & 3) * 8192 + sw) = pre[i];
        }
        {
            char* obp = (char*)(A.act + t0 * 2048 + h * 256 + dvh * 128 + 32 * eb);
            float* sqp = A.ssq + (t0 * 4 + h) * 8 + dvh * 4 + eb;
#pragma unroll
            for (int k = 0; k < 2; ++k) {
                float sq = 0.f;
#pragma unroll
                for (int r = 0; r < 16; ++r) sq += Oa[k][r] * Oa[k][r];
                sq = xor32_sum(sq);
                if (hh == 0) sqp[(size_t)(32 * (k ? ib1 : ib0) + li) * 32] = sq;
                const unsigned oo = k ? oo1 : oo0;
                u32x2 w[4];
#pragma unroll
                for (int g = 0; g < 4; ++g) {
                    const u32x2 gv = gg[k][g];
                    w[g].x = cvt_pk_bf16(Oa[k][4 * g] * bf_lo(gv.x), Oa[k][4 * g + 1] * bf_hi(gv.x)); w[g].y = cvt_pk_bf16(Oa[k][4 * g + 2] * bf_lo(gv.y), Oa[k][4 * g + 3] * bf_hi(gv.y));
                }
#pragma unroll
                for (int g = 0; g < 4; g += 2) {
                    const auto sx = __builtin_amdgcn_permlane32_swap(w[g].x, w[g + 1].x, false, false), sy = __builtin_amdgcn_permlane32_swap(w[g].y, w[g + 1].y, false, false);
                    *(u32x4*)(obp + (oo - 8 * hh) + 16 * (g + hh)) = (u32x4){(unsigned)sx[0], (unsigned)sy[0], (unsigned)sx[1], (unsigned)sy[1]};
                }
            }
        }
        RET_BAR();
    }
    __syncthreads();
}

struct Args { const void* in[24]; float* out; unsigned char* ws; int ph_lo, ph_hi; };
struct Frame {
    LAS unsigned char* lds; int tid, lane, wave, G, vcu;
    const float *x, *c, *w_ada, *b_ada, *norm_mix, *w_in, *w_ret_o, *w_diff_o, *lq1, *lk1, *lq2, *lk2, *diff_norm, *w_out, *norm_ffn, *w_rg, *b_rg, *w_re, *b_re, *w_eg, *w_eu, *w_ed, *norm_final;
    const int* positions; float* out; unsigned char* ws;
};
__device__ __forceinline__ unsigned f2bf(float f) { unsigned u = __builtin_bit_cast(unsigned, f); return (u + 0x7fffu + ((u >> 16) & 1u)) >> 16; }
__device__ __forceinline__ unsigned pk2(float lo, float hi) { return f2bf(lo) | (f2bf(hi) << 16); }

template <int MODE>
__device__ __forceinline__ void p0_transpose_item(const float* W, int N, bf16_t* WT, int ldk, int koff, LAS float* scr, int item, int lane) {
    const int nblk = N / 32, kb = item / nblk, nb = item % nblk, k0 = 64 * kb, n0 = 32 * nb;
    { float wv[32];
#pragma unroll
      for (int i = 0; i < 32; ++i) { const int kk = 2 * i + (lane >> 5); wv[i] = W[(size_t)(k0 + kk) * N + n0 + (lane & 31)]; }
#pragma unroll
      for (int i = 0; i < 32; ++i) { const int kk = 2 * i + (lane >> 5); scr[kk * 33 + (lane & 31)] = wv[i]; } }
    LDS_WAIT(); asm volatile("" ::: "memory");
    const int c = lane & 7;
#pragma unroll
    for (int j = 0; j < 4; ++j) {
        const int nl = (lane >> 3) + 8 * j, n = n0 + nl; const LAS float* s = scr + (8 * c) * 33 + nl;
        int np = n; float sc = 1.f;
        if (MODE == 1) {
            const bool rope = (n < 1024) || (n >= 3072 && n < 5120);
            if (rope) { const int f = n & 127; np = (n & ~127) + 8 * ((f & 63) >> 2) + 4 * (f >> 6) + (f & 3); }
            if ((n >= 512 && n < 1024) || (n >= 4096 && n < 5120)) sc = 0.08838834764831845f;
            else if (n >= 3072 && n < 4096) sc = 1.4426950408889634f;
        } else if (MODE == 2) np = 8 * (n >> 2) + (n & 3);
        else if (MODE == 3) np = 8 * (n >> 2) + 4 + (n & 3);
        u32x4 o; o.x = pk2(s[0 * 33] * sc, s[1 * 33] * sc); o.y = pk2(s[2 * 33] * sc, s[3 * 33] * sc); o.z = pk2(s[4 * 33] * sc, s[5 * 33] * sc); o.w = pk2(s[6 * 33] * sc, s[7 * 33] * sc);
        *(u32x4*)(WT + (size_t)np * ldk + koff + k0 + 8 * c) = o;
    }
    LDS_WAIT(); asm volatile("" ::: "memory");
}

template <int MODE>
__device__ __forceinline__ void p0_transpose_item8(const float* W, int N, unsigned char* WT8, int ldk, LAS float* scr, int item, int lane) {
    const int nblk = N / 32, kb = item / nblk, nb = item % nblk, k0 = 64 * kb, n0 = 32 * nb;
    { float wv[32];
#pragma unroll
      for (int i = 0; i < 32; ++i) { const int kk = 2 * i + (lane >> 5); wv[i] = W[(size_t)(k0 + kk) * N + n0 + (lane & 31)]; }
#pragma unroll
      for (int i = 0; i < 32; ++i) { const int kk = 2 * i + (lane >> 5); scr[kk * 33 + (lane & 31)] = wv[i]; } }
    LDS_WAIT(); asm volatile("" ::: "memory");
    const int c = lane & 7;
#pragma unroll
    for (int j = 0; j < 4; ++j) {
        const int nl = (lane >> 3) + 8 * j, n = n0 + nl; const LAS float* s = scr + (8 * c) * 33 + nl;
        const int np = (MODE == 2) ? 8 * (n >> 2) + (n & 3) : (MODE == 3) ? 8 * (n >> 2) + 4 + (n & 3) : n;
        u32x2 o; o.x = pk4_fp8(s[0 * 33] * 32.f, s[1 * 33] * 32.f, s[2 * 33] * 32.f, s[3 * 33] * 32.f); o.y = pk4_fp8(s[4 * 33] * 32.f, s[5 * 33] * 32.f, s[6 * 33] * 32.f, s[7 * 33] * 32.f);
        *(u32x2*)(WT8 + (size_t)np * ldk + k0 + 8 * c) = o;
    }
    LDS_WAIT(); asm volatile("" ::: "memory");
}
template <int MODE>
__device__ __forceinline__ void p0_transpose_pair8(const float* W, int N, unsigned char* WT8, int ldk, LAS float* scr, int item, int lane) {
    const int nblk = N / 32;
    float wa[32], wb[32];
    { const int kb = item / nblk, nb = item % nblk, k0 = 64 * kb, n0 = 32 * nb;
#pragma unroll
      for (int i = 0; i < 32; ++i) { const int kk = 2 * i + (lane >> 5); wa[i] = W[(size_t)(k0 + kk) * N + n0 + (lane & 31)]; } }
    { const int kb = (item + 1) / nblk, nb = (item + 1) % nblk, k0 = 64 * kb, n0 = 32 * nb;
#pragma unroll
      for (int i = 0; i < 32; ++i) { const int kk = 2 * i + (lane >> 5); wb[i] = W[(size_t)(k0 + kk) * N + n0 + (lane & 31)]; } }
#pragma unroll
    for (int h = 0; h < 2; ++h) {
        const int it = item + h, kb = it / nblk, nb = it % nblk, k0 = 64 * kb, n0 = 32 * nb;
#pragma unroll
        for (int i = 0; i < 32; ++i) { const int kk = 2 * i + (lane >> 5); scr[kk * 33 + (lane & 31)] = h ? wb[i] : wa[i]; }
        LDS_WAIT(); asm volatile("" ::: "memory");
        const int c = lane & 7;
#pragma unroll
        for (int j = 0; j < 4; ++j) {
            const int nl = (lane >> 3) + 8 * j, n = n0 + nl; const LAS float* sp = scr + (8 * c) * 33 + nl;
            const int np = (MODE == 2) ? 8 * (n >> 2) + (n & 3) : (MODE == 3) ? 8 * (n >> 2) + 4 + (n & 3) : n;
            u32x2 o; o.x = pk4_fp8(sp[0 * 33] * 32.f, sp[1 * 33] * 32.f, sp[2 * 33] * 32.f, sp[3 * 33] * 32.f); o.y = pk4_fp8(sp[4 * 33] * 32.f, sp[5 * 33] * 32.f, sp[6 * 33] * 32.f, sp[7 * 33] * 32.f);
            *(u32x2*)(WT8 + (size_t)np * ldk + k0 + 8 * c) = o;
        }
        LDS_WAIT(); asm volatile("" ::: "memory");
    }
}

__device__ __forceinline__ void p0_prologue(Frame& F) {
    F.lane = lane_now(); F.tid = F.wave * 64 + F.lane;
    float* mod = (float*)(F.ws + WS_MOD);
    LAS float* sc = (LAS float*)F.lds;
    for (int i = F.tid; i < NB * D; i += NTHR) { const float v = F.c[i]; sc[(i & 1023) * 8 + (i >> 10)] = v / (1.0f + __expf(-v)); }
    __syncthreads();
    LAS float* red = (LAS float*)(F.lds + 32768);
    for (int item = blockIdx.x; item < 192; item += F.G) {
        const int cl = F.tid & 31, kg = F.tid >> 5, col = item * 32 + cl;
        const float* wp = F.w_ada + (size_t)(kg * 64) * 6144 + col;
        float w[64];
#pragma unroll
        for (int k = 0; k < 64; ++k) w[k] = wp[(size_t)k * 6144];
        float a[8];
#pragma unroll
        for (int b = 0; b < 8; ++b) a[b] = 0.f;
#pragma unroll
        for (int k = 0; k < 64; ++k) { const f32x4 s0 = *(const LAS f32x4*)(sc + (kg * 64 + k) * 8), s1 = *(const LAS f32x4*)(sc + (kg * 64 + k) * 8 + 4);
            a[0] += s0.x * w[k]; a[1] += s0.y * w[k]; a[2] += s0.z * w[k]; a[3] += s0.w * w[k]; a[4] += s1.x * w[k]; a[5] += s1.y * w[k]; a[6] += s1.z * w[k]; a[7] += s1.w * w[k]; }
#pragma unroll
        for (int b = 0; b < 8; ++b) red[(kg * 8 + b) * 32 + cl] = a[b];
        __syncthreads();
        if (F.tid < 256) { const int b = F.tid >> 5; float s = 0.f;
#pragma unroll
          for (int g = 0; g < 16; ++g) s += red[(g * 8 + b) * 32 + cl];
          mod[(size_t)b * 6144 + col] = s + F.b_ada[col]; }
        __syncthreads();
    }
    if (blockIdx.x == 0 && F.wave == 0) {
        float s1 = F.lq1[F.lane] * F.lk1[F.lane] + F.lq1[F.lane + 64] * F.lk1[F.lane + 64], s2 = F.lq2[F.lane] * F.lk2[F.lane] + F.lq2[F.lane + 64] * F.lk2[F.lane + 64];
        s1 = wave_sum(s1); s2 = wave_sum(s2);
        if (F.lane == 0) *(float*)(F.ws + WS_MOD + 256 * 1024) = __expf(s1) - __expf(s2) + 0.2f;
    }
    { bf16_t* rth = (bf16_t*)(F.ws + WS_MOD + 512 * 1024); bf16_t* rtl = rth + 48 * D;
      for (int i = blockIdx.x * NTHR + F.tid; i < 48 * D; i += F.G * NTHR) { const int o = i >> 10, k = i & 1023; const float w = (o < 4) ? F.w_rg[k * 4 + o] : (o < 36) ? F.w_re[k * 32 + (o - 4)] : 0.f;
          const unsigned h = f2bf(w); rth[i] = (bf16_t)h; rtl[i] = (bf16_t)f2bf(w - __uint_as_float(h << 16)); } }
    __syncthreads();
    LAS float* scr = (LAS float*)(F.lds + F.wave * 16384);
    const int gw = launder_s(F.vcu * NWAVES + F.wave), NGW = F.G * NWAVES;
    constexpr int I_IN = 16 * 256, I_SQ = 16 * 32;
    constexpr int NITEMS = I_IN + 3 * I_SQ;
    bf16_t* Win = (bf16_t*)(F.ws + WS_WIN); bf16_t* Wmix = (bf16_t*)(F.ws + WS_WMIX); bf16_t* Wout = (bf16_t*)(F.ws + WS_WOUT);
    for (int it = gw; it < NITEMS; it += NGW) {
        int r = it;
        if (r < I_IN) { p0_transpose_item<1>(F.w_in, DIN, Win, 1024, 0, scr, r, F.lane); continue; } r -= I_IN;
        if (r < I_SQ) { p0_transpose_item<0>(F.w_ret_o, D, Wmix, 2048, 0, scr, r, F.lane); continue; } r -= I_SQ;
        if (r < I_SQ) { p0_transpose_item<0>(F.w_diff_o, D, Wmix, 2048, 1024, scr, r, F.lane); continue; } r -= I_SQ;
        p0_transpose_item<0>(F.w_out, D, Wout, 1024, 0, scr, r, F.lane);
    }
    float* cosT = (float*)(F.ws + WS_COS); float* sinT = (float*)(F.ws + WS_SIN);
    {
        constexpr int RIT = 16;
        const int stride = F.G * NTHR;
        for (int base = blockIdx.x * NTHR + F.tid; base < T * 64; base += stride * RIT) {
            int pos[RIT];
#pragma unroll
            for (int q = 0; q < RIT; ++q) { const int i = base + q * stride; pos[q] = (i < T * 64) ? F.positions[i >> 6] : 0; }
#pragma unroll
            for (int q = 0; q < RIT; ++q) {
                const int i = base + q * stride; if (i >= T * 64) break;
                const int j = i & 63;
                const float inv = __builtin_amdgcn_exp2f(-(float)j * (13.287712379549449f / 64.0f));
                const float ang = (float)pos[q] * inv;
                double rev = (double)ang * 0.15915494309189535; rev -= __builtin_rint(rev);
                const float rf = (float)rev;
                cosT[i] = __builtin_amdgcn_cosf(rf); sinT[i] = __builtin_amdgcn_sinf(rf);
            }
        }
    }
}

__device__ __forceinline__ void convert_experts(Frame& F) {
    constexpr int I_G = 32 * 256, NCH = (3 * I_G) / 32;
    unsigned* q2 = (unsigned*)(F.ws + WS_CTL) + CW_Q + 64 * 8;
    volatile LAS int* bc = (volatile LAS int*)(F.lds + LDSCTL_OFF + 64);
    LAS float* scr = (LAS float*)(F.lds + F.wave * 16384);
    unsigned char* Wgu = F.ws + WS_WGU; unsigned char* Wdn = F.ws + WS_WDN;
    const int lane = lane_now();
    for (;;) {
        __syncthreads();
        if (F.wave == 0 && lane_now() == 0) bc[0] = (int)__hip_atomic_fetch_add(q2, 1u, __ATOMIC_RELAXED, __HIP_MEMORY_SCOPE_AGENT);
        __syncthreads();
        const int c = bc[0];
        if (c >= NCH) break;
        for (int k = 0; k < 4; k += 2) {
            int r = c * 32 + F.wave * 4 + k;
            if (r < I_G) { const int e = r >> 8; p0_transpose_pair8<2>(F.w_eg + (size_t)e * D * DEXP, DEXP, Wgu + (size_t)e * 1024 * 1024, 1024, scr, r & 255, lane); continue; } r -= I_G;
            if (r < I_G) { const int e = r >> 8; p0_transpose_pair8<3>(F.w_eu + (size_t)e * D * DEXP, DEXP, Wgu + (size_t)e * 1024 * 1024, 1024, scr, r & 255, lane); continue; } r -= I_G;
            { const int e = r >> 8; p0_transpose_pair8<0>(F.w_ed + (size_t)e * DEXP * D, D, Wdn + (size_t)e * 1024 * 512, 512, scr, r & 255, lane); }
        }
    }
    __syncthreads();
}

__device__ __forceinline__ void p1_norm_mod(Frame& F) {
    F.lane = lane_now(); F.tid = F.wave * 64 + F.lane;
    const float* mod = (const float*)(F.ws + WS_MOD); bf16_t* H0 = (bf16_t*)(F.ws + WS_H); bf16_t* H1 = (bf16_t*)(F.out + (size_t)TH * D);
    const int gw = launder_s(F.vcu * NWAVES + F.wave), NGW = F.G * NWAVES;
    f32x4 v[4], vn[4];
    if (gw < T) { const f32x4* xr = (const f32x4*)(F.x + (size_t)gw * D) + F.lane;
#pragma unroll
        for (int j = 0; j < 4; ++j) v[j] = xr[64 * j]; }
    for (int t = gw; t < T; t += NGW) {
        const int b = t >> 12;
        f32x4 gs[4], sh[4];
#pragma unroll
        for (int j = 0; j < 4; ++j) { const int col = 4 * F.lane + 256 * j;
            const f32x4 g = *(const f32x4*)(F.norm_mix + col), sc = *(const f32x4*)(mod + (size_t)b * 6144 + 1024 + col); sh[j] = *(const f32x4*)(mod + (size_t)b * 6144 + col); gs[j] = g * (sc + 1.0f); }
        if (t + NGW < T) { const f32x4* xr = (const f32x4*)(F.x + (size_t)(t + NGW) * D) + F.lane;
#pragma unroll
            for (int j = 0; j < 4; ++j) vn[j] = xr[64 * j]; }
        float s = 0.f;
#pragma unroll
        for (int j = 0; j < 4; ++j) s += (v[j].x * v[j].x + v[j].y * v[j].y) + (v[j].z * v[j].z + v[j].w * v[j].w);
        const float rstd = 1.0f / sqrtf(wave_sum(s) * (1.0f / D) + EPS);
        u32x2* o8 = (u32x2*)((t < TH ? H0 : H1) + (size_t)(t & (TH - 1)) * D) + F.lane;
#pragma unroll
        for (int j = 0; j < 4; ++j) { const f32x4 y = (v[j] * rstd) * gs[j] + sh[j]; u32x2 w; w.x = cvt_pk_bf16(y.x, y.y); w.y = cvt_pk_bf16(y.z, y.w);
            o8[64 * j] = w; }
#pragma unroll
        for (int j = 0; j < 4; ++j) v[j] = vn[j];
    }
}

__device__ __forceinline__ void p3_mix(Frame& F, int hf) {
    F.lane = lane_now(); F.tid = F.wave * 64 + F.lane;
    MixArgs A; A.proj = (const bf16_t*)(F.ws + WS_PROJ); A.act = (bf16_t*)(F.ws + WS_ACT); A.diff_norm = F.diff_norm; A.ssq = (float*)(F.ws + WS_SSQ);
    A.lam = __uint_as_float(__builtin_amdgcn_readfirstlane(*(const unsigned*)(F.ws + WS_MOD + 256 * 1024)));
    unsigned* qbase = (unsigned*)(F.ws + WS_CTL) + CW_Q + 64 * 16 + 64 * 8 * hf;
    volatile LAS int* bc = (volatile LAS int*)(F.lds + LDSCTL_OFF + 64);
    { LAS float* dnl = (LAS float*)(F.lds + LDSCTL_OFF + 12288);
      if (F.tid < 64) *(LAS f32x4*)(dnl + 4 * F.tid) = *(const f32x4*)(F.diff_norm + 4 * F.tid); }
    const int x0 = (int)(xb_xcc_id() & 7u);
    int curk = 0; bool havepre = false;
    for (;;) {
        __syncthreads();
        if (F.wave == 0) {
            const int lane = lane_now();
            int u = -1, xq = (x0 + curk) & 7;
            for (int it = 0; it < 64; ++it) {
                int got = -1;
                if (havepre) got = bc[2];
                else if (lane == 0) got = (int)__hip_atomic_fetch_add(qbase + 64 * xq, 1u, __ATOMIC_RELAXED, __HIP_MEMORY_SCOPE_AGENT);
                havepre = false;
                got = __builtin_amdgcn_readfirstlane(got);
                if (got < 4 + 64) { u = got; break; }
                unsigned c = 4u + 64u;
                if (lane < 8) c = __hip_atomic_load(qbase + 64 * ((x0 + lane) & 7), __ATOMIC_RELAXED, __HIP_MEMORY_SCOPE_AGENT);
                const unsigned long long m = __builtin_amdgcn_ballot_w64(lane < 8 && c < 4u + 64u);
                if (m == 0ull) break;
                xq = (x0 + (int)__builtin_ctzll(m)) & 7;
            }
            curk = (xq - x0) & 7;
            if (lane == 0) { bc[0] = u; bc[1] = xq; }
        }
        __syncthreads();
        const int u = __builtin_amdgcn_readfirstlane(bc[0]), xq = __builtin_amdgcn_readfirstlane(bc[1]);
        if (u < 0) break;
#ifndef MIX_NO_RET
        if (u < 4) { const int bh = 2 * xq + (u >> 1); ret_unit(F.lds, F.wave, A, bh >> 2, bh & 3, u & 1); }
#endif
#ifndef MIX_NO_ATTN
        if (u >= 4) { const int v = u - 4, qb = 31 - (v >> 1), bh = 2 * xq + (v & 1);
            int pre = 0;
            if (F.wave == 0 && lane_now() == 0) pre = (int)__hip_atomic_fetch_add(qbase + 64 * xq, 1u, __ATOMIC_RELAXED, __HIP_MEMORY_SCOPE_AGENT);
            attn_unit(F.lds, F.wave, A, bh >> 2, bh & 3, qb, pre, bc + 2);
            havepre = true; }
#endif
    }
    convert_experts(F);
}

typedef float f32x4v __attribute__((ext_vector_type(4)));
__device__ __forceinline__ void p6_router(Frame& F, bool dummy) {
    F.lane = lane_now(); F.tid = F.wave * 64 + F.lane;
    const float* mod = (const float*)(F.ws + WS_MOD); const bf16_t* rth = (const bf16_t*)(F.ws + WS_MOD + 512 * 1024); const bf16_t* rtl = rth + 48 * D;
    unsigned char* H2 = F.ws + WS_H2; const float* x1 = F.x;
    const size_t rbase = dummy ? WS_EACT : WS_ROUT;
    int* tok_e = (int*)(F.ws + rbase); float* tok_w = (float*)(F.ws + rbase + 256 * 1024); int* tok_slot = (int*)(F.ws + rbase + 512 * 1024); int* list = (int*)(F.ws + rbase + 1024 * 1024);
    unsigned* cnt = (unsigned*)(F.ws + WS_CTL) + CW_CNT + (dummy ? 64 : 0);
    LAS int* hist = (LAS int*)(F.lds + LDSCTL_OFF + 256);
    constexpr int RSTR = 4112;
    LAS unsigned char* Xt = F.lds;
    LAS float* part = (LAS float*)(F.lds + 65792);
    LAS float* lgt = (LAS float*)(F.lds + 65792 + 24576);
    unsigned* ghist = (unsigned*)(F.ws + rbase + 768 * 1024);
    for (int tb = blockIdx.x; tb < T / 128; tb += F.G) {
        if (F.tid < 64) hist[F.tid] = 0;
        bf16x8 bwh[4][3], bwl[4][3];
        { const int ln = launder_i(F.lane), r = ln & 15, kq = ln >> 4, k0 = 128 * F.wave + 8 * kq;
#pragma unroll
          for (int g = 0; g < 4; ++g)
#pragma unroll
              for (int nb = 0; nb < 3; ++nb) { const unsigned wi = (unsigned)((16 * nb + r) * D + k0 + 32 * g); bwh[g][nb] = *(const bf16x8*)(rth + wi); bwl[g][nb] = *(const bf16x8*)(rtl + wi); } }
        f32x4 v[2][4]; u32x2 dv[2][4];
        const unsigned char* dbase = F.ws + delta_off(tb * 128);
#pragma unroll
        for (int q = 0; q < 2; ++q) { const f32x4* xr = (const f32x4*)(x1 + (size_t)(tb * 128 + 2 * F.wave + q) * D) + F.lane; const u32x2* dr = (const u32x2*)(dbase + (size_t)(2 * F.wave + q) * 2048) + F.lane;
#pragma unroll
            for (int j = 0; j < 4; ++j) { v[q][j] = xr[64 * j]; dv[q][j] = dr[64 * j]; } }
        LAS f32x4* gsl = (LAS f32x4*)(F.lds + 114944);
        if (F.wave == 0) { const int b = (tb * 128) >> 12;
#pragma unroll
          for (int j = 0; j < 4; ++j) { const int col = 4 * F.lane + 256 * j;
              const f32x4 g = *(const f32x4*)(F.norm_ffn + col), sc = *(const f32x4*)(mod + (size_t)b * 6144 + 4096 + col), sh = *(const f32x4*)(mod + (size_t)b * 6144 + 3072 + col);
              gsl[F.lane + 64 * j] = g * (sc + 1.0f); gsl[256 + F.lane + 64 * j] = sh; } }
        __syncthreads();
        for (int ps = 0; ps < 8; ++ps) {
#pragma unroll
            for (int q = 0; q < 2; ++q) {
                const int tk = 2 * F.wave + q, t = tb * 128 + ps * 16 + tk;
#pragma unroll
                for (int j = 0; j < 4; ++j) { const u32x2 d = dv[q][j]; v[q][j].x += bf_lo(d.x); v[q][j].y += bf_hi(d.x); v[q][j].z += bf_lo(d.y); v[q][j].w += bf_hi(d.y); }
                float s = 0.f;
#pragma unroll
                for (int j = 0; j < 4; ++j) s += (v[q][j].x * v[q][j].x + v[q][j].y * v[q][j].y) + (v[q][j].z * v[q][j].z + v[q][j].w * v[q][j].w);
                const float rstd = 1.0f / sqrtf(wave_sum(s) * (1.0f / D) + EPS);
                unsigned* o4 = (unsigned*)(H2 + (size_t)t * D) + F.lane;
#pragma unroll
                for (int j = 0; j < 4; ++j) {
                    const int col = 4 * F.lane + 256 * j;
                    const f32x4 y = (v[q][j] * rstd) * gsl[F.lane + 64 * j] + gsl[256 + F.lane + 64 * j];
                    o4[64 * j] = pk4_fp8(y.x, y.y, y.z, y.w);
                    *(LAS f32x4*)(Xt + tk * RSTR + col * 4) = y;
                }
            }
            if (ps + 1 < 8) {
#pragma unroll
                for (int q = 0; q < 2; ++q) { const f32x4* xr = (const f32x4*)(x1 + (size_t)(tb * 128 + (ps + 1) * 16 + 2 * F.wave + q) * D) + F.lane; const u32x2* dr = (const u32x2*)(dbase + (size_t)((ps + 1) * 16 + 2 * F.wave + q) * 2048) + F.lane;
#pragma unroll
                    for (int j = 0; j < 4; ++j) { v[q][j] = xr[64 * j]; dv[q][j] = dr[64 * j]; } }
            }
            __syncthreads();
            {
                const int r = F.lane & 15, kq = F.lane >> 4, k0 = 128 * F.wave + 8 * kq;
                f32x4v acc[3];
#pragma unroll
                for (int nb = 0; nb < 3; ++nb) acc[nb] = (f32x4v){0.f, 0.f, 0.f, 0.f};
#pragma unroll
                for (int g = 0; g < 4; ++g) {
                    const f32x4 a0 = *(const LAS f32x4*)(Xt + r * RSTR + (k0 + 32 * g) * 4), a1 = *(const LAS f32x4*)(Xt + r * RSTR + (k0 + 32 * g + 4) * 4);
                    unsigned hp[4], lp[4];
#pragma unroll
                    for (int q = 0; q < 4; ++q) { const float x0 = (q < 2) ? a0[2 * q] : a1[2 * q - 4], x1 = (q < 2) ? a0[2 * q + 1] : a1[2 * q - 3];
                        hp[q] = cvt_pk_bf16(x0, x1); lp[q] = cvt_pk_bf16(x0 - bf_lo(hp[q]), x1 - bf_hi(hp[q])); }
                    const bf16x8 ah = __builtin_bit_cast(bf16x8, (u32x4){hp[0], hp[1], hp[2], hp[3]}), al = __builtin_bit_cast(bf16x8, (u32x4){lp[0], lp[1], lp[2], lp[3]});
#pragma unroll
                    for (int nb = 0; nb < 3; ++nb) {
                        acc[nb] = __builtin_amdgcn_mfma_f32_16x16x32_bf16(ah, bwh[g][nb], acc[nb], 0, 0, 0);
                        acc[nb] = __builtin_amdgcn_mfma_f32_16x16x32_bf16(ah, bwl[g][nb], acc[nb], 0, 0, 0);
                        acc[nb] = __builtin_amdgcn_mfma_f32_16x16x32_bf16(al, bwh[g][nb], acc[nb], 0, 0, 0);
                    }
                }
#pragma unroll
                for (int nb = 0; nb < 3; ++nb)
#pragma unroll
                    for (int e = 0; e < 4; ++e) part[(F.wave * 16 + 4 * kq + e) * 48 + 16 * nb + r] = acc[nb][e];
            }
            __syncthreads();
            for (int idx = F.tid; idx < 16 * 36; idx += NTHR) { const int tk = idx / 36, o = idx - tk * 36; float s = 0.f;
#pragma unroll
                for (int w = 0; w < 8; ++w) s += part[(w * 16 + tk) * 48 + o];
                lgt[(ps * 16 + tk) * 48 + o] = s; }
        }
        __syncthreads();
        if (F.tid < 128) {
            const int t = tb * 128 + F.tid;
            float lg[36];
#pragma unroll
            for (int o = 0; o < 36; ++o) lg[o] = lgt[F.tid * 48 + o];
            float gl[4];
#pragma unroll
            for (int g = 0; g < 4; ++g) gl[g] = lg[g] + F.b_rg[g];
            int gs = 0; float gm = gl[0];
#pragma unroll
            for (int g = 1; g < 4; ++g) if (gl[g] > gm) { gm = gl[g]; gs = g; }
            float gden = 0.f;
#pragma unroll
            for (int g = 0; g < 4; ++g) gden += __expf(gl[g] - gm);
            const float gtop = 1.0f / gden;
            float el[8];
#pragma unroll
            for (int j = 0; j < 8; ++j) {
                const float v0 = lg[4 + j], v1 = lg[12 + j], v2 = lg[20 + j], v3 = lg[28 + j];
                el[j] = ((gs == 0) ? v0 : (gs == 1) ? v1 : (gs == 2) ? v2 : v3) + F.b_re[gs * 8 + j];
            }
            int e1 = 0; float m1 = el[0];
#pragma unroll
            for (int j = 1; j < 8; ++j) if (el[j] > m1) { m1 = el[j]; e1 = j; }
            int e2 = -1; float m2 = -INFINITY;
#pragma unroll
            for (int j = 0; j < 8; ++j) if (j != e1 && el[j] > m2) { m2 = el[j]; e2 = j; }
            const float w1 = 1.0f / (1.0f + __expf(m2 - m1)), w2 = 1.0f - w1;
            const int ea = gs * 8 + e1, eb = gs * 8 + e2;
            tok_e[2 * t] = ea; tok_e[2 * t + 1] = eb; tok_w[2 * t] = gtop * w1; tok_w[2 * t + 1] = gtop * w2;
            tok_slot[2 * t] = __hip_atomic_fetch_add(&hist[ea], 1, __ATOMIC_RELAXED, __HIP_MEMORY_SCOPE_WORKGROUP); tok_slot[2 * t + 1] = __hip_atomic_fetch_add(&hist[eb], 1, __ATOMIC_RELAXED, __HIP_MEMORY_SCOPE_WORKGROUP);
        }
        __syncthreads();
        if (F.tid < 32) ghist[tb * 32 + F.tid] = (unsigned)hist[F.tid];
        __syncthreads();
    }
}
__device__ __forceinline__ void p6b_lists(Frame& F) {
    F.lane = lane_now(); F.tid = F.wave * 64 + F.lane;
    const int* tok_e = (const int*)(F.ws + WS_ROUT); int* tok_slot = (int*)(F.ws + WS_ROUT + 512 * 1024); int* list = (int*)(F.ws + WS_ROUT + 1024 * 1024);
    const unsigned* ghist = (const unsigned*)(F.ws + WS_ROUT + 768 * 1024);
    unsigned* cnt = (unsigned*)(F.ws + WS_CTL) + CW_CNT;
    LAS int* red = (LAS int*)(F.lds + LDSCTL_OFF + 256);
    for (int tb = blockIdx.x; tb < T / 128; tb += F.G) {
        __syncthreads();
        { const int e = F.tid & 31, pt = F.tid >> 5; int s = 0, tot = 0;
          int cv[T / 128 / 16];
#pragma unroll
          for (int q = 0; q < T / 128 / 16; ++q) cv[q] = (int)ghist[(pt + 16 * q) * 32 + e];
#pragma unroll
          for (int q = 0; q < T / 128 / 16; ++q) { tot += cv[q]; if (pt + 16 * q < tb) s += cv[q]; }
          red[pt * 32 + e] = s; red[1024 + pt * 32 + e] = tot; }
        __syncthreads();
        if (F.tid < 32) { int s = 0, tot = 0;
#pragma unroll
            for (int pt = 0; pt < 16; ++pt) { s += red[pt * 32 + F.tid]; tot += red[1024 + pt * 32 + F.tid]; }
            red[512 + F.tid] = s; if (tb == 0) cnt[F.tid] = (unsigned)tot; }
        __syncthreads();
        if (F.tid < 256) {
            const int a = tb * 256 + F.tid, e = tok_e[a], slot = red[512 + e] + tok_slot[a];
            tok_slot[a] = slot; list[(size_t)e * T + slot] = a;
        }
    }
}

__device__ __forceinline__ void moe_table(Frame& F, LAS int* rbs) {
    F.lane = lane_now(); F.tid = F.wave * 64 + F.lane;
    const unsigned* cnt = (const unsigned*)(F.ws + WS_CTL) + CW_CNT;
    if (F.wave == 0) {
        const int e = F.lane;
        int c = 0;
        if (e < NEXP) { c = (int)__hip_atomic_load(cnt + e, __ATOMIC_RELAXED, __HIP_MEMORY_SCOPE_AGENT); rbs[64 + e] = c; }
        asm volatile("s_waitcnt lgkmcnt(0)" ::: "memory");
        if (e < NEXP) {
            int a = 0;
            for (int j = 0; j < e; ++j) a += (rbs[64 + j] + 255) >> 8;
            const int nb = (c + 255) >> 8;
            rbs[e] = a;
            for (int q = 0; q < nb; ++q) rbs[128 + a + q] = e;
            if (e == NEXP - 1) rbs[32] = a + nb;
        }
    }
    __syncthreads();
}

__device__ __forceinline__ void p9_final(Frame& F, const LAS int* rbs, bool dummy) {
    F.lane = lane_now(); F.tid = F.wave * 64 + F.lane;
    const float* mod = (const float*)(F.ws + WS_MOD); const unsigned char* Y = F.ws + WS_Y;
    const float* X = F.x;
    const int* tok_e = (const int*)(F.ws + WS_ROUT); const int* tok_slot = (const int*)(F.ws + WS_ROUT + 512 * 1024);
    const int gw = launder_s(F.vcu * NWAVES + F.wave), NGW = F.G * NWAVES;
    f32x4 ng[4];
#pragma unroll
    for (int j = 0; j < 4; ++j) ng[j] = *(const f32x4*)(F.norm_final + 4 * F.lane + 256 * j);
    f32x4 xv[4], xn[4]; unsigned ya[4], yb[4], yan[4], ybn[4]; u32x2 da[4], dn[4];
    int e0n = 0, e1n = 0, s0n = 0, s1n = 0;
    if (gw < T) {
        const int p0 = rbs[tok_e[2 * gw]] * 256 + tok_slot[2 * gw], p1 = rbs[tok_e[2 * gw + 1]] * 256 + tok_slot[2 * gw + 1];
        const f32x4* xr = (const f32x4*)(X + (size_t)gw * D) + F.lane; const unsigned* y0 = (const unsigned*)(Y + (size_t)p0 * D) + F.lane; const unsigned* y1 = (const unsigned*)(Y + (size_t)p1 * D) + F.lane;
        const u32x2* dr = (const u32x2*)(F.ws + delta_off(gw)) + F.lane;
#pragma unroll
        for (int j = 0; j < 4; ++j) { xv[j] = xr[64 * j]; ya[j] = y0[64 * j]; yb[j] = y1[64 * j]; da[j] = dr[64 * j]; }
        if (gw + NGW < T) { const int tn = gw + NGW; e0n = tok_e[2 * tn]; e1n = tok_e[2 * tn + 1]; s0n = tok_slot[2 * tn]; s1n = tok_slot[2 * tn + 1]; }
    }
    for (int t = gw; t < T; t += NGW) {
        const int b = t >> 12;
        f32x4 g2[4];
#pragma unroll
        for (int j = 0; j < 4; ++j) g2[j] = *(const f32x4*)(mod + (size_t)b * 6144 + 5120 + 4 * F.lane + 256 * j);
        if (t + NGW < T) {
            const int tn = t + NGW, p0 = rbs[e0n] * 256 + s0n, p1 = rbs[e1n] * 256 + s1n;
            const f32x4* xr = (const f32x4*)(X + (size_t)tn * D) + F.lane; const unsigned* y0 = (const unsigned*)(Y + (size_t)p0 * D) + F.lane; const unsigned* y1 = (const unsigned*)(Y + (size_t)p1 * D) + F.lane;
            const u32x2* dr = (const u32x2*)(F.ws + delta_off(tn)) + F.lane;
#pragma unroll
            for (int j = 0; j < 4; ++j) { xn[j] = xr[64 * j]; yan[j] = y0[64 * j]; ybn[j] = y1[64 * j]; dn[j] = dr[64 * j]; }
            if (tn + NGW < T) { const int t2 = tn + NGW; e0n = tok_e[2 * t2]; e1n = tok_e[2 * t2 + 1]; s0n = tok_slot[2 * t2]; s1n = tok_slot[2 * t2 + 1]; }
        }
        f32x4 v[4]; float s = 0.f;
#pragma unroll
        for (int j = 0; j < 4; ++j) {
            const int a = (int)ya[j], c = (int)yb[j];
            const f32x2 a0 = __builtin_amdgcn_cvt_pk_f32_fp8(a, false), a1 = __builtin_amdgcn_cvt_pk_f32_fp8(a, true), c0 = __builtin_amdgcn_cvt_pk_f32_fp8(c, false), c1 = __builtin_amdgcn_cvt_pk_f32_fp8(c, true);
            f32x4 y; y.x = (a0.x + c0.x) * 0.0625f; y.y = (a0.y + c0.y) * 0.0625f; y.z = (a1.x + c1.x) * 0.0625f; y.w = (a1.y + c1.y) * 0.0625f;
            const u32x2 dd = da[j]; const f32x4 dl = {bf_lo(dd.x), bf_hi(dd.x), bf_lo(dd.y), bf_hi(dd.y)};
            v[j] = (xv[j] + dl) + g2[j] * y;
            s += (v[j].x * v[j].x + v[j].y * v[j].y) + (v[j].z * v[j].z + v[j].w * v[j].w);
        }
        const float rstd = 1.0f / sqrtf(wave_sum(s) * (1.0f / D) + EPS);
        f32x4* xo = dummy ? (f32x4*)((float*)(F.ws + WS_H2) + (size_t)t * D) + F.lane : (f32x4*)(F.out + (size_t)t * D) + F.lane;
#pragma unroll
        for (int j = 0; j < 4; ++j) __builtin_nontemporal_store(v[j] * rstd * ng[j], xo + 64 * j);
#pragma unroll
        for (int j = 0; j < 4; ++j) { xv[j] = xn[j]; ya[j] = yan[j]; yb[j] = ybn[j]; da[j] = dn[j]; }
    }
}

constexpr int MOE_MAXU = 8;
__device__ __forceinline__ void moe_unit_tables(Frame& F, const LAS int* rbs, int nunits, bool weights) {
    const int tid = tid_now(F.wave);
    const int* list = (const int*)(F.ws + WS_ROUT + 1024 * 1024); const float* tokw = (const float*)(F.ws + WS_ROUT + 256 * 1024);
    LAS unsigned short* tokl = (LAS unsigned short*)(F.lds + LDSCTL_OFF + 4096); LAS float* wl = (LAS float*)(F.lds + LDSCTL_OFF + 8192);
    int av[MOE_MAXU / 2]; bool live[MOE_MAXU / 2], inr[MOE_MAXU / 2];
#pragma unroll
    for (int q = 0; q < MOE_MAXU / 2; ++q) {
        const int j = 2 * q + (tid >> 8), r = tid & 255, L = j * F.G + F.vcu;
        live[q] = L < nunits; inr[q] = false; av[q] = 0;
        if (live[q]) {
            const int rbi = L >> 2, e = rbs[128 + rbi], sl = (rbi - rbs[e]) * 256 + r, ce = rbs[64 + e];
            inr[q] = sl < ce;
            av[q] = list[(size_t)e * T + (inr[q] ? sl : 0)];
        }
    }
    float wv[MOE_MAXU / 2];
#pragma unroll
    for (int q = 0; q < MOE_MAXU / 2; ++q) wv[q] = (weights && live[q] && inr[q]) ? tokw[av[q]] * 0.5f : 0.f;
#pragma unroll
    for (int q = 0; q < MOE_MAXU / 2; ++q) {
        const int j = 2 * q + (tid >> 8), r = tid & 255;
        if (live[q]) { if (weights) wl[j * 256 + r] = wv[q]; else tokl[j * 256 + r] = (unsigned short)(av[q] >> 1); }
    }
    __syncthreads();
}

constexpr int N_PHASES = 16;
template <unsigned PHM>
__global__ void __launch_bounds__(NTHR, 2) fwd(Args args) {
    extern __shared__ __attribute__((aligned(16))) unsigned char lds_raw[];
    Frame F;
    F.lds = (LAS unsigned char*)lds_raw;
    F.tid = threadIdx.x; F.lane = F.tid & 63; F.wave = __builtin_amdgcn_readfirstlane(F.tid >> 6);
    F.G = gridDim.x; { const int bx = blockIdx.x; F.vcu = (F.G % 8 == 0) ? (bx % 8) * (F.G / 8) + bx / 8 : bx; }
    F.x = (const float*)args.in[0]; F.c = (const float*)args.in[1]; F.positions = (const int*)args.in[2]; F.w_ada = (const float*)args.in[3]; F.b_ada = (const float*)args.in[4];
    F.norm_mix = (const float*)args.in[5]; F.w_in = (const float*)args.in[6]; F.w_ret_o = (const float*)args.in[7]; F.w_diff_o = (const float*)args.in[8];
    F.lq1 = (const float*)args.in[9]; F.lk1 = (const float*)args.in[10]; F.lq2 = (const float*)args.in[11]; F.lk2 = (const float*)args.in[12]; F.diff_norm = (const float*)args.in[13];
    F.w_out = (const float*)args.in[14]; F.norm_ffn = (const float*)args.in[15]; F.w_rg = (const float*)args.in[16]; F.b_rg = (const float*)args.in[17]; F.w_re = (const float*)args.in[18]; F.b_re = (const float*)args.in[19];
    F.w_eg = (const float*)args.in[20]; F.w_eu = (const float*)args.in[21]; F.w_ed = (const float*)args.in[22]; F.norm_final = (const float*)args.in[23];
    F.out = args.out; F.ws = args.ws;
    for (int u = F.tid; u < (LDS_BYTES - LDSCTL_OFF) / 4; u += NTHR) ((LAS unsigned*)(F.lds + LDSCTL_OFF))[u] = 0u;
    __syncthreads();
    const int lo = args.ph_lo, hi = args.ph_hi;
    const bool use_bar = (hi - lo) > 1;
    XcdBarrier bar; bar.bar = (unsigned*)(F.ws + WS_CTL) + CW_BAR; bar.x = 0; bar.st = (volatile LAS unsigned*)(F.lds + LDSCTL_OFF);
    if (use_bar) bar = xcd_barrier_post((unsigned*)(F.ws + WS_CTL) + CW_BAR, (volatile LAS unsigned*)(F.lds + LDSCTL_OFF));
    bar.wave = F.wave;
#ifndef PROBE_DUP
#define PROBE_DUP 0u
#endif
#ifndef PROBE_MODE
#define PROBE_MODE 0
#endif
#define NREP(ty) ((((PROBE_DUP) >> (ty)) & 1u) ? 2 : 1)
#define INP(ty, k) ((((PHM) >> (ty)) & 1u) && lo <= (k) && (k) < hi)
#define INPL(ty, k) ((((PHM) >> (ty)) & 1u) && launder_s(lo) <= (k) && (k) < launder_s(hi))
#define IN(k) (lo <= (k) && (k) < hi)
#define SEAM(k) do { if (IN(k) && IN((k) + 1)) xcd_barrier(bar); } while (0)
    LAS int* rbs = (LAS int*)(F.lds + LDSCTL_OFF + 1024);

    if (INP(0, 0)) { for (int rep = 0; rep < NREP(0); ++rep) p0_prologue(F); SEAM(0); }
    for (int hf = 0; hf < 2; ++hf) {
        const int pb = 1 + 5 * hf;
        if (INP(1, pb) && hf == 0) { for (int rep = 0; rep < NREP(1); ++rep) p1_norm_mod(F); SEAM(pb); }
        if (INP(2, pb + 1)) {
            pg8::StaticOrder S; S.init(hf ? (const void*)(F.out + (size_t)TH * D) : (const void*)(F.ws + WS_H), F.ws + WS_WIN, TH, DIN, D, F.G, (int)blockIdx.x);
            pg8::EpiProj E{(bf16_t*)(F.ws + WS_PROJ), (const float*)(F.ws + WS_COS) + (size_t)hf * TH * 64, (const float*)(F.ws + WS_SIN) + (size_t)hf * TH * 64, 0};
            for (int rep = 0; rep < NREP(2); ++rep) { E.pmode = (rep + 1 < NREP(2)) ? PROBE_MODE : 0; pg8::gemm_phase<pg8::EpiProj, pg8::StaticOrder, true, false>(F.lds, F.wave, D, S, E); }
            SEAM(pb + 1);
        }
        if (INP(3, pb + 2)) { for (int rep = 0; rep < NREP(3); ++rep) p3_mix(F, hf + 2 * rep); SEAM(pb + 2); }
        if (INP(4, pb + 3)) {
            pg8::StaticOrder S; S.init(F.ws + WS_ACT, F.ws + WS_WMIX, TH, D, 2048, F.G, (int)blockIdx.x);
            LAS float* rst = (LAS float*)(F.lds + LDSCTL_OFF + 8192);
            for (int ui = 0; ; ++ui) {
                pg8::Unit u0; if (!S.next(ui, u0)) break;
                const int tl = tid_now(F.wave);
                { const float* sq = (const float*)(F.ws + WS_SSQ);
                  if (tl < 256) { float r[4];
#pragma unroll
                    for (int hd = 0; hd < 4; ++hd) { const f32x4* p = (const f32x4*)(sq + ((size_t)(u0.pm * 256 + tl) * 4 + hd) * 8); const f32x4 a = p[0], b = p[1];
                        r[hd] = 1.0f / sqrtf((((a.x + a.y) + (a.z + a.w)) + ((b.x + b.y) + (b.z + b.w))) * (1.0f / 256.0f) + EPS); }
                    rst[tl] = r[0] / r[1]; rst[256 + tl] = r[1] / r[2]; rst[512 + tl] = r[2] / r[3]; rst[768 + tl] = r[3]; } }
                __syncthreads();
                pg8::EpiMerged E{(const bf16_t*)(F.ws + WS_PROJ), (bf16_t*)(F.ws + WS_H), (const LAS float*)rst};
                pg8::OneUnit<pg8::StaticOrder> S1{S, ui};
                for (int rep = 0; rep < NREP(4); ++rep) pg8::gemm_phase<pg8::EpiMerged, pg8::OneUnit<pg8::StaticOrder>, false, false>(F.lds, F.wave, 2048, S1, E);
                __syncthreads();
            }
            SEAM(pb + 3);
        }
        if (INP(5, pb + 4)) {
            pg8::StaticOrder S; S.init(F.ws + WS_H, F.ws + WS_WOUT, TH, D, D, F.G, (int)blockIdx.x);
            pg8::EpiWout E{F.ws, (const float*)(F.ws + WS_MOD), hf * TH};
            for (int rep = 0; rep < NREP(5); ++rep) pg8::gemm_phase<pg8::EpiWout, pg8::StaticOrder, false, false>(F.lds, F.wave, D, S, E);
            if (hf == 1) SEAM(pb + 4);
        }
    }
    if (INPL(6, 11)) { for (int rep = 0; rep < NREP(6); ++rep) p6_router(F, rep + 1 < NREP(6)); SEAM(11); }
    if (INPL(10, 12)) { convert_experts(F); p6b_lists(F); SEAM(12); }
    if (INPL(7, 13)) {
        moe_table(F, rbs);
        const int nunits = __builtin_amdgcn_readfirstlane(rbs[32]) * 4;
        moe_unit_tables(F, rbs, nunits, false);
        pg8::MoeOrder S{F.G, F.vcu, 512, nunits, 1, rbs, (const LAS unsigned short*)(F.lds + LDSCTL_OFF + 4096), (const char*)(F.ws + WS_H2), (const char*)(F.ws + WS_WGU), (size_t)1024 * 1024};
        pg8::EpiGU E{F.ws + WS_EACT};
        for (int rep = 0; rep < NREP(7); ++rep) pg8::gemm_phase<pg8::EpiGU, pg8::MoeOrder, true, true, true>(F.lds, F.wave, launder_s(512), S, E);
        SEAM(13);
    }
    if (INPL(8, 14)) {
        moe_table(F, rbs);
        const int nunits = __builtin_amdgcn_readfirstlane(rbs[32]) * 4;
        moe_unit_tables(F, rbs, nunits, true);
        pg8::MoeOrder S{F.G, F.vcu, 256, nunits, 0, rbs, (const LAS unsigned short*)(F.lds + LDSCTL_OFF + 4096), (const char*)(F.ws + WS_EACT), (const char*)(F.ws + WS_WDN), (size_t)1024 * 512};
        pg8::EpiDown E{F.ws + WS_Y, (const LAS float*)(F.lds + LDSCTL_OFF + 8192)};
        for (int rep = 0; rep < NREP(8); ++rep) pg8::gemm_phase<pg8::EpiDown, pg8::MoeOrder, true, false, true>(F.lds, F.wave, launder_s(256), S, E);
        SEAM(14);
    }
    if (INPL(9, 15)) { moe_table(F, rbs); for (int rep = 0; rep < NREP(9); ++rep) p9_final(F, rbs, rep + 1 < NREP(9)); }
#undef IN
#undef INP
#undef INPL
#undef SEAM
}

#ifndef MK_ONE_LAUNCH
#define MK_ONE_LAUNCH 1
#endif
#if !MK_ONE_LAUNCH
typedef void (*KernFn)(Args);
static KernFn phase_kernel(int p) {
    const int ty = (p == 0) ? 0 : (p <= 10) ? 1 + (p - 1) % 5 : (p == 11) ? 6 : (p == 12) ? 10 : p - 6;
    switch (ty) {
        case 0: return fwd<1u << 0>; case 1: return fwd<1u << 1>; case 2: return fwd<1u << 2>; case 3: return fwd<1u << 3>; case 4: return fwd<1u << 4>;
        case 5: return fwd<1u << 5>; case 6: return fwd<1u << 6>; case 7: return fwd<1u << 7>; case 8: return fwd<1u << 8>; case 9: return fwd<1u << 9>; default: return fwd<1u << 10>;
    }
}
#endif
extern "C" void kernel_launch(void* const* d_in, const int* in_sizes, int n_in, void* d_out, int out_size, void* d_ws, size_t ws_size, hipStream_t stream) {
    static int grid = 0;
    if (grid == 0) {
        if (n_in != 24 || out_size != T * D || ws_size < WS_END) { fprintf(stderr, "kernel_launch: unexpected problem (n_in %d, out %d, ws %zu < %zu); nothing launched\n", n_in, out_size, ws_size, (size_t)WS_END); grid = -1; return; }
        int dev = 0, cus = 0;
        if (hipGetDevice(&dev) != hipSuccess || hipDeviceGetAttribute(&cus, hipDeviceAttributeMultiprocessorCount, dev) != hipSuccess) { grid = -1; return; }
#if MK_ONE_LAUNCH
        if (hipFuncSetAttribute((const void*)fwd<0x7FFu>, hipFuncAttributeMaxDynamicSharedMemorySize, LDS_BYTES) != hipSuccess) { grid = -1; return; }
#else
        for (int p = 0; p < N_PHASES; ++p)
            if (hipFuncSetAttribute((const void*)phase_kernel(p), hipFuncAttributeMaxDynamicSharedMemorySize, LDS_BYTES) != hipSuccess) { fprintf(stderr, "kernel_launch: hipFuncSetAttribute failed\n"); grid = -1; return; }
#endif
        (void)hipGetLastError();
        grid = cus;
    }
    if (grid < 0) return;
    (void)hipMemsetAsync((char*)d_ws + WS_CTL, 0, CTL_ZERO_BYTES, stream);
    Args a{};
    for (int i = 0; i < 24; ++i) a.in[i] = d_in[i];
    a.out = (float*)d_out; a.ws = (unsigned char*)d_ws;
#if MK_ONE_LAUNCH
    a.ph_lo = 0; a.ph_hi = N_PHASES;
    hipLaunchKernelGGL(fwd<0x7FFu>, dim3(grid), dim3(NTHR), LDS_BYTES, stream, a);
#else
    for (int p = 0; p < N_PHASES; ++p) { a.ph_lo = p; a.ph_hi = p + 1; hipLaunchKernelGGL(phase_kernel(p), dim3(grid), dim3(NTHR), LDS_BYTES, stream, a); }
#endif
}
```

```cpp
#include <hip/hip_runtime.h>
#include <cstdio>
#include <cstdint>

#define GAS __attribute__((address_space(1)))
#define LAS __attribute__((address_space(3)))
typedef unsigned short bf16_t;
typedef short bf16x8 __attribute__((ext_vector_type(8)));
typedef short s16x4 __attribute__((ext_vector_type(4)));
typedef float f32x4 __attribute__((ext_vector_type(4)));
typedef float f32x2 __attribute__((ext_vector_type(2)));
typedef float f32x16 __attribute__((ext_vector_type(16)));
typedef unsigned u32x4 __attribute__((ext_vector_type(4)));
typedef unsigned u32x2 __attribute__((ext_vector_type(2)));

constexpr int T = 32768, D = 1024, SEQ = 4096, NB = 8, DIN = 8192, TH = 16384, NWAVES = 8, NTHR = 512;
constexpr int NEXP = 32, DEXP = 512;
constexpr float EPS = 1e-6f;
constexpr int PROW_MAX = 65536 + NEXP * 256;

constexpr size_t MiB = 1u << 20;
constexpr size_t WS_CTL = 0, CTL_ZERO_BYTES = 64 * 1024;
constexpr size_t WS_MOD = 1 * MiB;
constexpr size_t WS_COS = 2 * MiB, WS_SIN = 10 * MiB;
constexpr size_t WS_WIN = 18 * MiB;
constexpr size_t WS_WMIX = 34 * MiB;
constexpr size_t WS_WOUT = 38 * MiB;
constexpr size_t WS_WGU = 40 * MiB;
constexpr size_t WS_WDN = 104 * MiB;
constexpr size_t WS_H = 136 * MiB;
constexpr size_t WS_ACT = 168 * MiB;
constexpr size_t WS_PROJ = 232 * MiB;
constexpr size_t WS_H2 = 168 * MiB;
constexpr size_t WS_EACT = 232 * MiB;
constexpr size_t WS_Y = 304 * MiB;
constexpr size_t WS_ROUT = 488 * MiB;
constexpr size_t WS_SSQ = 494 * MiB;
constexpr size_t WS_DELTA_A = 72 * MiB, WS_DELTA_B = 120 * MiB, WS_DELTA_C = 496 * MiB;
constexpr size_t WS_END = 512 * MiB;
constexpr int CW_BAR = 0;
constexpr int CW_CNT = 4096;
constexpr int CW_Q = 4224;

constexpr int RING_BYTES = 131072;
constexpr int LDSCTL_OFF = RING_BYTES;
constexpr int LDS_BYTES = 147456;

__device__ __forceinline__ unsigned cvt_pk_bf16(float lo, float hi) { unsigned r; asm("v_cvt_pk_bf16_f32 %0, %1, %2" : "=v"(r) : "v"(lo), "v"(hi)); return r; }
__device__ __forceinline__ unsigned pk4_fp8(float a, float b, float c, float d) {
    a = __builtin_amdgcn_fmed3f(a, -448.f, 448.f); b = __builtin_amdgcn_fmed3f(b, -448.f, 448.f); c = __builtin_amdgcn_fmed3f(c, -448.f, 448.f); d = __builtin_amdgcn_fmed3f(d, -448.f, 448.f);
    int w = __builtin_amdgcn_cvt_pk_fp8_f32(a, b, 0, false); w = __builtin_amdgcn_cvt_pk_fp8_f32(c, d, w, true); return (unsigned)w;
}
__device__ __forceinline__ float bf_lo(unsigned w) { return __uint_as_float(w << 16); }
__device__ __forceinline__ float bf_hi(unsigned w) { return __uint_as_float(w & 0xffff0000u); }
__device__ __forceinline__ float xor32_sum(float v) { const unsigned u = __builtin_bit_cast(unsigned, v); const auto r = __builtin_amdgcn_permlane32_swap(u, u, false, false);
    return __builtin_bit_cast(float, (unsigned)r[0]) + __builtin_bit_cast(float, (unsigned)r[1]); }
__device__ __forceinline__ float xor32_max(float v) { const unsigned u = __builtin_bit_cast(unsigned, v); const auto r = __builtin_amdgcn_permlane32_swap(u, u, false, false);
    return fmaxf(__builtin_bit_cast(float, (unsigned)r[0]), __builtin_bit_cast(float, (unsigned)r[1])); }
template <int O> __device__ __forceinline__ float swz_xor(float v) { return __builtin_bit_cast(float, __builtin_amdgcn_ds_swizzle(__builtin_bit_cast(int, v), 0x1F | (O << 10))); }
__device__ __forceinline__ float wave_sum(float v) { v += swz_xor<1>(v); v += swz_xor<2>(v); v += swz_xor<4>(v); v += swz_xor<8>(v); v += swz_xor<16>(v); return xor32_sum(v); }
__device__ __forceinline__ size_t delta_off(int t) { return (t < 16384) ? WS_DELTA_A + (size_t)t * 2048 : (t < 24576) ? WS_DELTA_B + (size_t)(t - 16384) * 2048 : WS_DELTA_C + (size_t)(t - 24576) * 2048; }
__device__ __forceinline__ float fast_sigmoid(float v) { return __builtin_amdgcn_rcpf(1.0f + __builtin_amdgcn_exp2f(-1.4426950408889634f * v)); }
__device__ __forceinline__ int launder_i(int v) { asm volatile("" : "+v"(v)); return v; }
__device__ __forceinline__ int launder_s(int v) { asm volatile("" : "+s"(v)); return v; }
__device__ __forceinline__ int lane_now() { int l; asm volatile("v_mbcnt_lo_u32_b32 %0, -1, 0\n\tv_mbcnt_hi_u32_b32 %0, -1, %0" : "=v"(l)); return l; }
__device__ __forceinline__ int tid_now(int wave) { return wave * 64 + lane_now(); }
#define LDS_WAIT() asm volatile("s_waitcnt lgkmcnt(0)" ::: "memory")
#define VM_WAIT() asm volatile("s_waitcnt vmcnt(0)" ::: "memory")

#define XB_TMO      128
#define XB_XCNT(j)  (256  + 64 * (j))
#define XB_XSUB(j)  (1280 + 64 * (j))
#define XB_XGEN(j)  (2304 + 64 * (j))
#define XB_TOP      3328
#define XB_TOPGEN   3392
#define XCD_BAR_WORDS 3456
#define XB_SPIN_CAP (1u << 18)
__device__ __forceinline__ unsigned xb_ld(unsigned* p)              { return __hip_atomic_load(p, __ATOMIC_RELAXED, __HIP_MEMORY_SCOPE_AGENT); }
__device__ __forceinline__ unsigned xb_add(unsigned* p, unsigned v) { return __hip_atomic_fetch_add(p, v, __ATOMIC_RELAXED, __HIP_MEMORY_SCOPE_AGENT); }
__device__ __forceinline__ unsigned xb_xcc_id() { return (unsigned)__builtin_amdgcn_s_getreg((3 << 11) | 20) & 0xFu; }
#define XB_SPIN(cond, bar) do { unsigned _sp = 0; while (cond) { __builtin_amdgcn_s_sleep(1); \
    if ((++_sp & 255u) == 0u) { if (xb_ld(&(bar)[XB_TMO])) break; if (_sp > XB_SPIN_CAP) { atomicAdd(&(bar)[XB_TMO], 1u); break; } } } } while (0)
struct XcdBarrier { unsigned* bar; unsigned x; volatile LAS unsigned* st; int wave; };
__device__ __forceinline__ XcdBarrier xcd_barrier_post(unsigned* bar, volatile LAS unsigned* st) {
    XcdBarrier b; b.bar = bar; b.x = xb_xcc_id(); b.st = st; b.wave = 0;
    if (threadIdx.x == 0) (void)xb_add(&bar[XB_XCNT(b.x)], 1u);
    return b;
}
__device__ __forceinline__ void xcd_barrier_complete(unsigned* bar, unsigned x, unsigned& nloc, unsigned& nx) {
    const unsigned G = gridDim.x * gridDim.y * gridDim.z;
    unsigned sum, cnt, mine, sp = 0u;
    for (;;) {
        sum = 0u; cnt = 0u; mine = 0u;
#pragma unroll
        for (unsigned j = 0; j < 16; ++j) { const unsigned c = xb_ld(&bar[XB_XCNT(j)]); sum += c; cnt += (c > 0u) ? 1u : 0u; mine = (j == x) ? c : mine; }
        if (sum == G) break;
        __builtin_amdgcn_s_sleep(1);
        if ((++sp & 255u) == 0u) { if (xb_ld(&bar[XB_TMO])) break; if (sp > XB_SPIN_CAP) { atomicAdd(&bar[XB_TMO], 1u); break; } }
    }
    nloc = mine > 0u ? mine : 1u; nx = cnt > 0u ? cnt : 1u;
}
__device__ __forceinline__ void xcd_barrier(const XcdBarrier& b) {
    asm volatile("s_waitcnt vmcnt(0)" ::: "memory");
    __syncthreads();
    if (b.wave == 0 && lane_now() == 0) {
        unsigned* bar = b.bar;
        __builtin_amdgcn_s_waitcnt(0);
        unsigned nloc = b.st[0], nx = b.st[1];
        if (nloc == 0u) { xcd_barrier_complete(bar, b.x, nloc, nx); b.st[0] = nloc; b.st[1] = nx; }
        const unsigned old = xb_add(&bar[XB_XSUB(b.x)], 1u);
        const unsigned gen = old / nloc;
        if (old + 1u == (gen + 1u) * nloc) {
            __builtin_amdgcn_fence(__ATOMIC_RELEASE, "agent");
            asm volatile("s_waitcnt vmcnt(0)" ::: "memory");
            const unsigned og = xb_add(&bar[XB_TOP], 1u);
            const unsigned tg = og / nx;
            if (og + 1u == (tg + 1u) * nx) xb_add(&bar[XB_TOPGEN], 1u);
            else XB_SPIN(xb_ld(&bar[XB_TOPGEN]) == tg, bar);
            __builtin_amdgcn_fence(__ATOMIC_ACQUIRE, "agent");
            xb_add(&bar[XB_XGEN(b.x)], 1u);
            asm volatile("s_waitcnt vmcnt(0)" ::: "memory");
        } else {
            XB_SPIN(xb_ld(&bar[XB_XGEN(b.x)]) == gen, bar);
            __builtin_amdgcn_fence(__ATOMIC_ACQUIRE, "agent");
            asm volatile("s_waitcnt vmcnt(0)" ::: "memory");
        }
    }
    __syncthreads();
}

namespace pg8 {
constexpr int BM = 256, BK = 64, HALF = 128, HTB = HALF * BK * 2, STAGE_BYTES = 8 * HTB, NXCD = 8, WGM = 8;
__host__ __device__ __forceinline__ int lds_byte(int r, int c) { const int st = (r >> 4) * 2 + (c >> 5), rr = r & 15, cc = c & 31, ob = rr * 64 + cc * 2; return st * 1024 + (ob ^ (((ob >> 9) & 1) << 5)); }
__host__ __device__ __forceinline__ void stage_rc(int b, int& R, int& C) { const int st = b / 1024, sb = b % 1024, swz = sb ^ (((sb >> 9) & 1) << 5); R = (st >> 1) * 16 + swz / 64; C = (st & 1) * 32 + (swz % 64) / 2; }
__host__ __device__ __forceinline__ int perm32(int rho) { const int n = rho >> 4, i = rho & 15; return 8 * (i >> 2) + 4 * n + (i & 3); }

struct Unit { int pm, pn, e, rb, idx; const char* A; const char* B; };

struct StaticOrder {
    int nM, nN, nwg, G, c, K; const char* A; const char* Bt;
    __device__ __forceinline__ void init(const void* A_, const void* Bt_, int M, int N, int K_, int G_, int c_) { A = (const char*)A_; Bt = (const char*)Bt_; K = K_; nM = M / BM; nN = N / BM; nwg = nM * nN; G = G_; c = c_; }
    __device__ __forceinline__ bool next(int i, Unit& u) const {
        const int L = i * G + c; if (L >= nwg) return false;
        int wgid = L; { const int q = nwg / NXCD, r = nwg % NXCD, xcd = wgid % NXCD, off = wgid / NXCD; wgid = (xcd < r ? xcd * (q + 1) : r * (q + 1) + (xcd - r) * q) + off; }
        const int nig = WGM * nN, gid = wgid / nig, fm = gid * WGM, gsz = (nM - fm) < WGM ? (nM - fm) : WGM;
        u.pm = fm + ((wgid % nig) % gsz); u.pn = (wgid % nig) / gsz; u.e = 0; u.rb = 0; u.idx = i;
        u.A = A + (size_t)u.pm * BM * K * 2; u.B = Bt + (size_t)u.pn * BM * K * 2; return true;
    }
    __device__ __forceinline__ int tok(const Unit&, int) const { return 0; }
};
template <class Sched> struct OneUnit {
    const Sched& S; int i;
    __device__ __forceinline__ bool next(int j, Unit& u) const { return j == 0 ? S.next(i, u) : false; }
    __device__ __forceinline__ int tok(const Unit& u, int r) const { return S.tok(u, r); }
};
struct MoeOrder {
    int G, vcu, K, nunits, gather; const LAS int* rbs; const LAS unsigned short* tokl; const char* A; const char* Bt; size_t bstride;
    __device__ __forceinline__ bool next(int i, Unit& u) const {
        const int L = i * G + vcu; if (L >= nunits) return false;
        const int rbi = L >> 2; const int e = __builtin_amdgcn_readfirstlane(rbs[128 + rbi]);
        u.pm = rbi; u.pn = L & 3; u.e = e; u.rb = rbi - __builtin_amdgcn_readfirstlane(rbs[e]); u.idx = i;
        u.A = gather ? A : A + (size_t)rbi * BM * K * 2; u.B = Bt + (size_t)e * bstride + (size_t)u.pn * BM * K * 2; return true;
    }
    __device__ __forceinline__ int tok(const Unit& u, int r) const { return (int)tokl[u.idx * 256 + r]; }
};

typedef f32x4 Acc[2][2][4][2];
typedef int v8i32 __attribute__((ext_vector_type(8)));
__device__ __forceinline__ v8i32 cat8(const bf16x8& a, const bf16x8& b) { const u32x4 x = __builtin_bit_cast(u32x4, a), y = __builtin_bit_cast(u32x4, b); return (v8i32){(int)x.x, (int)x.y, (int)x.z, (int)x.w, (int)y.x, (int)y.y, (int)y.z, (int)y.w}; }

template <class Epi, class Sched, bool ALIGN_EPI, bool GATHER, bool F8 = false>
__device__ __forceinline__ void gemm_phase(LAS unsigned char* lds, const int wid, const int K, const Sched& S, const Epi& E) {
    const int lane = lane_now(), tid = wid * 64 + lane, wr = wid >> 2, wc = wid & 3, fr = lane & 15, fq = lane >> 4;
    const int nt = K / BK;
    unsigned voffA[2], voffB[2];
#pragma unroll
    for (int i = 0; i < 2; ++i) { int R, C; stage_rc(tid * 16 + i * 8192, R, C); const int Rb = (R & ~31) + perm32(R & 31);
        voffA[i] = GATHER ? (unsigned)(C * 2) : (unsigned)(R * K + C) * 2u; voffB[i] = (unsigned)(Rb * K + C) * 2u; }
    unsigned gAc[2] = {0u, 0u};
    const unsigned K2 = (unsigned)(K * 2);
    const size_t kstep = (size_t)(BK * 2);
    const size_t hstep = (size_t)HALF * K * 2;
    const unsigned ldsw = (unsigned)wid * 1024u;
    const int aoff = lds_byte(wr * 64 + fr, fq * 8), boff = lds_byte(wc * 32 + fr, fq * 8);
    const LAS unsigned char* ldsB = lds + 4 * HTB + boff; asm volatile("" : "+v"(ldsB));
#define PG8_SA(b, h) (((b) * 2 + (h)) * HTB)
#define PG8_SB(b, h) ((4 + (b) * 2 + (h)) * HTB)
#define PG8_STAGEB(bufoff, gbase) do { _Pragma("unroll") for (int _i = 0; _i < 2; ++_i) { asm volatile("" : "+v"(voffB[_i])); \
        __builtin_amdgcn_global_load_lds((const unsigned*)((const char*)(gbase) + voffB[_i]), (LAS unsigned*)(lds + (bufoff) + ldsw + _i * 8192), 16, 0, 0); } } while (0)
#define PG8_STAGEA(bufoff, gbase, h, nx) do { _Pragma("unroll") for (int _i = 0; _i < 2; ++_i) { \
        unsigned _o; if constexpr (GATHER) { unsigned _pk = gAc[h]; asm volatile("" : "+v"(_pk)); _o = __umul24((_pk >> (16 * _i)) & 0xffffu, K2) + voffA[0]; } else { asm volatile("" : "+v"(voffA[_i])); _o = voffA[_i]; } \
        const char* _p = GATHER ? (const char*)(gbase) + _o : (const char*)(gbase) + (h) * hstep + _o; \
        __builtin_amdgcn_global_load_lds((const unsigned*)_p, (LAS unsigned*)(lds + (bufoff) + ldsw + _i * 8192), 16, 0, 0); } } while (0)
#define PG8_LDA(dst, b, h) do { _Pragma("unroll") for (int m = 0; m < 4; ++m) { \
        if constexpr (F8) { const u32x4 x_ = *(const LAS u32x4*)(lds + PG8_SA(b, h) + aoff + m * 2048), y_ = *(const LAS u32x4*)(lds + PG8_SA(b, h) + aoff + m * 2048 + 1024); \
            dst##8[m] = (v8i32){(int)x_.x, (int)x_.y, (int)x_.z, (int)x_.w, (int)y_.x, (int)y_.y, (int)y_.z, (int)y_.w}; } \
        else { _Pragma("unroll") for (int k = 0; k < 2; ++k) dst[m][k] = *(const LAS bf16x8*)(lds + PG8_SA(b, h) + aoff + m * 2048 + k * 1024); } } } while (0)
#define PG8_LDB(dst, b, h) do { _Pragma("unroll") for (int n = 0; n < 2; ++n) { \
        if constexpr (F8) { const u32x4 x_ = *(const LAS u32x4*)(ldsB + (PG8_SB(b, h) - 4 * HTB) + n * 2048), y_ = *(const LAS u32x4*)(ldsB + (PG8_SB(b, h) - 4 * HTB) + n * 2048 + 1024); \
            dst##8[n] = (v8i32){(int)x_.x, (int)x_.y, (int)x_.z, (int)x_.w, (int)y_.x, (int)y_.y, (int)y_.z, (int)y_.w}; } \
        else { _Pragma("unroll") for (int k = 0; k < 2; ++k) dst[n][k] = *(const LAS bf16x8*)(ldsB + (PG8_SB(b, h) - 4 * HTB) + n * 2048 + k * 1024); } } } while (0)
#define PG8_MMA(ai, bj, At, Bt) do { __builtin_amdgcn_s_setprio(1); \
        if constexpr (F8) { _Pragma("unroll") for (int m = 0; m < 4; ++m) _Pragma("unroll") for (int n = 0; n < 2; ++n) \
            acc[ai][bj][m][n] = __builtin_amdgcn_mfma_scale_f32_16x16x128_f8f6f4(Bt##8[n], At##8[m], acc[ai][bj][m][n], 0, 0, 0, 0x7F7F7F7F, 0, 0x7F7F7F7F); } \
        else { _Pragma("unroll") for (int m = 0; m < 4; ++m) _Pragma("unroll") for (int n = 0; n < 2; ++n) _Pragma("unroll") for (int k = 0; k < 2; ++k) \
            acc[ai][bj][m][n] = __builtin_amdgcn_mfma_f32_16x16x32_bf16(Bt[n][k], At[m][k], acc[ai][bj][m][n], 0, 0, 0); } __builtin_amdgcn_s_setprio(0); } while (0)
#define PG8_WAIT_V(n) asm volatile("s_waitcnt vmcnt(" #n ")" ::: "memory")
#define PG8_WAIT_VR() do { if (relax) asm volatile("s_waitcnt vmcnt(24)" ::: "memory"); else asm volatile("s_waitcnt vmcnt(8)" ::: "memory"); } while (0)
#define PG8_WAIT_L(n) asm volatile("s_waitcnt lgkmcnt(" #n ")" ::: "memory")
#define PG8_BAR __builtin_amdgcn_s_barrier()
#define PG8_SCHED __builtin_amdgcn_sched_barrier(0)
    Unit cur, nxt; int ui = 0;
    if (!S.next(0, cur)) return;
    if constexpr (GATHER) {
        int R0, C0; stage_rc(tid * 16, R0, C0);
#pragma unroll
        for (int h = 0; h < 2; ++h) gAc[h] = (unsigned)S.tok(cur, h * HALF + R0) | ((unsigned)S.tok(cur, h * HALF + R0 + 64) << 16);
    }
    Acc acc;
#pragma unroll
    for (int a = 0; a < 2; ++a)
#pragma unroll
        for (int b = 0; b < 2; ++b)
#pragma unroll
            for (int m = 0; m < 4; ++m)
#pragma unroll
                for (int n = 0; n < 2; ++n) acc[a][b][m][n] = (f32x4){0.f, 0.f, 0.f, 0.f};
    bf16x8 At[4][2], B0[2][2], B1[2][2]; v8i32 At8[4], B08[2], B18[2];
    const char* cA = cur.A; const char* cB = cur.B;
    PG8_STAGEB(PG8_SB(0, 0), cB); PG8_STAGEB(PG8_SB(0, 1), cB + hstep); PG8_STAGEA(PG8_SA(0, 0), cA, 0, false); PG8_STAGEA(PG8_SA(0, 1), cA, 1, false);
    if (wr == 1) PG8_BAR;
    PG8_WAIT_V(2); PG8_BAR;
    PG8_STAGEB(PG8_SB(1, 0), cB + kstep); PG8_STAGEA(PG8_SA(1, 0), cA + kstep, 0, false); PG8_STAGEB(PG8_SB(1, 1), cB + hstep + kstep);
    PG8_WAIT_V(6); PG8_BAR;
    for (;;) {
        const bool has_next = S.next(ui + 1, nxt);
        const char* nA = has_next ? nxt.A : cA; const char* nB = has_next ? nxt.B : cB;
        for (int t = 0; t < nt; t += 2) {
            const bool last = (t == nt - 2);
            const bool relax = (Epi::NSTORE == 16) && t == 0 && ui > 0;
            if constexpr (Epi::MID) { if (E.mid_at(t)) { const int l_ = lane_now(); E.mid(acc, cur, t, wr, wc, l_ & 15, l_ >> 4); } }
            const char* a1 = cA + (size_t)(t + 1) * kstep;
            const char* a2 = last ? nA : cA + (size_t)(t + 2) * kstep; const char* b2 = last ? nB : cB + (size_t)(t + 2) * kstep;
            const char* a3 = a2 + kstep; const char* b3 = b2 + kstep;
            PG8_LDB(B0, 0, 0); PG8_LDB(B1, 0, 1); PG8_SCHED; PG8_LDA(At, 0, 0); PG8_STAGEA(PG8_SA(1, 1), a1, 1, false);
            if constexpr (GATHER) { if (last && has_next) {
                int R0, C0; stage_rc((wid * 64 + lane_now()) * 16, R0, C0);
#pragma unroll
                for (int h = 0; h < 2; ++h) gAc[h] = (unsigned)S.tok(nxt, h * HALF + R0) | ((unsigned)S.tok(nxt, h * HALF + R0 + 64) << 16); } }
            PG8_WAIT_VR(); PG8_WAIT_L(0); PG8_BAR; PG8_MMA(0, 0, At, B0); PG8_MMA(0, 1, At, B1); PG8_BAR; PG8_SCHED;
            PG8_LDA(At, 0, 1); PG8_STAGEB(PG8_SB(0, 0), b2); PG8_STAGEB(PG8_SB(0, 1), b2 + hstep); PG8_STAGEA(PG8_SA(0, 0), a2, 0, last);
            PG8_WAIT_VR(); PG8_WAIT_L(0); PG8_BAR; PG8_MMA(1, 0, At, B0); PG8_MMA(1, 1, At, B1); PG8_BAR; PG8_SCHED;
            PG8_LDB(B0, 1, 0); PG8_LDB(B1, 1, 1); PG8_SCHED; PG8_LDA(At, 1, 0); PG8_STAGEA(PG8_SA(0, 1), a2, 1, last);
            PG8_WAIT_V(8); PG8_WAIT_L(0); PG8_BAR; PG8_MMA(0, 0, At, B0); PG8_MMA(0, 1, At, B1); PG8_BAR; PG8_SCHED;
            PG8_LDA(At, 1, 1); PG8_STAGEB(PG8_SB(1, 0), b3); PG8_STAGEB(PG8_SB(1, 1), b3 + hstep); PG8_STAGEA(PG8_SA(1, 0), a3, 0, last);
            PG8_WAIT_V(8); PG8_WAIT_L(0); PG8_BAR; PG8_MMA(1, 0, At, B0); PG8_MMA(1, 1, At, B1); PG8_BAR; PG8_SCHED;
        }
        if constexpr (ALIGN_EPI) { if (wr == 0) PG8_BAR; }
        { const int l_ = lane_now(); E(acc, cur, wr, wc, l_ & 15, l_ >> 4); }
        if (!has_next) break;
#pragma unroll
        for (int a = 0; a < 2; ++a)
#pragma unroll
            for (int b = 0; b < 2; ++b)
#pragma unroll
                for (int m = 0; m < 4; ++m)
#pragma unroll
                    for (int n = 0; n < 2; ++n) acc[a][b][m][n] = (f32x4){0.f, 0.f, 0.f, 0.f};
        cur = nxt; cA = nA; cB = nB; ++ui;
        if constexpr (ALIGN_EPI) { if (wr == 1) PG8_BAR; }
    }
    PG8_WAIT_V(0);
    if constexpr (!ALIGN_EPI) { if (wr == 0) PG8_BAR; }
    PG8_BAR;
#undef PG8_SA
#undef PG8_SB
#undef PG8_STAGEA
#undef PG8_STAGEB
#undef PG8_LDA
#undef PG8_LDB
#undef PG8_MMA
#undef PG8_WAIT_V
#undef PG8_WAIT_VR
#undef PG8_WAIT_L
#undef PG8_BAR
#undef PG8_SCHED
}

__device__ __forceinline__ void store8(bf16_t* p, const f32x4& v0, const f32x4& v1) {
    u32x4 w; w.x = cvt_pk_bf16(v0[0], v0[1]); w.y = cvt_pk_bf16(v0[2], v0[3]); w.z = cvt_pk_bf16(v1[0], v1[1]); w.w = cvt_pk_bf16(v1[2], v1[3]);
    *(u32x4*)p = w;
}
struct EpiProj {
    static constexpr bool MID = false;
    static constexpr int NSTORE = 16;
    bf16_t* O; const float* cosT; const float* sinT; int pmode;
    __device__ __forceinline__ bool mid_at(int) const { return false; }
    __device__ __forceinline__ void mid(Acc&, const Unit&, int, int, int, int, int) const {}
    __device__ __forceinline__ void operator()(Acc& acc, const Unit& u, int wr, int wc, int fr, int fq) const {
        if (pmode == 3) return;
        const int pn = u.pn; fr = launder_i(fr); fq = launder_i(fq);
        const int mode = (pn < 4) ? 1 : (pn < 8) ? 0 : (pn < 12) ? 2 : (pn < 20) ? 1 : (pn < 24) ? 0 : 3;
        const int row0 = u.pm * BM + wr * 64 + fr, col0 = pn * BM + wc * 32 + 8 * fq;
        if (mode == 1) {
            const int q4 = 4 * (4 * wc + fq);
            f32x4 cs[2][4], sn[2][4];
#pragma unroll
            for (int ai = 0; ai < 2; ++ai)
#pragma unroll
                for (int m = 0; m < 4; ++m) { const size_t ro = (size_t)(row0 + ai * HALF + m * 16) * 64 + q4; cs[ai][m] = *(const f32x4*)(cosT + ro); sn[ai][m] = *(const f32x4*)(sinT + ro); }
            asm volatile("" ::: "memory");
#pragma unroll
            for (int ai = 0; ai < 2; ++ai)
#pragma unroll
                for (int m = 0; m < 4; ++m) {
                    bf16_t* rowp = O + (size_t)(row0 + ai * HALF + m * 16) * DIN + col0;
                    const int ic = (wr * 64 + m * 16 + fr) & 127;
#pragma unroll
                    for (int bj = 0; bj < 2; ++bj) {
                        float f = 1.f;
                        if (pn < 4) { const int hd = (2 * pn + bj) & 3; const float lg = __builtin_amdgcn_logf(1.0f - __builtin_amdgcn_exp2f(-5.0f - (float)hd));
                            f = __builtin_amdgcn_exp2f(lg * (pn < 2 ? (float)(ic + 1) : (float)(127 - ic))); }
                        const f32x4 t1 = acc[ai][bj][m][0], t2 = acc[ai][bj][m][1];
                        const f32x4 o1 = (t1 * cs[ai][m] - t2 * sn[ai][m]) * f, o2 = (t2 * cs[ai][m] + t1 * sn[ai][m]) * f;
                        if (pmode != 1) store8(rowp + bj * HALF, o1, o2);
                    }
                }
        } else {
#pragma unroll
            for (int ai = 0; ai < 2; ++ai)
#pragma unroll
                for (int m = 0; m < 4; ++m) {
                    bf16_t* rowp = O + (size_t)(row0 + ai * HALF + m * 16) * DIN + col0;
#pragma unroll
                    for (int bj = 0; bj < 2; ++bj) {
                        f32x4 v0 = acc[ai][bj][m][0], v1 = acc[ai][bj][m][1];
                        if (mode == 2) {
#pragma unroll
                            for (int e = 0; e < 4; ++e) { v0[e] = v0[e] * fast_sigmoid(v0[e]); v1[e] = v1[e] * fast_sigmoid(v1[e]); }
                        } else if (mode == 3) {
#pragma unroll
                            for (int e = 0; e < 4; ++e) { v0[e] = fast_sigmoid(v0[e]); v1[e] = fast_sigmoid(v1[e]); }
                        }
                        if (pmode != 1) store8(rowp + bj * HALF, v0, v1);
                    }
                }
        }
        asm volatile("" ::: "memory");
    }
};
struct EpiMerged {
    static constexpr bool MID = true;
    static constexpr int NSTORE = 0;
    const bf16_t* proj; bf16_t* O; const LAS float* rst;
    __device__ __forceinline__ bool mid_at(int t) const { return t == 4 || t == 8 || t == 12 || t == 16; }
    __device__ __forceinline__ void mid(Acc& acc, const Unit& u, int t, int wr, int wc, int fr, int fq) const {
        fr = launder_i(fr); fq = launder_i(fq);
        const LAS float* rq = (const LAS float*)rst + ((t >> 2) - 1) * 256 + wr * 64 + fr;
#pragma unroll
        for (int ai = 0; ai < 2; ++ai)
#pragma unroll
            for (int m = 0; m < 4; ++m) {
                const float f = rq[ai * HALF + m * 16];
#pragma unroll
                for (int bj = 0; bj < 2; ++bj) { acc[ai][bj][m][0] = acc[ai][bj][m][0] * f; acc[ai][bj][m][1] = acc[ai][bj][m][1] * f; }
            }
        if (t == 16) {
            const int row0 = u.pm * BM + wr * 64 + fr, col0 = u.pn * BM + wc * 32 + 8 * fq;
#pragma unroll
            for (int ai = 0; ai < 2; ++ai) {
                u32x4 g[4][2], d[4][2];
#pragma unroll
                for (int m = 0; m < 4; ++m) { const bf16_t* gp = proj + (size_t)(row0 + ai * HALF + m * 16) * DIN + 6144 + col0;
#pragma unroll
                    for (int bj = 0; bj < 2; ++bj) { g[m][bj] = *(const u32x4*)(gp + bj * HALF); d[m][bj] = *(const u32x4*)(gp + 1024 + bj * HALF); } }
                asm volatile("" ::: "memory");
#pragma unroll
                for (int m = 0; m < 4; ++m)
#pragma unroll
                    for (int bj = 0; bj < 2; ++bj) {
                        const u32x4 gg = g[m][bj], dd = d[m][bj];
                        f32x4 q0, q1;
                        q0[0] = bf_lo(gg.x) * __builtin_amdgcn_rcpf(bf_lo(dd.x)); q0[1] = bf_hi(gg.x) * __builtin_amdgcn_rcpf(bf_hi(dd.x));
                        q0[2] = bf_lo(gg.y) * __builtin_amdgcn_rcpf(bf_lo(dd.y)); q0[3] = bf_hi(gg.y) * __builtin_amdgcn_rcpf(bf_hi(dd.y));
                        q1[0] = bf_lo(gg.z) * __builtin_amdgcn_rcpf(bf_lo(dd.z)); q1[1] = bf_hi(gg.z) * __builtin_amdgcn_rcpf(bf_hi(dd.z));
                        q1[2] = bf_lo(gg.w) * __builtin_amdgcn_rcpf(bf_lo(dd.w)); q1[3] = bf_hi(gg.w) * __builtin_amdgcn_rcpf(bf_hi(dd.w));
                        acc[ai][bj][m][0] = acc[ai][bj][m][0] * q0; acc[ai][bj][m][1] = acc[ai][bj][m][1] * q1;
                    }
                asm volatile("" ::: "memory");
            }
        }
    }
    __device__ __forceinline__ void operator()(Acc& acc, const Unit& u, int wr, int wc, int fr, int fq) const {
        fr = launder_i(fr); fq = launder_i(fq);
        const int row0 = u.pm * BM + wr * 64 + fr, col0 = u.pn * BM + wc * 32 + 8 * fq;
        u32x4 d[2][4][2];
#pragma unroll
        for (int ai = 0; ai < 2; ++ai)
#pragma unroll
            for (int m = 0; m < 4; ++m) { const bf16_t* gp = proj + (size_t)(row0 + ai * HALF + m * 16) * DIN + 7168 + col0;
#pragma unroll
                for (int bj = 0; bj < 2; ++bj) d[ai][m][bj] = *(const u32x4*)(gp + bj * HALF); }
        asm volatile("" ::: "memory");
#pragma unroll
        for (int ai = 0; ai < 2; ++ai)
#pragma unroll
            for (int m = 0; m < 4; ++m) {
                const int row = row0 + ai * HALF + m * 16;
#pragma unroll
                for (int bj = 0; bj < 2; ++bj) {
                    const u32x4 dd = d[ai][m][bj];
                    f32x4 s0, s1; s0[0] = bf_lo(dd.x); s0[1] = bf_hi(dd.x); s0[2] = bf_lo(dd.y); s0[3] = bf_hi(dd.y); s1[0] = bf_lo(dd.z); s1[1] = bf_hi(dd.z); s1[2] = bf_lo(dd.w); s1[3] = bf_hi(dd.w);
                    store8(O + (size_t)row * D + col0 + bj * HALF, acc[ai][bj][m][0] * s0, acc[ai][bj][m][1] * s1);
                }
            }
        asm volatile("" ::: "memory");
    }
};
struct EpiWout {
    static constexpr bool MID = false;
    static constexpr int NSTORE = 0;
    unsigned char* ws; const float* mod; int tbase;
    __device__ __forceinline__ bool mid_at(int) const { return false; }
    __device__ __forceinline__ void mid(Acc&, const Unit&, int, int, int, int, int) const {}
    __device__ __forceinline__ void operator()(Acc& acc, const Unit& u, int wr, int wc, int fr, int fq) const {
        fr = launder_i(fr); fq = launder_i(fq);
        const int row0 = tbase + u.pm * BM + wr * 64 + fr, col0 = u.pn * BM + wc * 32 + 8 * fq;
        const float* g1 = mod + (size_t)(row0 >> 12) * 6144 + 2048 + col0;
        f32x4 g[2][2];
#pragma unroll
        for (int bj = 0; bj < 2; ++bj) { g[bj][0] = *(const f32x4*)(g1 + bj * HALF); g[bj][1] = *(const f32x4*)(g1 + bj * HALF + 4); }
        bf16_t* base = (bf16_t*)(ws + delta_off(tbase + u.pm * BM)) + (size_t)(wr * 64 + fr) * D + col0;
#pragma unroll
        for (int ai = 0; ai < 2; ++ai)
#pragma unroll
            for (int m = 0; m < 4; ++m) {
                bf16_t* rowp = base + (size_t)(ai * HALF + m * 16) * D;
#pragma unroll
                for (int bj = 0; bj < 2; ++bj) store8(rowp + bj * HALF, g[bj][0] * acc[ai][bj][m][0], g[bj][1] * acc[ai][bj][m][1]);
            }
        asm volatile("" ::: "memory");
    }
};
struct EpiGU {
    static constexpr bool MID = false;
    static constexpr int NSTORE = 0;
    unsigned char* act;
    __device__ __forceinline__ bool mid_at(int) const { return false; }
    __device__ __forceinline__ void mid(Acc&, const Unit&, int, int, int, int, int) const {}
    __device__ __forceinline__ void operator()(Acc& acc, const Unit& u, int wr, int wc, int fr, int fq) const {
        fr = launder_i(fr); fq = launder_i(fq);
        const int row0 = u.pm * BM + wr * 64 + fr, col0 = u.pn * 128 + wc * 16 + 4 * fq;
#pragma unroll
        for (int ai = 0; ai < 2; ++ai)
#pragma unroll
            for (int m = 0; m < 4; ++m) {
                unsigned char* rowp = act + (size_t)(row0 + ai * HALF + m * 16) * DEXP + col0;
#pragma unroll
                for (int bj = 0; bj < 2; ++bj) {
                    const f32x4 gt = acc[ai][bj][m][0] * 0.03125f, up = acc[ai][bj][m][1] * 0.03125f; f32x4 a;
#pragma unroll
                    for (int e = 0; e < 4; ++e) a[e] = gt[e] * fast_sigmoid(gt[e]) * up[e];
                    *(unsigned*)(rowp + bj * 64) = pk4_fp8(a[0], a[1], a[2], a[3]);
                }
            }
        asm volatile("" ::: "memory");
    }
};
struct EpiDown {
    static constexpr bool MID = false;
    static constexpr int NSTORE = 0;
    unsigned char* y; const LAS float* wl;
    __device__ __forceinline__ bool mid_at(int) const { return false; }
    __device__ __forceinline__ void mid(Acc&, const Unit&, int, int, int, int, int) const {}
    __device__ __forceinline__ void operator()(Acc& acc, const Unit& u, int wr, int wc, int fr, int fq) const {
        fr = launder_i(fr); fq = launder_i(fq);
        const int r0 = wr * 64 + fr, col0 = u.pn * BM + wc * 32 + 8 * fq;
        const int colw = u.pn * BM + wc * 32 + 16 * (fq >> 1), odd = fq & 1;
#pragma unroll
        for (int ai = 0; ai < 2; ++ai)
#pragma unroll
            for (int mp = 0; mp < 2; ++mp) {
                unsigned char* rowp = y + (size_t)(u.pm * BM + r0 + ai * HALF + (2 * mp + odd) * 16) * D + colw;
                const float wA = wl[u.idx * 256 + r0 + ai * HALF + (2 * mp) * 16], wB = wl[u.idx * 256 + r0 + ai * HALF + (2 * mp + 1) * 16];
#pragma unroll
                for (int bj = 0; bj < 2; ++bj) {
                    u32x2 pa, pb;
                    { const int m = 2 * mp; const f32x4 v0 = acc[ai][bj][m][0] * wA, v1 = acc[ai][bj][m][1] * wA; pa.x = pk4_fp8(v0[0], v0[1], v0[2], v0[3]); pa.y = pk4_fp8(v1[0], v1[1], v1[2], v1[3]); }
                    { const int m = 2 * mp + 1; const f32x4 v0 = acc[ai][bj][m][0] * wB, v1 = acc[ai][bj][m][1] * wB; pb.x = pk4_fp8(v0[0], v0[1], v0[2], v0[3]); pb.y = pk4_fp8(v1[0], v1[1], v1[2], v1[3]); }
                    const auto sx = __builtin_amdgcn_permlane16_swap(pa.x, pb.x, false, false), sy = __builtin_amdgcn_permlane16_swap(pa.y, pb.y, false, false);
                    *(u32x4*)(rowp + bj * HALF) = (u32x4){(unsigned)sx[0], (unsigned)sy[0], (unsigned)sx[1], (unsigned)sy[1]};
                    asm volatile("" ::: "memory");
                }
            }
        asm volatile("" ::: "memory");
    }
};
}

__device__ __forceinline__ unsigned off_b(unsigned row, unsigned ch) { return 256u * row + 16u * (ch ^ (((row & 3u) << 2) | ((row >> 2) & 3u))); }
__device__ __forceinline__ int lds_addr(const LAS unsigned char* p) { return (int)(unsigned)(size_t)p; }
__device__ __forceinline__ int crow(int r, int hi) { return (r & 3) + 8 * (r >> 2) + 4 * hi; }
__device__ __forceinline__ s16x4 tr_read(const LAS unsigned char* p) { return __builtin_amdgcn_ds_read_tr16_b64_v4i16((LAS s16x4*)p); }
__device__ __forceinline__ bf16x8 tr_frag(const LAS unsigned char* tile, int r0, int r1, int c, int lane) {
    const int blk = (lane >> 4) & 1, q = (lane & 15) >> 2, p = lane & 3;
    const s16x4 a = tr_read(tile + off_b(r0 + q, 4 * c + 2 * blk + (p >> 1)) + 8 * (p & 1));
    const s16x4 b = tr_read(tile + off_b(r1 + q, 4 * c + 2 * blk + (p >> 1)) + 8 * (p & 1));
    return (bf16x8){a[0], a[1], a[2], a[3], b[0], b[1], b[2], b[3]};
}
__device__ __forceinline__ bf16x8 pack8(const f32x16& v, int base) {
    u32x4 w; w.x = cvt_pk_bf16(v[base + 0], v[base + 1]); w.y = cvt_pk_bf16(v[base + 2], v[base + 3]); w.z = cvt_pk_bf16(v[base + 4], v[base + 5]); w.w = cvt_pk_bf16(v[base + 6], v[base + 7]);
    return __builtin_bit_cast(bf16x8, w);
}
__device__ __forceinline__ int launder(int v) { asm volatile("" : "+v"(v)); return v; }
#define MFMA32(a, b, c) __builtin_amdgcn_mfma_f32_32x32x16_bf16(a, b, c, 0, 0, 0)

struct MixArgs { const bf16_t* proj; bf16_t* act; const float* diff_norm; float lam; float* ssq; };

template <int IMM> __device__ __forceinline__ void tr8_issue(s16x4 (&x)[8], const int (&ad)[8]) {
    asm volatile("ds_read_b64_tr_b16 %0, %8 offset:%16\n\tds_read_b64_tr_b16 %1, %9 offset:%16\n\tds_read_b64_tr_b16 %2, %10 offset:%16\n\tds_read_b64_tr_b16 %3, %11 offset:%16\n\t"
                 "ds_read_b64_tr_b16 %4, %12 offset:%16\n\tds_read_b64_tr_b16 %5, %13 offset:%16\n\tds_read_b64_tr_b16 %6, %14 offset:%16\n\tds_read_b64_tr_b16 %7, %15 offset:%16"
                 : "=&v"(x[0]), "=&v"(x[1]), "=&v"(x[2]), "=&v"(x[3]), "=&v"(x[4]), "=&v"(x[5]), "=&v"(x[6]), "=&v"(x[7])
                 : "v"(ad[0]), "v"(ad[1]), "v"(ad[2]), "v"(ad[3]), "v"(ad[4]), "v"(ad[5]), "v"(ad[6]), "v"(ad[7]), "n"(IMM) : "memory");
}
__device__ __forceinline__ void tr8_wait(s16x4 (&x)[8]) {
    asm volatile("s_waitcnt lgkmcnt(0)" : "+v"(x[0]), "+v"(x[1]), "+v"(x[2]), "+v"(x[3]), "+v"(x[4]), "+v"(x[5]), "+v"(x[6]), "+v"(x[7]) :: "memory");
}
template <int N> __device__ __forceinline__ void tr8_wait_n(s16x4 (&x)[8]) {
    asm volatile("s_waitcnt lgkmcnt(%8)" : "+v"(x[0]), "+v"(x[1]), "+v"(x[2]), "+v"(x[3]), "+v"(x[4]), "+v"(x[5]), "+v"(x[6]), "+v"(x[7]) : "n"(N) : "memory");
}
__device__ __forceinline__ void pv_mma(f32x16 (&O)[8], int ob, const s16x4 (&x)[8], const bf16x8& pf) {
    __builtin_amdgcn_s_setprio(2);
#pragma unroll
    for (int c = 0; c < 4; ++c) { const bf16x8 vf = {x[2 * c][0], x[2 * c][1], x[2 * c][2], x[2 * c][3], x[2 * c + 1][0], x[2 * c + 1][1], x[2 * c + 1][2], x[2 * c + 1][3]}; O[ob + c] = MFMA32(vf, pf, O[ob + c]); }
    __builtin_amdgcn_s_setprio(1);
}
template <int IMM> __device__ __forceinline__ void k4_issue(bf16x8 (&k)[4], int a0, int a1, int a2, int a3) {
    asm volatile("ds_read_b128 %0, %4 offset:%8\n\tds_read_b128 %1, %5 offset:%8\n\tds_read_b128 %2, %6 offset:%8\n\tds_read_b128 %3, %7 offset:%8"
                 : "=&v"(k[0]), "=&v"(k[1]), "=&v"(k[2]), "=&v"(k[3]) : "v"(a0), "v"(a1), "v"(a2), "v"(a3), "n"(IMM) : "memory");
}
__device__ __forceinline__ void tr4_issue(s16x4 (&x)[4], int a0, int a1, int a2, int a3) {
    asm volatile("ds_read_b64_tr_b16 %0, %4\n\tds_read_b64_tr_b16 %1, %5\n\tds_read_b64_tr_b16 %2, %6\n\tds_read_b64_tr_b16 %3, %7"
                 : "=&v"(x[0]), "=&v"(x[1]), "=&v"(x[2]), "=&v"(x[3]) : "v"(a0), "v"(a1), "v"(a2), "v"(a3) : "memory");
}
__device__ __forceinline__ void tr4_wait(s16x4 (&x)[4]) { asm volatile("s_waitcnt lgkmcnt(0)" : "+v"(x[0]), "+v"(x[1]), "+v"(x[2]), "+v"(x[3]) :: "memory"); }
__device__ __forceinline__ int tr_addr(const LAS unsigned char* tile, int r, int c, int lane) {
    const int blk = (lane >> 4) & 1, q = (lane & 15) >> 2, p = lane & 3;
    return lds_addr(tile) + (int)off_b(r + q, 4 * c + 2 * blk + (p >> 1)) + 8 * (p & 1);
}
__device__ __forceinline__ bf16x8 cat4(const s16x4& a, const s16x4& b) { return (bf16x8){a[0], a[1], a[2], a[3], b[0], b[1], b[2], b[3]}; }
template <int N> __device__ __forceinline__ void k4_wait(bf16x8 (&k)[4]) {
    asm volatile("s_waitcnt lgkmcnt(%4)" : "+v"(k[0]), "+v"(k[1]), "+v"(k[2]), "+v"(k[3]) : "n"(N) : "memory");
}
#define FENCE() __builtin_amdgcn_sched_barrier(0)
__device__ __forceinline__ bf16x8 lds_b128(int addr) { return *(const LAS bf16x8*)(size_t)(unsigned)addr; }
__device__ __forceinline__ s16x4 lds_tr(int addr) { return __builtin_amdgcn_ds_read_tr16_b64_v4i16((LAS s16x4*)(size_t)(unsigned)addr); }
template <int IMM> __device__ __forceinline__ s16x4 lds_tr_i(int addr) { return __builtin_amdgcn_ds_read_tr16_b64_v4i16((LAS s16x4*)((LAS unsigned char*)(size_t)(unsigned)addr + IMM)); }
__device__ __forceinline__ void dma16(const void* gptr, unsigned lds_base) {
    asm volatile("s_mov_b32 m0, %1\n\ts_nop 0\n\tglobal_load_lds_dwordx4 %0, off" :: "v"(gptr), "s"(lds_base) : "memory", "m0");
}
__device__ __forceinline__ void dma16s(unsigned long long sbase, unsigned voff, unsigned lds_base) {
    asm volatile("s_mov_b32 m0, %2\n\ts_nop 0\n\tglobal_load_lds_dwordx4 %0, %1" :: "v"(voff), "s"(sbase), "s"(lds_base) : "memory", "m0");
}
__device__ __forceinline__ unsigned attn_voff(int lane) { const int r4 = lane >> 4; return (unsigned)(r4 * DIN * 2 + (((lane & 15) ^ (r4 << 2)) * 16)); }
__device__ __forceinline__ void attn_issue(LAS unsigned char* buf, const bf16_t* proj, size_t trow0, int kcol0, int vcol0, int wid, unsigned voff0) {
    const int ti = wid >> 1;
    const int col = (ti < 2) ? kcol0 + ti * 128 : vcol0 + (ti - 2) * 128;
    const unsigned long long sb = (unsigned long long)(size_t)(proj + (trow0 + 32 * (wid & 1)) * DIN + col);
#pragma unroll
    for (int i = 0; i < 8; ++i)
        dma16s(sb + (unsigned long long)(4 * i) * DIN * 2, voff0 ^ (unsigned)(16 * (i & 3)), (unsigned)__builtin_amdgcn_readfirstlane(lds_addr(buf) + ti * 16384 + ((wid & 1) * 8 + i) * 1024));
}
__device__ __forceinline__ void attn_unit(LAS unsigned char* lds, const int wid, const MixArgs& A, int bl, int h, int qb, int pre, volatile LAS int* bcn) {
    const int lane0 = lane_now(), comp = wid >> 2, ri = wid & 3;
    const size_t tb = (size_t)bl * SEQ;
    const int kcol0 = 4096 + (2 * h) * 128, vcol0 = 5120 + h * 256;
    const int ntiles = 2 * (qb + 1);
    f32x16 O[8]; float mrun = -1e30f, lrun = 0.f;
    {
    const int lane = lane0, hh = lane >> 5, li = lane & 31;
    const unsigned voff0 = attn_voff(lane);
    attn_issue(lds, A.proj, tb, kcol0, vcol0, wid, voff0);
    const bf16_t* qrow = A.proj + (tb + qb * 128 + ri * 32 + li) * DIN + 3072 + (2 * h + comp) * 128;
    bf16x8 qf[8];
#pragma unroll
    for (int s = 0; s < 8; ++s) qf[s] = *(const bf16x8*)(qrow + 16 * s + 8 * hh);
    asm volatile("s_waitcnt vmcnt(0)" : "+v"(qf[0]), "+v"(qf[1]), "+v"(qf[2]), "+v"(qf[3]), "+v"(qf[4]), "+v"(qf[5]), "+v"(qf[6]), "+v"(qf[7]), "+v"(pre) :: "memory");
    if (wid == 0 && lane == 0) bcn[0] = pre;
#pragma unroll
    for (int i = 0; i < 8; ++i)
#pragma unroll
        for (int r = 0; r < 16; ++r) O[i][r] = 0.f;
    const int kadr = 256 * li + 16 * (hh ^ (((li & 3) << 2) | ((li >> 2) & 3)));
    const int blk = (lane >> 4) & 1, q = (lane & 15) >> 2, p = lane & 3, lo1 = (2 * blk + (p >> 1)) ^ hh;
    const int vb1 = 256 * (4 * hh + q) + 64 * q + 16 * lo1 + 8 * (p & 1), vb2 = 256 * (4 * hh + q + 8) + 64 * q + 16 * (lo1 ^ 2) + 8 * (p & 1);
    for (int kt = 0; kt < ntiles; ++kt) {
        asm volatile("s_waitcnt vmcnt(0)" ::: "memory");
        __builtin_amdgcn_s_barrier();
        asm volatile("" ::: "memory");
        if (kt + 1 < ntiles) attn_issue(lds + ((kt + 1) & 1) * 65536, A.proj, tb + (size_t)(kt + 1) * 64, kcol0, vcol0, wid, voff0);
        const int krel0 = (kt - 2 * qb) * 64;
        if (krel0 > ri * 32 + 31) continue;
        const LAS unsigned char* Kt = lds + (kt & 1) * 65536 + comp * 16384;
        const LAS unsigned char* Vt = lds + (kt & 1) * 65536 + 32768;
        f32x16 sc[2];
#pragma unroll
        for (int kb = 0; kb < 2; ++kb)
#pragma unroll
            for (int r = 0; r < 16; ++r) sc[kb][r] = 0.f;
        __builtin_amdgcn_s_setprio(1);
        {
            const int kbase = lds_addr(Kt);
            bf16x8 ka[2][4];
#pragma unroll
            for (int s = 0; s < 4; ++s) ka[0][s] = lds_b128(kbase + (kadr ^ (32 * s)));
#pragma unroll
            for (int grp = 0; grp < 4; ++grp) {
                const int s0 = 4 * (grp >> 1), kb = grp & 1;
                if (grp + 1 < 4) { const int s1 = 4 * ((grp + 1) >> 1), kb1 = (grp + 1) & 1;
#pragma unroll
                    for (int s = 0; s < 4; ++s) ka[(grp + 1) & 1][s] = lds_b128(kbase + 8192 * kb1 + (kadr ^ (32 * (s1 + s)))); }
                FENCE();
                __builtin_amdgcn_s_setprio(2);
#pragma unroll
                for (int s = 0; s < 4; ++s) sc[kb] = MFMA32(ka[grp & 1][s], qf[s0 + s], sc[kb]);
                __builtin_amdgcn_s_setprio(1);
                FENCE();
            }
        }
        __builtin_amdgcn_s_setprio(0);
        if (krel0 >= 0) {
            const int qrel = ri * 32 + li;
#pragma unroll
            for (int kb = 0; kb < 2; ++kb)
#pragma unroll
                for (int r = 0; r < 16; ++r) if (krel0 + 32 * kb + crow(r, hh) > qrel) sc[kb][r] = -INFINITY;
        }
        float pmax = sc[0][0];
#pragma unroll
        for (int r = 1; r < 16; ++r) pmax = fmaxf(pmax, sc[0][r]);
#pragma unroll
        for (int r = 0; r < 16; ++r) pmax = fmaxf(pmax, sc[1][r]);
        pmax = xor32_max(pmax);
        if (!__all(pmax <= mrun + 11.0f)) {
            const float mn = fmaxf(mrun, pmax), alpha = __builtin_amdgcn_exp2f(mrun - mn);
            mrun = mn; lrun *= alpha;
#pragma unroll
            for (int i = 0; i < 8; ++i)
#pragma unroll
                for (int r = 0; r < 16; ++r) O[i][r] *= alpha;
        }
        float ps = 0.f;
#pragma unroll
        for (int kb = 0; kb < 2; ++kb)
#pragma unroll
            for (int r = 0; r < 16; ++r) { const float pe = __builtin_amdgcn_exp2f(sc[kb][r] - mrun); sc[kb][r] = pe; ps += pe; }
        lrun += ps;
        {
            const int vbase = (int)(unsigned)(size_t)Vt;
            int ad[8];
#pragma unroll
            for (int c = 0; c < 4; ++c) { ad[2 * c] = vbase + (vb1 ^ (64 * c)); ad[2 * c + 1] = vbase + (vb2 ^ (64 * c)); }
            const bf16x8 pf0 = pack8(sc[0], 0), pf1 = pack8(sc[0], 8), pf2 = pack8(sc[1], 0), pf3 = pack8(sc[1], 8);
            s16x4 xa[8], xb[8];
            __builtin_amdgcn_s_setprio(1);
#define PV_LOAD(x, IMM) do { _Pragma("unroll") for (int c = 0; c < 8; ++c) x[c] = lds_tr_i<(IMM)>(ad[c]); } while (0)
            PV_LOAD(xa, 256 * 0);
            PV_LOAD(xb, 256 * 0 + 16384);  FENCE(); pv_mma(O, 0, xa, pf0); FENCE();
            PV_LOAD(xa, 256 * 16);         FENCE(); pv_mma(O, 4, xb, pf0); FENCE();
            PV_LOAD(xb, 256 * 16 + 16384); FENCE(); pv_mma(O, 0, xa, pf1); FENCE();
            PV_LOAD(xa, 256 * 32);         FENCE(); pv_mma(O, 4, xb, pf1); FENCE();
            PV_LOAD(xb, 256 * 32 + 16384); FENCE(); pv_mma(O, 0, xa, pf2); FENCE();
            PV_LOAD(xa, 256 * 48);         FENCE(); pv_mma(O, 4, xb, pf2); FENCE();
            PV_LOAD(xb, 256 * 48 + 16384); FENCE(); pv_mma(O, 0, xa, pf3); FENCE();
                                                    pv_mma(O, 4, xb, pf3);
            __builtin_amdgcn_s_setprio(0);
#undef PV_LOAD
        }
    }
    }
    __syncthreads();
    const float inv = 1.0f / xor32_sum(lrun);
    LAS f32x4* X = (LAS f32x4*)lds;
    const int lane = lane_now(), hh = lane >> 5, li = lane & 31;
    if (comp == 1) {
#pragma unroll
        for (int dvb = 0; dvb < 8; ++dvb)
#pragma unroll
            for (int g = 0; g < 4; ++g) X[((ri * 8 + dvb) * 4 + g) * 64 + lane] = (f32x4){O[dvb][4 * g] * inv, O[dvb][4 * g + 1] * inv, O[dvb][4 * g + 2] * inv, O[dvb][4 * g + 3] * inv};
    }
    __syncthreads();
    if (comp == 0) {
        float ss = 0.f;
#pragma unroll
        for (int dvb = 0; dvb < 8; ++dvb)
#pragma unroll
            for (int g = 0; g < 4; ++g) {
                const f32x4 o2 = X[((ri * 8 + dvb) * 4 + g) * 64 + lane];
#pragma unroll
                for (int e = 0; e < 4; ++e) { float d = O[dvb][4 * g + e] * inv - A.lam * o2[e]; asm volatile("" : "+v"(d)); O[dvb][4 * g + e] = d; ss += d * d; }
            }
        ss = xor32_sum(ss);
        const float rstd = 0.8f / sqrtf(ss * (1.0f / 256.0f) + EPS);
        LAS unsigned char* stg = lds + ri * 32768;
#pragma unroll
        for (int dh = 0; dh < 2; ++dh) {
            asm volatile("" ::: "memory");
            f32x4 gn[4][4];
#pragma unroll
            for (int d4 = 0; d4 < 4; ++d4)
#pragma unroll
                for (int g = 0; g < 4; ++g) gn[d4][g] = *(const f32x4*)(A.diff_norm + 32 * (4 * dh + d4) + 8 * g + 4 * hh);
            asm volatile("" ::: "memory");
#pragma unroll
            for (int d4 = 0; d4 < 4; ++d4) {
                const int dvb = 4 * dh + d4;
#pragma unroll
                for (int g = 0; g < 4; ++g) {
                    u32x2 w; w.x = cvt_pk_bf16(O[dvb][4 * g] * rstd * gn[d4][g][0], O[dvb][4 * g + 1] * rstd * gn[d4][g][1]); w.y = cvt_pk_bf16(O[dvb][4 * g + 2] * rstd * gn[d4][g][2], O[dvb][4 * g + 3] * rstd * gn[d4][g][3]);
                    *(LAS u32x2*)(stg + li * 528 + 64 * dvb + 16 * g + 8 * hh) = w;
                }
            }
        }
        asm volatile("s_waitcnt lgkmcnt(0)" ::: "memory");
        bf16_t* obase = A.act + (tb + qb * 128 + ri * 32 + hh) * 2048 + 1024 + h * 256 + 8 * li;
#pragma unroll
        for (int i4 = 0; i4 < 4; ++i4) {
            u32x4 v[4];
#pragma unroll
            for (int q = 0; q < 4; ++q) v[q] = *(const LAS u32x4*)(stg + (2 * (4 * i4 + q) + hh) * 528 + 16 * li);
#pragma unroll
            for (int q = 0; q < 4; ++q) *(u32x4*)(obase + (size_t)(2 * (4 * i4 + q)) * 2048) = v[q];
        }
    }
    __syncthreads();
}

#define MFMA_DEP(acc, zs) (__builtin_amdgcn_readfirstlane(__float_as_int((acc)[15])) & (zs))
#define MFMA_DEP2(a, b, zs) ((__builtin_amdgcn_readfirstlane(__float_as_int((a)[15])) | __builtin_amdgcn_readfirstlane(__float_as_int((b)[15]))) & (zs))
#define MFMA_DEP4(a, b, c, d, zs) ((__builtin_amdgcn_readfirstlane(__float_as_int((a)[15])) | __builtin_amdgcn_readfirstlane(__float_as_int((b)[15])) | __builtin_amdgcn_readfirstlane(__float_as_int((c)[15])) | __builtin_amdgcn_readfirstlane(__float_as_int((d)[15]))) & (zs))
#define RET_BAR() do { asm volatile("s_waitcnt lgkmcnt(0)" ::: "memory"); __builtin_amdgcn_s_barrier(); asm volatile("" ::: "memory"); } while (0)
template <int J2> __device__ __forceinline__ void ret_step34(f32x16 (&Oa)[2], f32x16 (&St)[2], const int (&tv)[2], const int (&tk)[2][2], int pa0, int pa1, int pb0, int pb1, int ib0, int ib1) {
    constexpr int R = 256 * 32 * J2;
    s16x4 xv[4], xk0[4], xk1[4]; bf16x8 pp[4];
    xv[0] = lds_tr_i<R>(tv[0]); xv[1] = lds_tr_i<R + 1024>(tv[1]); xv[2] = lds_tr_i<R + 4096>(tv[0]); xv[3] = lds_tr_i<R + 5120>(tv[1]);
    xk0[0] = lds_tr_i<R>(tk[0][0]); xk0[1] = lds_tr_i<R + 1024>(tk[0][1]); xk0[2] = lds_tr_i<R + 4096>(tk[0][0]); xk0[3] = lds_tr_i<R + 5120>(tk[0][1]);
    xk1[0] = lds_tr_i<R>(tk[1][0]); xk1[1] = lds_tr_i<R + 1024>(tk[1][1]); xk1[2] = lds_tr_i<R + 4096>(tk[1][0]); xk1[3] = lds_tr_i<R + 5120>(tk[1][1]);
    pp[0] = lds_b128(pa0); pp[1] = lds_b128(pb0); pp[2] = lds_b128(pa1); pp[3] = lds_b128(pb1);
    FENCE();
    const bf16x8 z = {0, 0, 0, 0, 0, 0, 0, 0};
#pragma unroll
    for (int q = 0; q < 2; ++q) {
        const bf16x8 vf = cat4(xv[2 * q], xv[2 * q + 1]);
        Oa[0] = MFMA32(vf, (J2 <= ib0) ? pp[2 * q] : z, Oa[0]); Oa[1] = MFMA32(vf, (J2 <= ib1) ? pp[2 * q + 1] : z, Oa[1]);
        St[0] = MFMA32(cat4(xk0[2 * q], xk0[2 * q + 1]), vf, St[0]); St[1] = MFMA32(cat4(xk1[2 * q], xk1[2 * q + 1]), vf, St[1]);
    }
    FENCE();
}
__device__ __forceinline__ void ret_unit(LAS unsigned char* lds, const int wid, const MixArgs& A, int bl, int h, int dvh) {
    const int lane = lane_now(), tid = wid * 64 + lane, eb = wid & 3, hf = wid >> 2;
    const int ib0 = hf ? 1 : 0, ib1 = hf ? 2 : 3, li = lane & 31, hh = lane >> 5;
    const size_t tb = (size_t)bl * SEQ;
    const float gamma = 1.0f - __builtin_amdgcn_exp2f(-5.0f - (float)h), lg = __builtin_amdgcn_logf(gamma);
    const float cdecay = __builtin_amdgcn_exp2f(128.0f * lg), cinv = __builtin_amdgcn_exp2f(-128.0f * lg);
    const int L0 = lds_addr(lds), X = ((li & 3) << 2) | ((li >> 2) & 3);
    int rb[8];
#pragma unroll
    for (int s = 0; s < 8; ++s) rb[s] = L0 + 256 * li + 16 * ((2 * s + hh) ^ X);
    int wb[4];
#pragma unroll
    for (int g = 0; g < 4; ++g) wb[g] = L0 + 256 * li + 16 * (g ^ (X & 3)) + 8 * hh;
    const int xh = X >> 2;
    const int tq = (lane & 15) >> 2, tp = lane & 3, tblk = (lane >> 4) & 1;
    int tv[2], tk[2][2];
#pragma unroll
    for (int t = 0; t < 2; ++t) {
        const int lp = 2048 * hh + 256 * tq + 16 * ((2 * tblk + (tp >> 1)) ^ (2 * hh + t)) + 8 * (tp & 1);
        tv[t] = L0 + 65536 + lp + 64 * (eb ^ tq);
#pragma unroll
        for (int k = 0; k < 2; ++k) tk[k][t] = L0 + 32768 + lp + 64 * ((2 * hf + k) ^ tq);
    }
    const int sS0 = 98304 + 8192 * eb, sA0 = 8192 * ib0, sB0 = 8192 * ib1;
    const int sw = 256 * (tid >> 4) + 16 * ((tid & 15) ^ ((((tid >> 4) & 3) << 2) | ((tid >> 6) & 3)));
    const unsigned gq = (unsigned)(((tid >> 4) * DIN + (tid & 15) * 8) * 2);
    const unsigned colb[3] = {(unsigned)(h * 128 * 2), (unsigned)((512 + h * 128) * 2), (unsigned)((1024 + h * 256 + dvh * 128) * 2)};
    const unsigned go0 = (unsigned)(((32 * ib0 + li) * DIN + 4 * hh) * 2), go1 = (unsigned)(((32 * ib1 + li) * DIN + 4 * hh) * 2);
    const unsigned oo0 = (unsigned)(((32 * ib0 + li) * 2048 + 4 * hh) * 2), oo1 = (unsigned)(((32 * ib1 + li) * 2048 + 4 * hh) * 2);
    f32x16 St[2];
#pragma unroll
    for (int i = 0; i < 2; ++i)
#pragma unroll
        for (int r = 0; r < 16; ++r) St[i][r] = 0.f;
    u32x4 pre[12];
    {
        const char* cb = (const char*)(A.proj + tb * DIN);
#pragma unroll
        for (int i = 0; i < 12; ++i) pre[i] = *(const u32x4*)(cb + (size_t)(i & 3) * 32 * DIN * 2 + (gq + colb[i >> 2]));
#pragma unroll
        for (int i = 0; i < 12; ++i) *(LAS u32x4*)(lds + (i >> 2) * 32768 + (i & 3) * 8192 + sw) = pre[i];
    }
    RET_BAR();
    for (int n = 0; n < 32; ++n) {
        const size_t t0 = tb + (size_t)n * 128;
        int sS = sS0, sA = sA0, sB = sB0, wl = wid;
        asm volatile("" : "+s"(sS), "+s"(sA), "+s"(sB), "+s"(wl));
        if (n + 1 < 32) {
            const char* cb = (const char*)(A.proj + (t0 + 128) * DIN);
#pragma unroll
            for (int i = 0; i < 12; ++i) pre[i] = *(const u32x4*)(cb + (size_t)(i & 3) * 32 * DIN * 2 + (gq + colb[i >> 2]));
        }
        f32x16 Oa[2];
#pragma unroll
        for (int i = 0; i < 2; ++i)
#pragma unroll
            for (int r = 0; r < 16; ++r) Oa[i][r] = 0.f;
        if (n > 0) {
#pragma unroll
            for (int s4 = 0; s4 < 2; ++s4) {
                bf16x8 sa[4], qa[4], qb[4];
#pragma unroll
                for (int s = 0; s < 4; ++s) { sa[s] = lds_b128(rb[4 * s4 + s] + sS); qa[s] = lds_b128(rb[4 * s4 + s] + sA); qb[s] = lds_b128(rb[4 * s4 + s] + sB); }
                FENCE();
#pragma unroll
                for (int s = 0; s < 4; ++s) { Oa[0] = MFMA32(sa[s], qa[s], Oa[0]); Oa[1] = MFMA32(sa[s], qb[s], Oa[1]); }
                FENCE();
            }
        }
        f32x16 sb[2]; int jbs[2], ibs[2];
#pragma unroll
        for (int u = 0; u < 2; ++u) {
            const int id = wl + 8 * u;
            const int ib = (id >= 6) ? 3 : (id >= 3) ? 2 : (id >= 1) ? 1 : 0, jb = id - (ib * (ib + 1)) / 2;
            ibs[u] = ib; jbs[u] = jb;
#pragma unroll
            for (int r = 0; r < 16; ++r) sb[u][r] = 0.f;
            if (id < 10) {
                bf16x8 fa[4], fb[4];
                const int ok = 32768 + 8192 * jb, oq = 8192 * ib;
#pragma unroll
                for (int h2 = 0; h2 < 2; ++h2) {
#pragma unroll
                    for (int s = 0; s < 4; ++s) { fa[s] = lds_b128(rb[4 * h2 + s] + ok); fb[s] = lds_b128(rb[4 * h2 + s] + oq); }
                    FENCE();
#pragma unroll
                    for (int s = 0; s < 4; ++s) sb[u] = MFMA32(fa[s], fb[s], sb[u]);
                    FENCE();
                }
            }
        }
        RET_BAR();
#pragma unroll
        for (int u = 0; u < 2; ++u) {
            const int id = wl + 8 * u;
            if (id < 10) {
                const int ib = ibs[u], jb = jbs[u], wo = 8192 * ib + 64 * (jb ^ xh);
#pragma unroll
                for (int g = 0; g < 4; ++g) {
                    float p[4];
#pragma unroll
                    for (int e = 0; e < 4; ++e) { const int j = 8 * g + 4 * hh + e; p[e] = (ib == jb && j > li) ? 0.f : sb[u][4 * g + e] * cinv; }
                    u32x2 w; w.x = cvt_pk_bf16(p[0], p[1]); w.y = cvt_pk_bf16(p[2], p[3]);
                    *(LAS u32x2*)(size_t)(unsigned)(wb[g] + wo) = w;
                }
            }
        }
        RET_BAR();
        u32x2 gg[2][4];
        { const char* gbp = (const char*)(A.proj + t0 * DIN + 2048 + h * 256 + dvh * 128 + 32 * eb);
#pragma unroll
          for (int g = 0; g < 4; ++g) { gg[0][g] = *(const u32x2*)(gbp + go0 + 16 * g); gg[1][g] = *(const u32x2*)(gbp + go1 + 16 * g); } }
#pragma unroll
        for (int k = 0; k < 2; ++k)
#pragma unroll
            for (int r = 0; r < 16; ++r) St[k][r] *= cdecay;
        ret_step34<0>(Oa, St, tv, tk, rb[0] + sA, rb[1] + sA, rb[0] + sB, rb[1] + sB, ib0, ib1);
        ret_step34<1>(Oa, St, tv, tk, rb[2] + sA, rb[3] + sA, rb[2] + sB, rb[3] + sB, ib0, ib1);
        ret_step34<2>(Oa, St, tv, tk, rb[4] + sA, rb[5] + sA, rb[4] + sB, rb[5] + sB, ib0, ib1);
        ret_step34<3>(Oa, St, tv, tk, rb[6] + sA, rb[7] + sA, rb[6] + sB, rb[7] + sB, ib0, ib1);
        RET_BAR();
#pragma unroll
        for (int k = 0; k < 2; ++k) {
            const int so = sS + 64 * ((2 * (wl >> 2) + k) ^ xh);
#pragma unroll
            for (int g = 0; g < 4; ++g) {
                u32x2 w; w.x = cvt_pk_bf16(St[k][4 * g], St[k][4 * g + 1]); w.y = cvt_pk_bf16(St[k][4 * g + 2], St[k][4 * g + 3]);
                *(LAS u32x2*)(size_t)(unsigned)(wb[g] + so) = w;
            }
        }
        if (n + 1 < 32) {
#pragma unroll
            for (int i = 0; i < 12; ++i) *(LAS u32x4*)(lds + (i >> 2) * 32768 + (i & 3) * 8192 + sw) = pre[i];
        }
        {
            char* obp = (char*)(A.act + t0 * 2048 + h * 256 + dvh * 128 + 32 * eb);
            float* sqp = A.ssq + (t0 * 4 + h) * 8 + dvh * 4 + eb;
#pragma unroll
            for (int k = 0; k < 2; ++k) {
                float sq = 0.f;
#pragma unroll
                for (int r = 0; r < 16; ++r) sq += Oa[k][r] * Oa[k][r];
                sq = xor32_sum(sq);
                if (hh == 0) sqp[(size_t)(32 * (k ? ib1 : ib0) + li) * 32] = sq;
                const unsigned oo = k ? oo1 : oo0;
                u32x2 w[4];
#pragma unroll
                for (int g = 0; g < 4; ++g) {
                    const u32x2 gv = gg[k][g];
                    w[g].x = cvt_pk_bf16(Oa[k][4 * g] * bf_lo(gv.x), Oa[k][4 * g + 1] * bf_hi(gv.x)); w[g].y = cvt_pk_bf16(Oa[k][4 * g + 2] * bf_lo(gv.y), Oa[k][4 * g + 3] * bf_hi(gv.y));
                }
#pragma unroll
                for (int g = 0; g < 4; g += 2) {
                    const auto sx = __builtin_amdgcn_permlane32_swap(w[g].x, w[g + 1].x, false, false), sy = __builtin_amdgcn_permlane32_swap(w[g].y, w[g + 1].y, false, false);
                    *(u32x4*)(obp + (oo - 8 * hh) + 16 * (g + hh)) = (u32x4){(unsigned)sx[0], (unsigned)sy[0], (unsigned)sx[1], (unsigned)sy[1]};
                }
            }
        }
        RET_BAR();
    }
    __syncthreads();
}

struct Args { const void* in[24]; float* out; unsigned char* ws; int ph_lo, ph_hi; };
struct Frame {
    LAS unsigned char* lds; int tid, lane, wave, G, vcu;
    const float *x, *c, *w_ada, *b_ada, *norm_mix, *w_in, *w_ret_o, *w_diff_o, *lq1, *lk1, *lq2, *lk2, *diff_norm, *w_out, *norm_ffn, *w_rg, *b_rg, *w_re, *b_re, *w_eg, *w_eu, *w_ed, *norm_final;
    const int* positions; float* out; unsigned char* ws;
};
__device__ __forceinline__ unsigned f2bf(float f) { unsigned u = __builtin_bit_cast(unsigned, f); return (u + 0x7fffu + ((u >> 16) & 1u)) >> 16; }
__device__ __forceinline__ unsigned pk2(float lo, float hi) { return f2bf(lo) | (f2bf(hi) << 16); }

template <int MODE>
__device__ __forceinline__ void p0_transpose_item(const float* W, int N, bf16_t* WT, int ldk, int koff, LAS float* scr, int item, int lane) {
    const int nblk = N / 32, kb = item / nblk, nb = item % nblk, k0 = 64 * kb, n0 = 32 * nb;
    { float wv[32];
#pragma unroll
      for (int i = 0; i < 32; ++i) { const int kk = 2 * i + (lane >> 5); wv[i] = W[(size_t)(k0 + kk) * N + n0 + (lane & 31)]; }
#pragma unroll
      for (int i = 0; i < 32; ++i) { const int kk = 2 * i + (lane >> 5); scr[kk * 33 + (lane & 31)] = wv[i]; } }
    LDS_WAIT(); asm volatile("" ::: "memory");
    const int c = lane & 7;
#pragma unroll
    for (int j = 0; j < 4; ++j) {
        const int nl = (lane >> 3) + 8 * j, n = n0 + nl; const LAS float* s = scr + (8 * c) * 33 + nl;
        int np = n; float sc = 1.f;
        if (MODE == 1) {
            const bool rope = (n < 1024) || (n >= 3072 && n < 5120);
            if (rope) { const int f = n & 127; np = (n & ~127) + 8 * ((f & 63) >> 2) + 4 * (f >> 6) + (f & 3); }
            if ((n >= 512 && n < 1024) || (n >= 4096 && n < 5120)) sc = 0.08838834764831845f;
            else if (n >= 3072 && n < 4096) sc = 1.4426950408889634f;
        } else if (MODE == 2) np = 8 * (n >> 2) + (n & 3);
        else if (MODE == 3) np = 8 * (n >> 2) + 4 + (n & 3);
        u32x4 o; o.x = pk2(s[0 * 33] * sc, s[1 * 33] * sc); o.y = pk2(s[2 * 33] * sc, s[3 * 33] * sc); o.z = pk2(s[4 * 33] * sc, s[5 * 33] * sc); o.w = pk2(s[6 * 33] * sc, s[7 * 33] * sc);
        *(u32x4*)(WT + (size_t)np * ldk + koff + k0 + 8 * c) = o;
    }
    LDS_WAIT(); asm volatile("" ::: "memory");
}

template <int MODE>
__device__ __forceinline__ void p0_transpose_item8(const float* W, int N, unsigned char* WT8, int ldk, LAS float* scr, int item, int lane) {
    const int nblk = N / 32, kb = item / nblk, nb = item % nblk, k0 = 64 * kb, n0 = 32 * nb;
    { float wv[32];
#pragma unroll
      for (int i = 0; i < 32; ++i) { const int kk = 2 * i + (lane >> 5); wv[i] = W[(size_t)(k0 + kk) * N + n0 + (lane & 31)]; }
#pragma unroll
      for (int i = 0; i < 32; ++i) { const int kk = 2 * i + (lane >> 5); scr[kk * 33 + (lane & 31)] = wv[i]; } }
    LDS_WAIT(); asm volatile("" ::: "memory");
    const int c = lane & 7;
#pragma unroll
    for (int j = 0; j < 4; ++j) {
        const int nl = (lane >> 3) + 8 * j, n = n0 + nl; const LAS float* s = scr + (8 * c) * 33 + nl;
        const int np = (MODE == 2) ? 8 * (n >> 2) + (n & 3) : (MODE == 3) ? 8 * (n >> 2) + 4 + (n & 3) : n;
        u32x2 o; o.x = pk4_fp8(s[0 * 33] * 32.f, s[1 * 33] * 32.f, s[2 * 33] * 32.f, s[3 * 33] * 32.f); o.y = pk4_fp8(s[4 * 33] * 32.f, s[5 * 33] * 32.f, s[6 * 33] * 32.f, s[7 * 33] * 32.f);
        *(u32x2*)(WT8 + (size_t)np * ldk + k0 + 8 * c) = o;
    }
    LDS_WAIT(); asm volatile("" ::: "memory");
}
template <int MODE>
__device__ __forceinline__ void p0_transpose_pair8(const float* W, int N, unsigned char* WT8, int ldk, LAS float* scr, int item, int lane) {
    const int nblk = N / 32;
    float wa[32], wb[32];
    { const int kb = item / nblk, nb = item % nblk, k0 = 64 * kb, n0 = 32 * nb;
#pragma unroll
      for (int i = 0; i < 32; ++i) { const int kk = 2 * i + (lane >> 5); wa[i] = W[(size_t)(k0 + kk) * N + n0 + (lane & 31)]; } }
    { const int kb = (item + 1) / nblk, nb = (item + 1) % nblk, k0 = 64 * kb, n0 = 32 * nb;
#pragma unroll
      for (int i = 0; i < 32; ++i) { const int kk = 2 * i + (lane >> 5); wb[i] = W[(size_t)(k0 + kk) * N + n0 + (lane & 31)]; } }
#pragma unroll
    for (int h = 0; h < 2; ++h) {
        const int it = item + h, kb = it / nblk, nb = it % nblk, k0 = 64 * kb, n0 = 32 * nb;
#pragma unroll
        for (int i = 0; i < 32; ++i) { const int kk = 2 * i + (lane >> 5); scr[kk * 33 + (lane & 31)] = h ? wb[i] : wa[i]; }
        LDS_WAIT(); asm volatile("" ::: "memory");
        const int c = lane & 7;
#pragma unroll
        for (int j = 0; j < 4; ++j) {
            const int nl = (lane >> 3) + 8 * j, n = n0 + nl; const LAS float* sp = scr + (8 * c) * 33 + nl;
            const int np = (MODE == 2) ? 8 * (n >> 2) + (n & 3) : (MODE == 3) ? 8 * (n >> 2) + 4 + (n & 3) : n;
            u32x2 o; o.x = pk4_fp8(sp[0 * 33] * 32.f, sp[1 * 33] * 32.f, sp[2 * 33] * 32.f, sp[3 * 33] * 32.f); o.y = pk4_fp8(sp[4 * 33] * 32.f, sp[5 * 33] * 32.f, sp[6 * 33] * 32.f, sp[7 * 33] * 32.f);
            *(u32x2*)(WT8 + (size_t)np * ldk + k0 + 8 * c) = o;
        }
        LDS_WAIT(); asm volatile("" ::: "memory");
    }
}

__device__ __forceinline__ void p0_prologue(Frame& F) {
    F.lane = lane_now(); F.tid = F.wave * 64 + F.lane;
    float* mod = (float*)(F.ws + WS_MOD);
    LAS float* sc = (LAS float*)F.lds;
    for (int i = F.tid; i < NB * D; i += NTHR) { const float v = F.c[i]; sc[(i & 1023) * 8 + (i >> 10)] = v / (1.0f + __expf(-v)); }
    __syncthreads();
    LAS float* red = (LAS float*)(F.lds + 32768);
    for (int item = blockIdx.x; item < 192; item += F.G) {
        const int cl = F.tid & 31, kg = F.tid >> 5, col = item * 32 + cl;
        const float* wp = F.w_ada + (size_t)(kg * 64) * 6144 + col;
        float w[64];
#pragma unroll
        for (int k = 0; k < 64; ++k) w[k] = wp[(size_t)k * 6144];
        float a[8];
#pragma unroll
        for (int b = 0; b < 8; ++b) a[b] = 0.f;
#pragma unroll
        for (int k = 0; k < 64; ++k) { const f32x4 s0 = *(const LAS f32x4*)(sc + (kg * 64 + k) * 8), s1 = *(const LAS f32x4*)(sc + (kg * 64 + k) * 8 + 4);
            a[0] += s0.x * w[k]; a[1] += s0.y * w[k]; a[2] += s0.z * w[k]; a[3] += s0.w * w[k]; a[4] += s1.x * w[k]; a[5] += s1.y * w[k]; a[6] += s1.z * w[k]; a[7] += s1.w * w[k]; }
#pragma unroll
        for (int b = 0; b < 8; ++b) red[(kg * 8 + b) * 32 + cl] = a[b];
        __syncthreads();
        if (F.tid < 256) { const int b = F.tid >> 5; float s = 0.f;
#pragma unroll
          for (int g = 0; g < 16; ++g) s += red[(g * 8 + b) * 32 + cl];
          mod[(size_t)b * 6144 + col] = s + F.b_ada[col]; }
        __syncthreads();
    }
    if (blockIdx.x == 0 && F.wave == 0) {
        float s1 = F.lq1[F.lane] * F.lk1[F.lane] + F.lq1[F.lane + 64] * F.lk1[F.lane + 64], s2 = F.lq2[F.lane] * F.lk2[F.lane] + F.lq2[F.lane + 64] * F.lk2[F.lane + 64];
        s1 = wave_sum(s1); s2 = wave_sum(s2);
        if (F.lane == 0) *(float*)(F.ws + WS_MOD + 256 * 1024) = __expf(s1) - __expf(s2) + 0.2f;
    }
    { bf16_t* rth = (bf16_t*)(F.ws + WS_MOD + 512 * 1024); bf16_t* rtl = rth + 48 * D;
      for (int i = blockIdx.x * NTHR + F.tid; i < 48 * D; i += F.G * NTHR) { const int o = i >> 10, k = i & 1023; const float w = (o < 4) ? F.w_rg[k * 4 + o] : (o < 36) ? F.w_re[k * 32 + (o - 4)] : 0.f;
          const unsigned h = f2bf(w); rth[i] = (bf16_t)h; rtl[i] = (bf16_t)f2bf(w - __uint_as_float(h << 16)); } }
    __syncthreads();
    LAS float* scr = (LAS float*)(F.lds + F.wave * 16384);
    const int gw = launder_s(F.vcu * NWAVES + F.wave), NGW = F.G * NWAVES;
    constexpr int I_IN = 16 * 256, I_SQ = 16 * 32;
    constexpr int NITEMS = I_IN + 3 * I_SQ;
    bf16_t* Win = (bf16_t*)(F.ws + WS_WIN); bf16_t* Wmix = (bf16_t*)(F.ws + WS_WMIX); bf16_t* Wout = (bf16_t*)(F.ws + WS_WOUT);
    for (int it = gw; it < NITEMS; it += NGW) {
        int r = it;
        if (r < I_IN) { p0_transpose_item<1>(F.w_in, DIN, Win, 1024, 0, scr, r, F.lane); continue; } r -= I_IN;
        if (r < I_SQ) { p0_transpose_item<0>(F.w_ret_o, D, Wmix, 2048, 0, scr, r, F.lane); continue; } r -= I_SQ;
        if (r < I_SQ) { p0_transpose_item<0>(F.w_diff_o, D, Wmix, 2048, 1024, scr, r, F.lane); continue; } r -= I_SQ;
        p0_transpose_item<0>(F.w_out, D, Wout, 1024, 0, scr, r, F.lane);
    }
    float* cosT = (float*)(F.ws + WS_COS); float* sinT = (float*)(F.ws + WS_SIN);
    {
        constexpr int RIT = 16;
        const int stride = F.G * NTHR;
        for (int base = blockIdx.x * NTHR + F.tid; base < T * 64; base += stride * RIT) {
            int pos[RIT];
#pragma unroll
            for (int q = 0; q < RIT; ++q) { const int i = base + q * stride; pos[q] = (i < T * 64) ? F.positions[i >> 6] : 0; }
#pragma unroll
            for (int q = 0; q < RIT; ++q) {
                const int i = base + q * stride; if (i >= T * 64) break;
                const int j = i & 63;
                const float inv = __builtin_amdgcn_exp2f(-(float)j * (13.287712379549449f / 64.0f));
                const float ang = (float)pos[q] * inv;
                double rev = (double)ang * 0.15915494309189535; rev -= __builtin_rint(rev);
                const float rf = (float)rev;
                cosT[i] = __builtin_amdgcn_cosf(rf); sinT[i] = __builtin_amdgcn_sinf(rf);
            }
        }
    }
}

__device__ __forceinline__ void convert_experts(Frame& F) {
    constexpr int I_G = 32 * 256, NCH = (3 * I_G) / 32;
    unsigned* q2 = (unsigned*)(F.ws + WS_CTL) + CW_Q + 64 * 8;
    volatile LAS int* bc = (volatile LAS int*)(F.lds + LDSCTL_OFF + 64);
    LAS float* scr = (LAS float*)(F.lds + F.wave * 16384);
    unsigned char* Wgu = F.ws + WS_WGU; unsigned char* Wdn = F.ws + WS_WDN;
    const int lane = lane_now();
    for (;;) {
        __syncthreads();
        if (F.wave == 0 && lane_now() == 0) bc[0] = (int)__hip_atomic_fetch_add(q2, 1u, __ATOMIC_RELAXED, __HIP_MEMORY_SCOPE_AGENT);
        __syncthreads();
        const int c = bc[0];
        if (c >= NCH) break;
        for (int k = 0; k < 4; k += 2) {
            int r = c * 32 + F.wave * 4 + k;
            if (r < I_G) { const int e = r >> 8; p0_transpose_pair8<2>(F.w_eg + (size_t)e * D * DEXP, DEXP, Wgu + (size_t)e * 1024 * 1024, 1024, scr, r & 255, lane); continue; } r -= I_G;
            if (r < I_G) { const int e = r >> 8; p0_transpose_pair8<3>(F.w_eu + (size_t)e * D * DEXP, DEXP, Wgu + (size_t)e * 1024 * 1024, 1024, scr, r & 255, lane); continue; } r -= I_G;
            { const int e = r >> 8; p0_transpose_pair8<0>(F.w_ed + (size_t)e * DEXP * D, D, Wdn + (size_t)e * 1024 * 512, 512, scr, r & 255, lane); }
        }
    }
    __syncthreads();
}

__device__ __forceinline__ void p1_norm_mod(Frame& F) {
    F.lane = lane_now(); F.tid = F.wave * 64 + F.lane;
    const float* mod = (const float*)(F.ws + WS_MOD); bf16_t* H0 = (bf16_t*)(F.ws + WS_H); bf16_t* H1 = (bf16_t*)(F.out + (size_t)TH * D);
    const int gw = launder_s(F.vcu * NWAVES + F.wave), NGW = F.G * NWAVES;
    f32x4 v[4], vn[4];
    if (gw < T) { const f32x4* xr = (const f32x4*)(F.x + (size_t)gw * D) + F.lane;
#pragma unroll
        for (int j = 0; j < 4; ++j) v[j] = xr[64 * j]; }
    for (int t = gw; t < T; t += NGW) {
        const int b = t >> 12;
        f32x4 gs[4], sh[4];
#pragma unroll
        for (int j = 0; j < 4; ++j) { const int col = 4 * F.lane + 256 * j;
            const f32x4 g = *(const f32x4*)(F.norm_mix + col), sc = *(const f32x4*)(mod + (size_t)b * 6144 + 1024 + col); sh[j] = *(const f32x4*)(mod + (size_t)b * 6144 + col); gs[j] = g * (sc + 1.0f); }
        if (t + NGW < T) { const f32x4* xr = (const f32x4*)(F.x + (size_t)(t + NGW) * D) + F.lane;
#pragma unroll
            for (int j = 0; j < 4; ++j) vn[j] = xr[64 * j]; }
        float s = 0.f;
#pragma unroll
        for (int j = 0; j < 4; ++j) s += (v[j].x * v[j].x + v[j].y * v[j].y) + (v[j].z * v[j].z + v[j].w * v[j].w);
        const float rstd = 1.0f / sqrtf(wave_sum(s) * (1.0f / D) + EPS);
        u32x2* o8 = (u32x2*)((t < TH ? H0 : H1) + (size_t)(t & (TH - 1)) * D) + F.lane;
#pragma unroll
        for (int j = 0; j < 4; ++j) { const f32x4 y = (v[j] * rstd) * gs[j] + sh[j]; u32x2 w; w.x = cvt_pk_bf16(y.x, y.y); w.y = cvt_pk_bf16(y.z, y.w);
            o8[64 * j] = w; }
#pragma unroll
        for (int j = 0; j < 4; ++j) v[j] = vn[j];
    }
}

__device__ __forceinline__ void p3_mix(Frame& F, int hf) {
    F.lane = lane_now(); F.tid = F.wave * 64 + F.lane;
    MixArgs A; A.proj = (const bf16_t*)(F.ws + WS_PROJ); A.act = (bf16_t*)(F.ws + WS_ACT); A.diff_norm = F.diff_norm; A.ssq = (float*)(F.ws + WS_SSQ);
    A.lam = __uint_as_float(__builtin_amdgcn_readfirstlane(*(const unsigned*)(F.ws + WS_MOD + 256 * 1024)));
    unsigned* qbase = (unsigned*)(F.ws + WS_CTL) + CW_Q + 64 * 16 + 64 * 8 * hf;
    volatile LAS int* bc = (volatile LAS int*)(F.lds + LDSCTL_OFF + 64);
    const int x0 = (int)(xb_xcc_id() & 7u);
    int curk = 0; bool havepre = false;
    for (;;) {
        __syncthreads();
        if (F.wave == 0) {
            const int lane = lane_now();
            int u = -1, xq = (x0 + curk) & 7;
            for (int it = 0; it < 64; ++it) {
                int got = -1;
                if (havepre) got = bc[2];
                else if (lane == 0) got = (int)__hip_atomic_fetch_add(qbase + 64 * xq, 1u, __ATOMIC_RELAXED, __HIP_MEMORY_SCOPE_AGENT);
                havepre = false;
                got = __builtin_amdgcn_readfirstlane(got);
                if (got < 4 + 64) { u = got; break; }
                unsigned c = 4u + 64u;
                if (lane < 8) c = __hip_atomic_load(qbase + 64 * ((x0 + lane) & 7), __ATOMIC_RELAXED, __HIP_MEMORY_SCOPE_AGENT);
                const unsigned long long m = __builtin_amdgcn_ballot_w64(lane < 8 && c < 4u + 64u);
                if (m == 0ull) break;
                xq = (x0 + (int)__builtin_ctzll(m)) & 7;
            }
            curk = (xq - x0) & 7;
            if (lane == 0) { bc[0] = u; bc[1] = xq; }
        }
        __syncthreads();
        const int u = __builtin_amdgcn_readfirstlane(bc[0]), xq = __builtin_amdgcn_readfirstlane(bc[1]);
        if (u < 0) break;
#ifndef MIX_NO_RET
        if (u < 4) { const int bh = 2 * xq + (u >> 1); ret_unit(F.lds, F.wave, A, bh >> 2, bh & 3, u & 1); }
#endif
#ifndef MIX_NO_ATTN
        if (u >= 4) { const int v = u - 4, qb = 31 - (v >> 1), bh = 2 * xq + (v & 1);
            int pre = 0;
            if (F.wave == 0 && lane_now() == 0) pre = (int)__hip_atomic_fetch_add(qbase + 64 * xq, 1u, __ATOMIC_RELAXED, __HIP_MEMORY_SCOPE_AGENT);
            attn_unit(F.lds, F.wave, A, bh >> 2, bh & 3, qb, pre, bc + 2);
            havepre = true; }
#endif
    }
    convert_experts(F);
}

typedef float f32x4v __attribute__((ext_vector_type(4)));
__device__ __forceinline__ void p6_router(Frame& F, bool dummy) {
    F.lane = lane_now(); F.tid = F.wave * 64 + F.lane;
    const float* mod = (const float*)(F.ws + WS_MOD); const bf16_t* rth = (const bf16_t*)(F.ws + WS_MOD + 512 * 1024); const bf16_t* rtl = rth + 48 * D;
    unsigned char* H2 = F.ws + WS_H2; const float* x1 = F.x;
    const size_t rbase = dummy ? WS_EACT : WS_ROUT;
    int* tok_e = (int*)(F.ws + rbase); float* tok_w = (float*)(F.ws + rbase + 256 * 1024); int* tok_slot = (int*)(F.ws + rbase + 512 * 1024); int* list = (int*)(F.ws + rbase + 1024 * 1024);
    unsigned* cnt = (unsigned*)(F.ws + WS_CTL) + CW_CNT + (dummy ? 64 : 0);
    LAS int* hist = (LAS int*)(F.lds + LDSCTL_OFF + 256);
    constexpr int RSTR = 4112;
    LAS unsigned char* Xt = F.lds;
    LAS float* part = (LAS float*)(F.lds + 65792);
    LAS float* lgt = (LAS float*)(F.lds + 65792 + 24576);
    unsigned* ghist = (unsigned*)(F.ws + rbase + 768 * 1024);
    for (int tb = blockIdx.x; tb < T / 128; tb += F.G) {
        if (F.tid < 64) hist[F.tid] = 0;
        bf16x8 bwh[4][3], bwl[4][3];
        { const int ln = launder_i(F.lane), r = ln & 15, kq = ln >> 4, k0 = 128 * F.wave + 8 * kq;
#pragma unroll
          for (int g = 0; g < 4; ++g)
#pragma unroll
              for (int nb = 0; nb < 3; ++nb) { const unsigned wi = (unsigned)((16 * nb + r) * D + k0 + 32 * g); bwh[g][nb] = *(const bf16x8*)(rth + wi); bwl[g][nb] = *(const bf16x8*)(rtl + wi); } }
        f32x4 v[2][4]; u32x2 dv[2][4];
        const unsigned char* dbase = F.ws + delta_off(tb * 128);
#pragma unroll
        for (int q = 0; q < 2; ++q) { const f32x4* xr = (const f32x4*)(x1 + (size_t)(tb * 128 + 2 * F.wave + q) * D) + F.lane; const u32x2* dr = (const u32x2*)(dbase + (size_t)(2 * F.wave + q) * 2048) + F.lane;
#pragma unroll
            for (int j = 0; j < 4; ++j) { v[q][j] = xr[64 * j]; dv[q][j] = dr[64 * j]; } }
        LAS f32x4* gsl = (LAS f32x4*)(F.lds + 114944);
        if (F.wave == 0) { const int b = (tb * 128) >> 12;
#pragma unroll
          for (int j = 0; j < 4; ++j) { const int col = 4 * F.lane + 256 * j;
              const f32x4 g = *(const f32x4*)(F.norm_ffn + col), sc = *(const f32x4*)(mod + (size_t)b * 6144 + 4096 + col), sh = *(const f32x4*)(mod + (size_t)b * 6144 + 3072 + col);
              gsl[F.lane + 64 * j] = g * (sc + 1.0f); gsl[256 + F.lane + 64 * j] = sh; } }
        __syncthreads();
        for (int ps = 0; ps < 8; ++ps) {
#pragma unroll
            for (int q = 0; q < 2; ++q) {
                const int tk = 2 * F.wave + q, t = tb * 128 + ps * 16 + tk;
#pragma unroll
                for (int j = 0; j < 4; ++j) { const u32x2 d = dv[q][j]; v[q][j].x += bf_lo(d.x); v[q][j].y += bf_hi(d.x); v[q][j].z += bf_lo(d.y); v[q][j].w += bf_hi(d.y); }
                float s = 0.f;
#pragma unroll
                for (int j = 0; j < 4; ++j) s += (v[q][j].x * v[q][j].x + v[q][j].y * v[q][j].y) + (v[q][j].z * v[q][j].z + v[q][j].w * v[q][j].w);
                const float rstd = 1.0f / sqrtf(wave_sum(s) * (1.0f / D) + EPS);
                unsigned* o4 = (unsigned*)(H2 + (size_t)t * D) + F.lane;
#pragma unroll
                for (int j = 0; j < 4; ++j) {
                    const int col = 4 * F.lane + 256 * j;
                    const f32x4 y = (v[q][j] * rstd) * gsl[F.lane + 64 * j] + gsl[256 + F.lane + 64 * j];
                    o4[64 * j] = pk4_fp8(y.x, y.y, y.z, y.w);
                    *(LAS f32x4*)(Xt + tk * RSTR + col * 4) = y;
                }
            }
            if (ps + 1 < 8) {
#pragma unroll
                for (int q = 0; q < 2; ++q) { const f32x4* xr = (const f32x4*)(x1 + (size_t)(tb * 128 + (ps + 1) * 16 + 2 * F.wave + q) * D) + F.lane; const u32x2* dr = (const u32x2*)(dbase + (size_t)((ps + 1) * 16 + 2 * F.wave + q) * 2048) + F.lane;
#pragma unroll
                    for (int j = 0; j < 4; ++j) { v[q][j] = xr[64 * j]; dv[q][j] = dr[64 * j]; } }
            }
            __syncthreads();
            {
                const int r = F.lane & 15, kq = F.lane >> 4, k0 = 128 * F.wave + 8 * kq;
                f32x4v acc[3];
#pragma unroll
                for (int nb = 0; nb < 3; ++nb) acc[nb] = (f32x4v){0.f, 0.f, 0.f, 0.f};
#pragma unroll
                for (int g = 0; g < 4; ++g) {
                    const f32x4 a0 = *(const LAS f32x4*)(Xt + r * RSTR + (k0 + 32 * g) * 4), a1 = *(const LAS f32x4*)(Xt + r * RSTR + (k0 + 32 * g + 4) * 4);
                    unsigned hp[4], lp[4];
#pragma unroll
                    for (int q = 0; q < 4; ++q) { const float x0 = (q < 2) ? a0[2 * q] : a1[2 * q - 4], x1 = (q < 2) ? a0[2 * q + 1] : a1[2 * q - 3];
                        hp[q] = cvt_pk_bf16(x0, x1); lp[q] = cvt_pk_bf16(x0 - bf_lo(hp[q]), x1 - bf_hi(hp[q])); }
                    const bf16x8 ah = __builtin_bit_cast(bf16x8, (u32x4){hp[0], hp[1], hp[2], hp[3]}), al = __builtin_bit_cast(bf16x8, (u32x4){lp[0], lp[1], lp[2], lp[3]});
#pragma unroll
                    for (int nb = 0; nb < 3; ++nb) {
                        acc[nb] = __builtin_amdgcn_mfma_f32_16x16x32_bf16(ah, bwh[g][nb], acc[nb], 0, 0, 0);
                        acc[nb] = __builtin_amdgcn_mfma_f32_16x16x32_bf16(ah, bwl[g][nb], acc[nb], 0, 0, 0);
                        acc[nb] = __builtin_amdgcn_mfma_f32_16x16x32_bf16(al, bwh[g][nb], acc[nb], 0, 0, 0);
                    }
                }
#pragma unroll
                for (int nb = 0; nb < 3; ++nb)
#pragma unroll
                    for (int e = 0; e < 4; ++e) part[(F.wave * 16 + 4 * kq + e) * 48 + 16 * nb + r] = acc[nb][e];
            }
            __syncthreads();
            for (int idx = F.tid; idx < 16 * 36; idx += NTHR) { const int tk = idx / 36, o = idx - tk * 36; float s = 0.f;
#pragma unroll
                for (int w = 0; w < 8; ++w) s += part[(w * 16 + tk) * 48 + o];
                lgt[(ps * 16 + tk) * 48 + o] = s; }
        }
        __syncthreads();
        if (F.tid < 128) {
            const int t = tb * 128 + F.tid;
            float lg[36];
#pragma unroll
            for (int o = 0; o < 36; ++o) lg[o] = lgt[F.tid * 48 + o];
            float gl[4];
#pragma unroll
            for (int g = 0; g < 4; ++g) gl[g] = lg[g] + F.b_rg[g];
            int gs = 0; float gm = gl[0];
#pragma unroll
            for (int g = 1; g < 4; ++g) if (gl[g] > gm) { gm = gl[g]; gs = g; }
            float gden = 0.f;
#pragma unroll
            for (int g = 0; g < 4; ++g) gden += __expf(gl[g] - gm);
            const float gtop = 1.0f / gden;
            float el[8];
#pragma unroll
            for (int j = 0; j < 8; ++j) {
                const float v0 = lg[4 + j], v1 = lg[12 + j], v2 = lg[20 + j], v3 = lg[28 + j];
                el[j] = ((gs == 0) ? v0 : (gs == 1) ? v1 : (gs == 2) ? v2 : v3) + F.b_re[gs * 8 + j];
            }
            int e1 = 0; float m1 = el[0];
#pragma unroll
            for (int j = 1; j < 8; ++j) if (el[j] > m1) { m1 = el[j]; e1 = j; }
            int e2 = -1; float m2 = -INFINITY;
#pragma unroll
            for (int j = 0; j < 8; ++j) if (j != e1 && el[j] > m2) { m2 = el[j]; e2 = j; }
            const float w1 = 1.0f / (1.0f + __expf(m2 - m1)), w2 = 1.0f - w1;
            const int ea = gs * 8 + e1, eb = gs * 8 + e2;
            tok_e[2 * t] = ea; tok_e[2 * t + 1] = eb; tok_w[2 * t] = gtop * w1; tok_w[2 * t + 1] = gtop * w2;
            tok_slot[2 * t] = __hip_atomic_fetch_add(&hist[ea], 1, __ATOMIC_RELAXED, __HIP_MEMORY_SCOPE_WORKGROUP); tok_slot[2 * t + 1] = __hip_atomic_fetch_add(&hist[eb], 1, __ATOMIC_RELAXED, __HIP_MEMORY_SCOPE_WORKGROUP);
        }
        __syncthreads();
        if (F.tid < 32) ghist[tb * 32 + F.tid] = (unsigned)hist[F.tid];
        __syncthreads();
    }
}
__device__ __forceinline__ void p6b_lists(Frame& F) {
    F.lane = lane_now(); F.tid = F.wave * 64 + F.lane;
    const int* tok_e = (const int*)(F.ws + WS_ROUT); int* tok_slot = (int*)(F.ws + WS_ROUT + 512 * 1024); int* list = (int*)(F.ws + WS_ROUT + 1024 * 1024);
    const unsigned* ghist = (const unsigned*)(F.ws + WS_ROUT + 768 * 1024);
    unsigned* cnt = (unsigned*)(F.ws + WS_CTL) + CW_CNT;
    LAS int* red = (LAS int*)(F.lds + LDSCTL_OFF + 256);
    for (int tb = blockIdx.x; tb < T / 128; tb += F.G) {
        __syncthreads();
        { const int e = F.tid & 31, pt = F.tid >> 5; int s = 0, tot = 0;
          int cv[T / 128 / 16];
#pragma unroll
          for (int q = 0; q < T / 128 / 16; ++q) cv[q] = (int)ghist[(pt + 16 * q) * 32 + e];
#pragma unroll
          for (int q = 0; q < T / 128 / 16; ++q) { tot += cv[q]; if (pt + 16 * q < tb) s += cv[q]; }
          red[pt * 32 + e] = s; red[1024 + pt * 32 + e] = tot; }
        __syncthreads();
        if (F.tid < 32) { int s = 0, tot = 0;
#pragma unroll
            for (int pt = 0; pt < 16; ++pt) { s += red[pt * 32 + F.tid]; tot += red[1024 + pt * 32 + F.tid]; }
            red[512 + F.tid] = s; if (tb == 0) cnt[F.tid] = (unsigned)tot; }
        __syncthreads();
        if (F.tid < 256) {
            const int a = tb * 256 + F.tid, e = tok_e[a], slot = red[512 + e] + tok_slot[a];
            tok_slot[a] = slot; list[(size_t)e * T + slot] = a;
        }
    }
}

__device__ __forceinline__ void moe_table(Frame& F, LAS int* rbs) {
    F.lane = lane_now(); F.tid = F.wave * 64 + F.lane;
    const unsigned* cnt = (const unsigned*)(F.ws + WS_CTL) + CW_CNT;
    if (F.wave == 0) {
        const int e = F.lane;
        int c = 0;
        if (e < NEXP) { c = (int)__hip_atomic_load(cnt + e, __ATOMIC_RELAXED, __HIP_MEMORY_SCOPE_AGENT); rbs[64 + e] = c; }
        asm volatile("s_waitcnt lgkmcnt(0)" ::: "memory");
        if (e < NEXP) {
            int a = 0;
            for (int j = 0; j < e; ++j) a += (rbs[64 + j] + 255) >> 8;
            const int nb = (c + 255) >> 8;
            rbs[e] = a;
            for (int q = 0; q < nb; ++q) rbs[128 + a + q] = e;
            if (e == NEXP - 1) rbs[32] = a + nb;
        }
    }
    __syncthreads();
}

__device__ __forceinline__ void p9_final(Frame& F, const LAS int* rbs, bool dummy) {
    F.lane = lane_now(); F.tid = F.wave * 64 + F.lane;
    const float* mod = (const float*)(F.ws + WS_MOD); const unsigned char* Y = F.ws + WS_Y;
    const float* X = F.x;
    const int* tok_e = (const int*)(F.ws + WS_ROUT); const int* tok_slot = (const int*)(F.ws + WS_ROUT + 512 * 1024);
    const int gw = launder_s(F.vcu * NWAVES + F.wave), NGW = F.G * NWAVES;
    f32x4 ng[4];
#pragma unroll
    for (int j = 0; j < 4; ++j) ng[j] = *(const f32x4*)(F.norm_final + 4 * F.lane + 256 * j);
    f32x4 xv[4], xn[4]; unsigned ya[4], yb[4], yan[4], ybn[4]; u32x2 da[4], dn[4];
    int e0n = 0, e1n = 0, s0n = 0, s1n = 0;
    if (gw < T) {
        const int p0 = rbs[tok_e[2 * gw]] * 256 + tok_slot[2 * gw], p1 = rbs[tok_e[2 * gw + 1]] * 256 + tok_slot[2 * gw + 1];
        const f32x4* xr = (const f32x4*)(X + (size_t)gw * D) + F.lane; const unsigned* y0 = (const unsigned*)(Y + (size_t)p0 * D) + F.lane; const unsigned* y1 = (const unsigned*)(Y + (size_t)p1 * D) + F.lane;
        const u32x2* dr = (const u32x2*)(F.ws + delta_off(gw)) + F.lane;
#pragma unroll
        for (int j = 0; j < 4; ++j) { xv[j] = xr[64 * j]; ya[j] = y0[64 * j]; yb[j] = y1[64 * j]; da[j] = dr[64 * j]; }
        if (gw + NGW < T) { const int tn = gw + NGW; e0n = tok_e[2 * tn]; e1n = tok_e[2 * tn + 1]; s0n = tok_slot[2 * tn]; s1n = tok_slot[2 * tn + 1]; }
    }
    for (int t = gw; t < T; t += NGW) {
        const int b = t >> 12;
        f32x4 g2[4];
#pragma unroll
        for (int j = 0; j < 4; ++j) g2[j] = *(const f32x4*)(mod + (size_t)b * 6144 + 5120 + 4 * F.lane + 256 * j);
        if (t + NGW < T) {
            const int tn = t + NGW, p0 = rbs[e0n] * 256 + s0n, p1 = rbs[e1n] * 256 + s1n;
            const f32x4* xr = (const f32x4*)(X + (size_t)tn * D) + F.lane; const unsigned* y0 = (const unsigned*)(Y + (size_t)p0 * D) + F.lane; const unsigned* y1 = (const unsigned*)(Y + (size_t)p1 * D) + F.lane;
            const u32x2* dr = (const u32x2*)(F.ws + delta_off(tn)) + F.lane;
#pragma unroll
            for (int j = 0; j < 4; ++j) { xn[j] = xr[64 * j]; yan[j] = y0[64 * j]; ybn[j] = y1[64 * j]; dn[j] = dr[64 * j]; }
            if (tn + NGW < T) { const int t2 = tn + NGW; e0n = tok_e[2 * t2]; e1n = tok_e[2 * t2 + 1]; s0n = tok_slot[2 * t2]; s1n = tok_slot[2 * t2 + 1]; }
        }
        f32x4 v[4]; float s = 0.f;
#pragma unroll
        for (int j = 0; j < 4; ++j) {
            const int a = (int)ya[j], c = (int)yb[j];
            const f32x2 a0 = __builtin_amdgcn_cvt_pk_f32_fp8(a, false), a1 = __builtin_amdgcn_cvt_pk_f32_fp8(a, true), c0 = __builtin_amdgcn_cvt_pk_f32_fp8(c, false), c1 = __builtin_amdgcn_cvt_pk_f32_fp8(c, true);
            f32x4 y; y.x = (a0.x + c0.x) * 0.0625f; y.y = (a0.y + c0.y) * 0.0625f; y.z = (a1.x + c1.x) * 0.0625f; y.w = (a1.y + c1.y) * 0.0625f;
            const u32x2 dd = da[j]; const f32x4 dl = {bf_lo(dd.x), bf_hi(dd.x), bf_lo(dd.y), bf_hi(dd.y)};
            v[j] = (xv[j] + dl) + g2[j] * y;
            s += (v[j].x * v[j].x + v[j].y * v[j].y) + (v[j].z * v[j].z + v[j].w * v[j].w);
        }
        const float rstd = 1.0f / sqrtf(wave_sum(s) * (1.0f / D) + EPS);
        f32x4* xo = dummy ? (f32x4*)((float*)(F.ws + WS_H2) + (size_t)t * D) + F.lane : (f32x4*)(F.out + (size_t)t * D) + F.lane;
#pragma unroll
        for (int j = 0; j < 4; ++j) __builtin_nontemporal_store(v[j] * rstd * ng[j], xo + 64 * j);
#pragma unroll
        for (int j = 0; j < 4; ++j) { xv[j] = xn[j]; ya[j] = yan[j]; yb[j] = ybn[j]; da[j] = dn[j]; }
    }
}

constexpr int MOE_MAXU = 8;
__device__ __forceinline__ void moe_unit_tables(Frame& F, const LAS int* rbs, int nunits, bool weights) {
    const int tid = tid_now(F.wave);
    const int* list = (const int*)(F.ws + WS_ROUT + 1024 * 1024); const float* tokw = (const float*)(F.ws + WS_ROUT + 256 * 1024);
    LAS unsigned short* tokl = (LAS unsigned short*)(F.lds + LDSCTL_OFF + 4096); LAS float* wl = (LAS float*)(F.lds + LDSCTL_OFF + 8192);
    int av[MOE_MAXU / 2]; bool live[MOE_MAXU / 2], inr[MOE_MAXU / 2];
#pragma unroll
    for (int q = 0; q < MOE_MAXU / 2; ++q) {
        const int j = 2 * q + (tid >> 8), r = tid & 255, L = j * F.G + F.vcu;
        live[q] = L < nunits; inr[q] = false; av[q] = 0;
        if (live[q]) {
            const int rbi = L >> 2, e = rbs[128 + rbi], sl = (rbi - rbs[e]) * 256 + r, ce = rbs[64 + e];
            inr[q] = sl < ce;
            av[q] = list[(size_t)e * T + (inr[q] ? sl : 0)];
        }
    }
    float wv[MOE_MAXU / 2];
#pragma unroll
    for (int q = 0; q < MOE_MAXU / 2; ++q) wv[q] = (weights && live[q] && inr[q]) ? tokw[av[q]] * 0.5f : 0.f;
#pragma unroll
    for (int q = 0; q < MOE_MAXU / 2; ++q) {
        const int j = 2 * q + (tid >> 8), r = tid & 255;
        if (live[q]) { if (weights) wl[j * 256 + r] = wv[q]; else tokl[j * 256 + r] = (unsigned short)(av[q] >> 1); }
    }
    __syncthreads();
}

constexpr int N_PHASES = 16;
template <unsigned PHM>
__global__ void __launch_bounds__(NTHR, 2) fwd(Args args) {
    extern __shared__ __attribute__((aligned(16))) unsigned char lds_raw[];
    Frame F;
    F.lds = (LAS unsigned char*)lds_raw;
    F.tid = threadIdx.x; F.lane = F.tid & 63; F.wave = __builtin_amdgcn_readfirstlane(F.tid >> 6);
    F.G = gridDim.x; { const int bx = blockIdx.x; F.vcu = (F.G % 8 == 0) ? (bx % 8) * (F.G / 8) + bx / 8 : bx; }
    F.x = (const float*)args.in[0]; F.c = (const float*)args.in[1]; F.positions = (const int*)args.in[2]; F.w_ada = (const float*)args.in[3]; F.b_ada = (const float*)args.in[4];
    F.norm_mix = (const float*)args.in[5]; F.w_in = (const float*)args.in[6]; F.w_ret_o = (const float*)args.in[7]; F.w_diff_o = (const float*)args.in[8];
    F.lq1 = (const float*)args.in[9]; F.lk1 = (const float*)args.in[10]; F.lq2 = (const float*)args.in[11]; F.lk2 = (const float*)args.in[12]; F.diff_norm = (const float*)args.in[13];
    F.w_out = (const float*)args.in[14]; F.norm_ffn = (const float*)args.in[15]; F.w_rg = (const float*)args.in[16]; F.b_rg = (const float*)args.in[17]; F.w_re = (const float*)args.in[18]; F.b_re = (const float*)args.in[19];
    F.w_eg = (const float*)args.in[20]; F.w_eu = (const float*)args.in[21]; F.w_ed = (const float*)args.in[22]; F.norm_final = (const float*)args.in[23];
    F.out = args.out; F.ws = args.ws;
    for (int u = F.tid; u < (LDS_BYTES - LDSCTL_OFF) / 4; u += NTHR) ((LAS unsigned*)(F.lds + LDSCTL_OFF))[u] = 0u;
    __syncthreads();
    const int lo = args.ph_lo, hi = args.ph_hi;
    const bool use_bar = (hi - lo) > 1;
    XcdBarrier bar; bar.bar = (unsigned*)(F.ws + WS_CTL) + CW_BAR; bar.x = 0; bar.st = (volatile LAS unsigned*)(F.lds + LDSCTL_OFF);
    if (use_bar) bar = xcd_barrier_post((unsigned*)(F.ws + WS_CTL) + CW_BAR, (volatile LAS unsigned*)(F.lds + LDSCTL_OFF));
    bar.wave = F.wave;
#ifndef PROBE_DUP
#define PROBE_DUP 0u
#endif
#ifndef PROBE_MODE
#define PROBE_MODE 0
#endif
#define NREP(ty) ((((PROBE_DUP) >> (ty)) & 1u) ? 2 : 1)
#define INP(ty, k) ((((PHM) >> (ty)) & 1u) && lo <= (k) && (k) < hi)
#define INPL(ty, k) ((((PHM) >> (ty)) & 1u) && launder_s(lo) <= (k) && (k) < launder_s(hi))
#define IN(k) (lo <= (k) && (k) < hi)
#define SEAM(k) do { if (IN(k) && IN((k) + 1)) xcd_barrier(bar); } while (0)
    LAS int* rbs = (LAS int*)(F.lds + LDSCTL_OFF + 1024);

    if (INP(0, 0)) { for (int rep = 0; rep < NREP(0); ++rep) p0_prologue(F); SEAM(0); }
    for (int hf = 0; hf < 2; ++hf) {
        const int pb = 1 + 5 * hf;
        if (INP(1, pb) && hf == 0) { for (int rep = 0; rep < NREP(1); ++rep) p1_norm_mod(F); SEAM(pb); }
        if (INP(2, pb + 1)) {
            pg8::StaticOrder S; S.init(hf ? (const void*)(F.out + (size_t)TH * D) : (const void*)(F.ws + WS_H), F.ws + WS_WIN, TH, DIN, D, F.G, (int)blockIdx.x);
            pg8::EpiProj E{(bf16_t*)(F.ws + WS_PROJ), (const float*)(F.ws + WS_COS) + (size_t)hf * TH * 64, (const float*)(F.ws + WS_SIN) + (size_t)hf * TH * 64, 0};
            for (int rep = 0; rep < NREP(2); ++rep) { E.pmode = (rep + 1 < NREP(2)) ? PROBE_MODE : 0; pg8::gemm_phase<pg8::EpiProj, pg8::StaticOrder, true, false>(F.lds, F.wave, D, S, E); }
            SEAM(pb + 1);
        }
        if (INP(3, pb + 2)) { for (int rep = 0; rep < NREP(3); ++rep) p3_mix(F, hf + 2 * rep); SEAM(pb + 2); }
        if (INP(4, pb + 3)) {
            pg8::StaticOrder S; S.init(F.ws + WS_ACT, F.ws + WS_WMIX, TH, D, 2048, F.G, (int)blockIdx.x);
            LAS float* rst = (LAS float*)(F.lds + LDSCTL_OFF + 8192);
            for (int ui = 0; ; ++ui) {
                pg8::Unit u0; if (!S.next(ui, u0)) break;
                const int tl = tid_now(F.wave);
                { const float* sq = (const float*)(F.ws + WS_SSQ);
                  if (tl < 256) { float r[4];
#pragma unroll
                    for (int hd = 0; hd < 4; ++hd) { const f32x4* p = (const f32x4*)(sq + ((size_t)(u0.pm * 256 + tl) * 4 + hd) * 8); const f32x4 a = p[0], b = p[1];
                        r[hd] = 1.0f / sqrtf((((a.x + a.y) + (a.z + a.w)) + ((b.x + b.y) + (b.z + b.w))) * (1.0f / 256.0f) + EPS); }
                    rst[tl] = r[0] / r[1]; rst[256 + tl] = r[1] / r[2]; rst[512 + tl] = r[2] / r[3]; rst[768 + tl] = r[3]; } }
                __syncthreads();
                pg8::EpiMerged E{(const bf16_t*)(F.ws + WS_PROJ), (bf16_t*)(F.ws + WS_H), (const LAS float*)rst};
                pg8::OneUnit<pg8::StaticOrder> S1{S, ui};
                for (int rep = 0; rep < NREP(4); ++rep) pg8::gemm_phase<pg8::EpiMerged, pg8::OneUnit<pg8::StaticOrder>, false, false>(F.lds, F.wave, 2048, S1, E);
                __syncthreads();
            }
            SEAM(pb + 3);
        }
        if (INP(5, pb + 4)) {
            pg8::StaticOrder S; S.init(F.ws + WS_H, F.ws + WS_WOUT, TH, D, D, F.G, (int)blockIdx.x);
            pg8::EpiWout E{F.ws, (const float*)(F.ws + WS_MOD), hf * TH};
            for (int rep = 0; rep < NREP(5); ++rep) pg8::gemm_phase<pg8::EpiWout, pg8::StaticOrder, false, false>(F.lds, F.wave, D, S, E);
            if (hf == 1) SEAM(pb + 4);
        }
    }
    if (INPL(6, 11)) { for (int rep = 0; rep < NREP(6); ++rep) p6_router(F, rep + 1 < NREP(6)); SEAM(11); }
    if (INPL(10, 12)) { convert_experts(F); p6b_lists(F); SEAM(12); }
    if (INPL(7, 13)) {
        moe_table(F, rbs);
        const int nunits = __builtin_amdgcn_readfirstlane(rbs[32]) * 4;
        moe_unit_tables(F, rbs, nunits, false);
        pg8::MoeOrder S{F.G, F.vcu, 512, nunits, 1, rbs, (const LAS unsigned short*)(F.lds + LDSCTL_OFF + 4096), (const char*)(F.ws + WS_H2), (const char*)(F.ws + WS_WGU), (size_t)1024 * 1024};
        pg8::EpiGU E{F.ws + WS_EACT};
        for (int rep = 0; rep < NREP(7); ++rep) pg8::gemm_phase<pg8::EpiGU, pg8::MoeOrder, true, true, true>(F.lds, F.wave, launder_s(512), S, E);
        SEAM(13);
    }
    if (INPL(8, 14)) {
        moe_table(F, rbs);
        const int nunits = __builtin_amdgcn_readfirstlane(rbs[32]) * 4;
        moe_unit_tables(F, rbs, nunits, true);
        pg8::MoeOrder S{F.G, F.vcu, 256, nunits, 0, rbs, (const LAS unsigned short*)(F.lds + LDSCTL_OFF + 4096), (const char*)(F.ws + WS_EACT), (const char*)(F.ws + WS_WDN), (size_t)1024 * 512};
        pg8::EpiDown E{F.ws + WS_Y, (const LAS float*)(F.lds + LDSCTL_OFF + 8192)};
        for (int rep = 0; rep < NREP(8); ++rep) pg8::gemm_phase<pg8::EpiDown, pg8::MoeOrder, true, false, true>(F.lds, F.wave, launder_s(256), S, E);
        SEAM(14);
    }
    if (INPL(9, 15)) { moe_table(F, rbs); for (int rep = 0; rep < NREP(9); ++rep) p9_final(F, rbs, rep + 1 < NREP(9)); }
#undef IN
#undef INP
#undef INPL
#undef SEAM
}

#ifndef MK_ONE_LAUNCH
#define MK_ONE_LAUNCH 1
#endif
#if !MK_ONE_LAUNCH
typedef void (*KernFn)(Args);
static KernFn phase_kernel(int p) {
    const int ty = (p == 0) ? 0 : (p <= 10) ? 1 + (p - 1) % 5 : (p == 11) ? 6 : (p == 12) ? 10 : p - 6;
    switch (ty) {
        case 0: return fwd<1u << 0>; case 1: return fwd<1u << 1>; case 2: return fwd<1u << 2>; case 3: return fwd<1u << 3>; case 4: return fwd<1u << 4>;
        case 5: return fwd<1u << 5>; case 6: return fwd<1u << 6>; case 7: return fwd<1u << 7>; case 8: return fwd<1u << 8>; case 9: return fwd<1u << 9>; default: return fwd<1u << 10>;
    }
}
#endif
extern "C" void kernel_launch(void* const* d_in, const int* in_sizes, int n_in, void* d_out, int out_size, void* d_ws, size_t ws_size, hipStream_t stream) {
    static int grid = 0;
    if (grid == 0) {
        if (n_in != 24 || out_size != T * D || ws_size < WS_END) { fprintf(stderr, "kernel_launch: unexpected problem (n_in %d, out %d, ws %zu < %zu); nothing launched\n", n_in, out_size, ws_size, (size_t)WS_END); grid = -1; return; }
        int dev = 0, cus = 0;
        if (hipGetDevice(&dev) != hipSuccess || hipDeviceGetAttribute(&cus, hipDeviceAttributeMultiprocessorCount, dev) != hipSuccess) { grid = -1; return; }
#if MK_ONE_LAUNCH
        if (hipFuncSetAttribute((const void*)fwd<0x7FFu>, hipFuncAttributeMaxDynamicSharedMemorySize, LDS_BYTES) != hipSuccess) { grid = -1; return; }
#else
        for (int p = 0; p < N_PHASES; ++p)
            if (hipFuncSetAttribute((const void*)phase_kernel(p), hipFuncAttributeMaxDynamicSharedMemorySize, LDS_BYTES) != hipSuccess) { fprintf(stderr, "kernel_launch: hipFuncSetAttribute failed\n"); grid = -1; return; }
#endif
        (void)hipGetLastError();
        grid = cus;
    }
    if (grid < 0) return;
    (void)hipMemsetAsync((char*)d_ws + WS_CTL, 0, CTL_ZERO_BYTES, stream);
    Args a{};
    for (int i = 0; i < 24; ++i) a.in[i] = d_in[i];
    a.out = (float*)d_out; a.ws = (unsigned char*)d_ws;
#if MK_ONE_LAUNCH
    a.ph_lo = 0; a.ph_hi = N_PHASES;
    hipLaunchKernelGGL(fwd<0x7FFu>, dim3(grid), dim3(NTHR), LDS_BYTES, stream, a);
#else
    for (int p = 0; p < N_PHASES; ++p) { a.ph_lo = p; a.ph_hi = p + 1; hipLaunchKernelGGL(phase_kernel(p), dim3(grid), dim3(NTHR), LDS_BYTES, stream, a); }
#endif
}
```

```cpp
#include <hip/hip_runtime.h>
#include <cstdio>
#include <cstdint>

#define GAS __attribute__((address_space(1)))
#define LAS __attribute__((address_space(3)))
typedef unsigned short bf16_t;
typedef short bf16x8 __attribute__((ext_vector_type(8)));
typedef short s16x4 __attribute__((ext_vector_type(4)));
typedef float f32x4 __attribute__((ext_vector_type(4)));
typedef float f32x2 __attribute__((ext_vector_type(2)));
typedef float f32x16 __attribute__((ext_vector_type(16)));
typedef unsigned u32x4 __attribute__((ext_vector_type(4)));
typedef unsigned u32x2 __attribute__((ext_vector_type(2)));

constexpr int T = 32768, D = 1024, SEQ = 4096, NB = 8, DIN = 8192, TH = 16384, NWAVES = 8, NTHR = 512;
constexpr int NEXP = 32, DEXP = 512;
constexpr float EPS = 1e-6f;
constexpr int PROW_MAX = 65536 + NEXP * 256;

constexpr size_t MiB = 1u << 20;
constexpr size_t WS_CTL = 0, CTL_ZERO_BYTES = 64 * 1024;
constexpr size_t WS_MOD = 1 * MiB;
constexpr size_t WS_COS = 2 * MiB, WS_SIN = 10 * MiB;
constexpr size_t WS_WIN = 18 * MiB;
constexpr size_t WS_WMIX = 34 * MiB;
constexpr size_t WS_WOUT = 38 * MiB;
constexpr size_t WS_WGU = 40 * MiB;
constexpr size_t WS_WDN = 104 * MiB;
constexpr size_t WS_H = 136 * MiB;
constexpr size_t WS_ACT = 168 * MiB;
constexpr size_t WS_PROJ = 232 * MiB;
constexpr size_t WS_H2 = 168 * MiB;
constexpr size_t WS_EACT = 232 * MiB;
constexpr size_t WS_Y = 304 * MiB;
constexpr size_t WS_ROUT = 488 * MiB;
constexpr size_t WS_SSQ = 494 * MiB;
constexpr size_t WS_DELTA_A = 72 * MiB, WS_DELTA_B = 120 * MiB, WS_DELTA_C = 496 * MiB;
constexpr size_t WS_END = 512 * MiB;
constexpr int CW_BAR = 0;
constexpr int CW_CNT = 4096;
constexpr int CW_Q = 4224;

constexpr int RING_BYTES = 131072;
constexpr int LDSCTL_OFF = RING_BYTES;
constexpr int LDS_BYTES = 147456;

__device__ __forceinline__ unsigned cvt_pk_bf16(float lo, float hi) { unsigned r; asm("v_cvt_pk_bf16_f32 %0, %1, %2" : "=v"(r) : "v"(lo), "v"(hi)); return r; }
__device__ __forceinline__ unsigned pk4_fp8(float a, float b, float c, float d) {
    a = __builtin_amdgcn_fmed3f(a, -448.f, 448.f); b = __builtin_amdgcn_fmed3f(b, -448.f, 448.f); c = __builtin_amdgcn_fmed3f(c, -448.f, 448.f); d = __builtin_amdgcn_fmed3f(d, -448.f, 448.f);
    int w = __builtin_amdgcn_cvt_pk_fp8_f32(a, b, 0, false); w = __builtin_amdgcn_cvt_pk_fp8_f32(c, d, w, true); return (unsigned)w;
}
__device__ __forceinline__ float bf_lo(unsigned w) { return __uint_as_float(w << 16); }
__device__ __forceinline__ float bf_hi(unsigned w) { return __uint_as_float(w & 0xffff0000u); }
__device__ __forceinline__ float xor32_sum(float v) { const unsigned u = __builtin_bit_cast(unsigned, v); const auto r = __builtin_amdgcn_permlane32_swap(u, u, false, false);
    return __builtin_bit_cast(float, (unsigned)r[0]) + __builtin_bit_cast(float, (unsigned)r[1]); }
__device__ __forceinline__ float xor32_max(float v) { const unsigned u = __builtin_bit_cast(unsigned, v); const auto r = __builtin_amdgcn_permlane32_swap(u, u, false, false);
    return fmaxf(__builtin_bit_cast(float, (unsigned)r[0]), __builtin_bit_cast(float, (unsigned)r[1])); }
template <int O> __device__ __forceinline__ float swz_xor(float v) { return __builtin_bit_cast(float, __builtin_amdgcn_ds_swizzle(__builtin_bit_cast(int, v), 0x1F | (O << 10))); }
__device__ __forceinline__ float wave_sum(float v) { v += swz_xor<1>(v); v += swz_xor<2>(v); v += swz_xor<4>(v); v += swz_xor<8>(v); v += swz_xor<16>(v); return xor32_sum(v); }
__device__ __forceinline__ size_t delta_off(int t) { return (t < 16384) ? WS_DELTA_A + (size_t)t * 2048 : (t < 24576) ? WS_DELTA_B + (size_t)(t - 16384) * 2048 : WS_DELTA_C + (size_t)(t - 24576) * 2048; }
__device__ __forceinline__ float fast_sigmoid(float v) { return __builtin_amdgcn_rcpf(1.0f + __builtin_amdgcn_exp2f(-1.4426950408889634f * v)); }
__device__ __forceinline__ int launder_i(int v) { asm volatile("" : "+v"(v)); return v; }
__device__ __forceinline__ int launder_s(int v) { asm volatile("" : "+s"(v)); return v; }
__device__ __forceinline__ int lane_now() { int l; asm volatile("v_mbcnt_lo_u32_b32 %0, -1, 0\n\tv_mbcnt_hi_u32_b32 %0, -1, %0" : "=v"(l)); return l; }
__device__ __forceinline__ int tid_now(int wave) { return wave * 64 + lane_now(); }
#define LDS_WAIT() asm volatile("s_waitcnt lgkmcnt(0)" ::: "memory")
#define VM_WAIT() asm volatile("s_waitcnt vmcnt(0)" ::: "memory")

#define XB_TMO      128
#define XB_XCNT(j)  (256  + 64 * (j))
#define XB_XSUB(j)  (1280 + 64 * (j))
#define XB_XGEN(j)  (2304 + 64 * (j))
#define XB_TOP      3328
#define XB_TOPGEN   3392
#define XCD_BAR_WORDS 3456
#define XB_SPIN_CAP (1u << 18)
__device__ __forceinline__ unsigned xb_ld(unsigned* p)              { return __hip_atomic_load(p, __ATOMIC_RELAXED, __HIP_MEMORY_SCOPE_AGENT); }
__device__ __forceinline__ unsigned xb_add(unsigned* p, unsigned v) { return __hip_atomic_fetch_add(p, v, __ATOMIC_RELAXED, __HIP_MEMORY_SCOPE_AGENT); }
__device__ __forceinline__ unsigned xb_xcc_id() { return (unsigned)__builtin_amdgcn_s_getreg((3 << 11) | 20) & 0xFu; }
#define XB_SPIN(cond, bar) do { unsigned _sp = 0; while (cond) { __builtin_amdgcn_s_sleep(1); \
    if ((++_sp & 255u) == 0u) { if (xb_ld(&(bar)[XB_TMO])) break; if (_sp > XB_SPIN_CAP) { atomicAdd(&(bar)[XB_TMO], 1u); break; } } } } while (0)
struct XcdBarrier { unsigned* bar; unsigned x; volatile LAS unsigned* st; int wave; };
__device__ __forceinline__ XcdBarrier xcd_barrier_post(unsigned* bar, volatile LAS unsigned* st) {
    XcdBarrier b; b.bar = bar; b.x = xb_xcc_id(); b.st = st; b.wave = 0;
    if (threadIdx.x == 0) (void)xb_add(&bar[XB_XCNT(b.x)], 1u);
    return b;
}
__device__ __forceinline__ void xcd_barrier_complete(unsigned* bar, unsigned x, unsigned& nloc, unsigned& nx) {
    const unsigned G = gridDim.x * gridDim.y * gridDim.z;
    unsigned sum, cnt, mine, sp = 0u;
    for (;;) {
        sum = 0u; cnt = 0u; mine = 0u;
#pragma unroll
        for (unsigned j = 0; j < 16; ++j) { const unsigned c = xb_ld(&bar[XB_XCNT(j)]); sum += c; cnt += (c > 0u) ? 1u : 0u; mine = (j == x) ? c : mine; }
        if (sum == G) break;
        __builtin_amdgcn_s_sleep(1);
        if ((++sp & 255u) == 0u) { if (xb_ld(&bar[XB_TMO])) break; if (sp > XB_SPIN_CAP) { atomicAdd(&bar[XB_TMO], 1u); break; } }
    }
    nloc = mine > 0u ? mine : 1u; nx = cnt > 0u ? cnt : 1u;
}
__device__ __forceinline__ void xcd_barrier(const XcdBarrier& b) {
    asm volatile("s_waitcnt vmcnt(0)" ::: "memory");
    __syncthreads();
    if (b.wave == 0 && lane_now() == 0) {
        unsigned* bar = b.bar;
        __builtin_amdgcn_s_waitcnt(0);
        unsigned nloc = b.st[0], nx = b.st[1];
        if (nloc == 0u) { xcd_barrier_complete(bar, b.x, nloc, nx); b.st[0] = nloc; b.st[1] = nx; }
        const unsigned old = xb_add(&bar[XB_XSUB(b.x)], 1u);
        const unsigned gen = old / nloc;
        if (old + 1u == (gen + 1u) * nloc) {
            __builtin_amdgcn_fence(__ATOMIC_RELEASE, "agent");
            asm volatile("s_waitcnt vmcnt(0)" ::: "memory");
            const unsigned og = xb_add(&bar[XB_TOP], 1u);
            const unsigned tg = og / nx;
            if (og + 1u == (tg + 1u) * nx) xb_add(&bar[XB_TOPGEN], 1u);
            else XB_SPIN(xb_ld(&bar[XB_TOPGEN]) == tg, bar);
            __builtin_amdgcn_fence(__ATOMIC_ACQUIRE, "agent");
            xb_add(&bar[XB_XGEN(b.x)], 1u);
            asm volatile("s_waitcnt vmcnt(0)" ::: "memory");
        } else {
            XB_SPIN(xb_ld(&bar[XB_XGEN(b.x)]) == gen, bar);
            __builtin_amdgcn_fence(__ATOMIC_ACQUIRE, "agent");
            asm volatile("s_waitcnt vmcnt(0)" ::: "memory");
        }
    }
    __syncthreads();
}

namespace pg8 {
constexpr int BM = 256, BK = 64, HALF = 128, HTB = HALF * BK * 2, STAGE_BYTES = 8 * HTB, NXCD = 8, WGM = 8;
__host__ __device__ __forceinline__ int lds_byte(int r, int c) { const int st = (r >> 4) * 2 + (c >> 5), rr = r & 15, cc = c & 31, ob = rr * 64 + cc * 2; return st * 1024 + (ob ^ (((ob >> 9) & 1) << 5)); }
__host__ __device__ __forceinline__ void stage_rc(int b, int& R, int& C) { const int st = b / 1024, sb = b % 1024, swz = sb ^ (((sb >> 9) & 1) << 5); R = (st >> 1) * 16 + swz / 64; C = (st & 1) * 32 + (swz % 64) / 2; }
__host__ __device__ __forceinline__ int perm32(int rho) { const int n = rho >> 4, i = rho & 15; return 8 * (i >> 2) + 4 * n + (i & 3); }

struct Unit { int pm, pn, e, rb, idx; const char* A; const char* B; };

struct StaticOrder {
    int nM, nN, nwg, G, c, K; const char* A; const char* Bt;
    __device__ __forceinline__ void init(const void* A_, const void* Bt_, int M, int N, int K_, int G_, int c_) { A = (const char*)A_; Bt = (const char*)Bt_; K = K_; nM = M / BM; nN = N / BM; nwg = nM * nN; G = G_; c = c_; }
    __device__ __forceinline__ bool next(int i, Unit& u) const {
        const int L = i * G + c; if (L >= nwg) return false;
        int wgid = L; { const int q = nwg / NXCD, r = nwg % NXCD, xcd = wgid % NXCD, off = wgid / NXCD; wgid = (xcd < r ? xcd * (q + 1) : r * (q + 1) + (xcd - r) * q) + off; }
        const int nig = WGM * nN, gid = wgid / nig, fm = gid * WGM, gsz = (nM - fm) < WGM ? (nM - fm) : WGM;
        u.pm = fm + ((wgid % nig) % gsz); u.pn = (wgid % nig) / gsz; u.e = 0; u.rb = 0; u.idx = i;
        u.A = A + (size_t)u.pm * BM * K * 2; u.B = Bt + (size_t)u.pn * BM * K * 2; return true;
    }
    __device__ __forceinline__ int tok(const Unit&, int) const { return 0; }
};
template <class Sched> struct OneUnit {
    const Sched& S; int i;
    __device__ __forceinline__ bool next(int j, Unit& u) const { return j == 0 ? S.next(i, u) : false; }
    __device__ __forceinline__ int tok(const Unit& u, int r) const { return S.tok(u, r); }
};
struct MoeOrder {
    int G, vcu, K, nunits, gather; const LAS int* rbs; const LAS unsigned short* tokl; const char* A; const char* Bt; size_t bstride;
    __device__ __forceinline__ bool next(int i, Unit& u) const {
        const int L = i * G + vcu; if (L >= nunits) return false;
        const int rbi = L >> 2; const int e = __builtin_amdgcn_readfirstlane(rbs[128 + rbi]);
        u.pm = rbi; u.pn = L & 3; u.e = e; u.rb = rbi - __builtin_amdgcn_readfirstlane(rbs[e]); u.idx = i;
        u.A = gather ? A : A + (size_t)rbi * BM * K * 2; u.B = Bt + (size_t)e * bstride + (size_t)u.pn * BM * K * 2; return true;
    }
    __device__ __forceinline__ int tok(const Unit& u, int r) const { return (int)tokl[u.idx * 256 + r]; }
};

typedef f32x4 Acc[2][2][4][2];
typedef int v8i32 __attribute__((ext_vector_type(8)));
__device__ __forceinline__ v8i32 cat8(const bf16x8& a, const bf16x8& b) { const u32x4 x = __builtin_bit_cast(u32x4, a), y = __builtin_bit_cast(u32x4, b); return (v8i32){(int)x.x, (int)x.y, (int)x.z, (int)x.w, (int)y.x, (int)y.y, (int)y.z, (int)y.w}; }

template <class Epi, class Sched, bool ALIGN_EPI, bool GATHER, bool F8 = false>
__device__ __forceinline__ void gemm_phase(LAS unsigned char* lds, const int wid, const int K, const Sched& S, const Epi& E) {
    const int lane = lane_now(), tid = wid * 64 + lane, wr = wid >> 2, wc = wid & 3, fr = lane & 15, fq = lane >> 4;
    const int nt = K / BK;
    unsigned voffA[2], voffB[2];
#pragma unroll
    for (int i = 0; i < 2; ++i) { int R, C; stage_rc(tid * 16 + i * 8192, R, C); const int Rb = (R & ~31) + perm32(R & 31);
        voffA[i] = GATHER ? (unsigned)(C * 2) : (unsigned)(R * K + C) * 2u; voffB[i] = (unsigned)(Rb * K + C) * 2u; }
    unsigned gAc[2] = {0u, 0u};
    const unsigned K2 = (unsigned)(K * 2);
    const size_t kstep = (size_t)(BK * 2);
    const size_t hstep = (size_t)HALF * K * 2;
    const unsigned ldsw = (unsigned)wid * 1024u;
    const int aoff = lds_byte(wr * 64 + fr, fq * 8), boff = lds_byte(wc * 32 + fr, fq * 8);
    const LAS unsigned char* ldsB = lds + 4 * HTB + boff; asm volatile("" : "+v"(ldsB));
#define PG8_SA(b, h) (((b) * 2 + (h)) * HTB)
#define PG8_SB(b, h) ((4 + (b) * 2 + (h)) * HTB)
#define PG8_STAGEB(bufoff, gbase) do { _Pragma("unroll") for (int _i = 0; _i < 2; ++_i) { asm volatile("" : "+v"(voffB[_i])); \
        __builtin_amdgcn_global_load_lds((const unsigned*)((const char*)(gbase) + voffB[_i]), (LAS unsigned*)(lds + (bufoff) + ldsw + _i * 8192), 16, 0, 0); } } while (0)
#define PG8_STAGEA(bufoff, gbase, h, nx) do { _Pragma("unroll") for (int _i = 0; _i < 2; ++_i) { \
        unsigned _o; if constexpr (GATHER) { unsigned _pk = gAc[h]; asm volatile("" : "+v"(_pk)); _o = __umul24((_pk >> (16 * _i)) & 0xffffu, K2) + voffA[0]; } else { asm volatile("" : "+v"(voffA[_i])); _o = voffA[_i]; } \
        const char* _p = GATHER ? (const char*)(gbase) + _o : (const char*)(gbase) + (h) * hstep + _o; \
        __builtin_amdgcn_global_load_lds((const unsigned*)_p, (LAS unsigned*)(lds + (bufoff) + ldsw + _i * 8192), 16, 0, 0); } } while (0)
#define PG8_LDA(dst, b, h) do { _Pragma("unroll") for (int m = 0; m < 4; ++m) { \
        if constexpr (F8) { const u32x4 x_ = *(const LAS u32x4*)(lds + PG8_SA(b, h) + aoff + m * 2048), y_ = *(const LAS u32x4*)(lds + PG8_SA(b, h) + aoff + m * 2048 + 1024); \
            dst##8[m] = (v8i32){(int)x_.x, (int)x_.y, (int)x_.z, (int)x_.w, (int)y_.x, (int)y_.y, (int)y_.z, (int)y_.w}; } \
        else { _Pragma("unroll") for (int k = 0; k < 2; ++k) dst[m][k] = *(const LAS bf16x8*)(lds + PG8_SA(b, h) + aoff + m * 2048 + k * 1024); } } } while (0)
#define PG8_LDB(dst, b, h) do { _Pragma("unroll") for (int n = 0; n < 2; ++n) { \
        if constexpr (F8) { const u32x4 x_ = *(const LAS u32x4*)(ldsB + (PG8_SB(b, h) - 4 * HTB) + n * 2048), y_ = *(const LAS u32x4*)(ldsB + (PG8_SB(b, h) - 4 * HTB) + n * 2048 + 1024); \
            dst##8[n] = (v8i32){(int)x_.x, (int)x_.y, (int)x_.z, (int)x_.w, (int)y_.x, (int)y_.y, (int)y_.z, (int)y_.w}; } \
        else { _Pragma("unroll") for (int k = 0; k < 2; ++k) dst[n][k] = *(const LAS bf16x8*)(ldsB + (PG8_SB(b, h) - 4 * HTB) + n * 2048 + k * 1024); } } } while (0)
#define PG8_MMA(ai, bj, At, Bt) do { __builtin_amdgcn_s_setprio(2); \
        if constexpr (F8) { _Pragma("unroll") for (int m = 0; m < 4; ++m) _Pragma("unroll") for (int n = 0; n < 2; ++n) \
            acc[ai][bj][m][n] = __builtin_amdgcn_mfma_scale_f32_16x16x128_f8f6f4(Bt##8[n], At##8[m], acc[ai][bj][m][n], 0, 0, 0, 0x7F7F7F7F, 0, 0x7F7F7F7F); } \
        else { _Pragma("unroll") for (int m = 0; m < 4; ++m) _Pragma("unroll") for (int n = 0; n < 2; ++n) _Pragma("unroll") for (int k = 0; k < 2; ++k) \
            acc[ai][bj][m][n] = __builtin_amdgcn_mfma_f32_16x16x32_bf16(Bt[n][k], At[m][k], acc[ai][bj][m][n], 0, 0, 0); } __builtin_amdgcn_s_setprio(0); } while (0)
#define PG8_WAIT_V(n) asm volatile("s_waitcnt vmcnt(" #n ")" ::: "memory")
#define PG8_WAIT_L(n) asm volatile("s_waitcnt lgkmcnt(" #n ")" ::: "memory")
#define PG8_BAR __builtin_amdgcn_s_barrier()
#define PG8_SCHED __builtin_amdgcn_sched_barrier(0)
#define PG8_HI __builtin_amdgcn_s_setprio(1)
#define PG8_LO __builtin_amdgcn_s_setprio(0)
    Unit cur, nxt; int ui = 0;
    if (!S.next(0, cur)) return;
    if constexpr (GATHER) {
        int R0, C0; stage_rc(tid * 16, R0, C0);
#pragma unroll
        for (int h = 0; h < 2; ++h) gAc[h] = (unsigned)S.tok(cur, h * HALF + R0) | ((unsigned)S.tok(cur, h * HALF + R0 + 64) << 16);
    }
    Acc acc;
#pragma unroll
    for (int a = 0; a < 2; ++a)
#pragma unroll
        for (int b = 0; b < 2; ++b)
#pragma unroll
            for (int m = 0; m < 4; ++m)
#pragma unroll
                for (int n = 0; n < 2; ++n) acc[a][b][m][n] = (f32x4){0.f, 0.f, 0.f, 0.f};
    bf16x8 At[4][2], B0[2][2], B1[2][2]; v8i32 At8[4], B08[2], B18[2];
    const char* cA = cur.A; const char* cB = cur.B;
    PG8_STAGEB(PG8_SB(0, 0), cB); PG8_STAGEB(PG8_SB(0, 1), cB + hstep); PG8_STAGEA(PG8_SA(0, 0), cA, 0, false); PG8_STAGEA(PG8_SA(0, 1), cA, 1, false);
    if (wr == 1) PG8_BAR;
    PG8_WAIT_V(2); PG8_BAR;
    PG8_STAGEB(PG8_SB(1, 0), cB + kstep); PG8_STAGEA(PG8_SA(1, 0), cA + kstep, 0, false); PG8_STAGEB(PG8_SB(1, 1), cB + hstep + kstep);
    PG8_WAIT_V(6); PG8_BAR;
    for (;;) {
        const bool has_next = S.next(ui + 1, nxt);
        const char* nA = has_next ? nxt.A : cA; const char* nB = has_next ? nxt.B : cB;
        for (int t = 0; t < nt; t += 2) {
            const bool last = (t == nt - 2);
            if constexpr (Epi::MID) { if (E.mid_at(t)) { const int l_ = lane_now(); E.mid(acc, cur, t, wr, wc, l_ & 15, l_ >> 4); } }
            const char* a1 = cA + (size_t)(t + 1) * kstep;
            const char* a2 = last ? nA : cA + (size_t)(t + 2) * kstep; const char* b2 = last ? nB : cB + (size_t)(t + 2) * kstep;
            const char* a3 = a2 + kstep; const char* b3 = b2 + kstep;
            PG8_HI; PG8_LDB(B0, 0, 0); PG8_LDB(B1, 0, 1); PG8_SCHED; PG8_LDA(At, 0, 0); PG8_LO; PG8_STAGEA(PG8_SA(1, 1), a1, 1, false);
            if constexpr (GATHER) { if (last && has_next) {
                int R0, C0; stage_rc((wid * 64 + lane_now()) * 16, R0, C0);
#pragma unroll
                for (int h = 0; h < 2; ++h) gAc[h] = (unsigned)S.tok(nxt, h * HALF + R0) | ((unsigned)S.tok(nxt, h * HALF + R0 + 64) << 16); } }
            PG8_WAIT_V(8); PG8_WAIT_L(0); PG8_BAR; PG8_MMA(0, 0, At, B0); PG8_MMA(0, 1, At, B1); PG8_BAR; PG8_SCHED;
            PG8_HI; PG8_LDA(At, 0, 1); PG8_LO; PG8_STAGEB(PG8_SB(0, 0), b2); PG8_STAGEB(PG8_SB(0, 1), b2 + hstep); PG8_STAGEA(PG8_SA(0, 0), a2, 0, last);
            PG8_WAIT_V(8); PG8_WAIT_L(0); PG8_BAR; PG8_MMA(1, 0, At, B0); PG8_MMA(1, 1, At, B1); PG8_BAR; PG8_SCHED;
            PG8_HI; PG8_LDB(B0, 1, 0); PG8_LDB(B1, 1, 1); PG8_SCHED; PG8_LDA(At, 1, 0); PG8_LO; PG8_STAGEA(PG8_SA(0, 1), a2, 1, last);
            PG8_WAIT_V(8); PG8_WAIT_L(0); PG8_BAR; PG8_MMA(0, 0, At, B0); PG8_MMA(0, 1, At, B1); PG8_BAR; PG8_SCHED;
            PG8_HI; PG8_LDA(At, 1, 1); PG8_LO; PG8_STAGEB(PG8_SB(1, 0), b3); PG8_STAGEB(PG8_SB(1, 1), b3 + hstep); PG8_STAGEA(PG8_SA(1, 0), a3, 0, last);
            PG8_WAIT_V(8); PG8_WAIT_L(0); PG8_BAR; PG8_MMA(1, 0, At, B0); PG8_MMA(1, 1, At, B1); PG8_BAR; PG8_SCHED;
        }
        if constexpr (ALIGN_EPI) { if (wr == 0) PG8_BAR; }
        { const int l_ = lane_now(); E(acc, cur, wr, wc, l_ & 15, l_ >> 4); }
        if (!has_next) break;
#pragma unroll
        for (int a = 0; a < 2; ++a)
#pragma unroll
            for (int b = 0; b < 2; ++b)
#pragma unroll
                for (int m = 0; m < 4; ++m)
#pragma unroll
                    for (int n = 0; n < 2; ++n) acc[a][b][m][n] = (f32x4){0.f, 0.f, 0.f, 0.f};
        cur = nxt; cA = nA; cB = nB; ++ui;
        if constexpr (ALIGN_EPI) { if (wr == 1) PG8_BAR; }
    }
    PG8_WAIT_V(0);
    if constexpr (!ALIGN_EPI) { if (wr == 0) PG8_BAR; }
    PG8_BAR;
#undef PG8_SA
#undef PG8_SB
#undef PG8_STAGEA
#undef PG8_STAGEB
#undef PG8_LDA
#undef PG8_LDB
#undef PG8_MMA
#undef PG8_WAIT_V
#undef PG8_WAIT_L
#undef PG8_BAR
#undef PG8_SCHED
#undef PG8_HI
#undef PG8_LO
}

__device__ __forceinline__ void store8(bf16_t* p, const f32x4& v0, const f32x4& v1) {
    u32x4 w; w.x = cvt_pk_bf16(v0[0], v0[1]); w.y = cvt_pk_bf16(v0[2], v0[3]); w.z = cvt_pk_bf16(v1[0], v1[1]); w.w = cvt_pk_bf16(v1[2], v1[3]);
    *(u32x4*)p = w;
}
struct EpiProj {
    static constexpr bool MID = false;
    bf16_t* O; const float* cosT; const float* sinT; int pmode;
    __device__ __forceinline__ bool mid_at(int) const { return false; }
    __device__ __forceinline__ void mid(Acc&, const Unit&, int, int, int, int, int) const {}
    __device__ __forceinline__ void operator()(Acc& acc, const Unit& u, int wr, int wc, int fr, int fq) const {
        if (pmode == 3) return;
        const int pn = u.pn; fr = launder_i(fr); fq = launder_i(fq);
        const int mode = (pn < 4) ? 1 : (pn < 8) ? 0 : (pn < 12) ? 2 : (pn < 20) ? 1 : (pn < 24) ? 0 : 3;
        const int row0 = u.pm * BM + wr * 64 + fr, col0 = pn * BM + wc * 32 + 8 * fq;
        if (mode == 1) {
            const int q4 = 4 * (4 * wc + fq);
            f32x4 cs[2][4], sn[2][4];
#pragma unroll
            for (int ai = 0; ai < 2; ++ai)
#pragma unroll
                for (int m = 0; m < 4; ++m) { const size_t ro = (size_t)(row0 + ai * HALF + m * 16) * 64 + q4; cs[ai][m] = *(const f32x4*)(cosT + ro); sn[ai][m] = *(const f32x4*)(sinT + ro); }
            asm volatile("" ::: "memory");
#pragma unroll
            for (int ai = 0; ai < 2; ++ai)
#pragma unroll
                for (int m = 0; m < 4; ++m) {
                    bf16_t* rowp = O + (size_t)(row0 + ai * HALF + m * 16) * DIN + col0;
                    const int ic = (wr * 64 + m * 16 + fr) & 127;
#pragma unroll
                    for (int bj = 0; bj < 2; ++bj) {
                        float f = 1.f;
                        if (pn < 4) { const int hd = (2 * pn + bj) & 3; const float lg = __builtin_amdgcn_logf(1.0f - __builtin_amdgcn_exp2f(-5.0f - (float)hd));
                            f = __builtin_amdgcn_exp2f(lg * (pn < 2 ? (float)(ic + 1) : (float)(127 - ic))); }
                        const f32x4 t1 = acc[ai][bj][m][0], t2 = acc[ai][bj][m][1];
                        const f32x4 o1 = (t1 * cs[ai][m] - t2 * sn[ai][m]) * f, o2 = (t2 * cs[ai][m] + t1 * sn[ai][m]) * f;
                        if (pmode != 1) store8(rowp + bj * HALF, o1, o2);
                    }
                }
        } else {
#pragma unroll
            for (int ai = 0; ai < 2; ++ai)
#pragma unroll
                for (int m = 0; m < 4; ++m) {
                    bf16_t* rowp = O + (size_t)(row0 + ai * HALF + m * 16) * DIN + col0;
#pragma unroll
                    for (int bj = 0; bj < 2; ++bj) {
                        f32x4 v0 = acc[ai][bj][m][0], v1 = acc[ai][bj][m][1];
                        if (mode == 2) {
#pragma unroll
                            for (int e = 0; e < 4; ++e) { v0[e] = v0[e] * fast_sigmoid(v0[e]); v1[e] = v1[e] * fast_sigmoid(v1[e]); }
                        } else if (mode == 3) {
#pragma unroll
                            for (int e = 0; e < 4; ++e) { v0[e] = fast_sigmoid(v0[e]); v1[e] = fast_sigmoid(v1[e]); }
                        }
                        if (pmode != 1) store8(rowp + bj * HALF, v0, v1);
                    }
                }
        }
        asm volatile("" ::: "memory");
    }
};
struct EpiMerged {
    static constexpr bool MID = true;
    const bf16_t* proj; bf16_t* O; const LAS float* rst;
    __device__ __forceinline__ bool mid_at(int t) const { return t == 4 || t == 8 || t == 12 || t == 16; }
    __device__ __forceinline__ void mid(Acc& acc, const Unit& u, int t, int wr, int wc, int fr, int fq) const {
        fr = launder_i(fr); fq = launder_i(fq);
        const LAS float* rq = (const LAS float*)rst + ((t >> 2) - 1) * 256 + wr * 64 + fr;
#pragma unroll
        for (int ai = 0; ai < 2; ++ai)
#pragma unroll
            for (int m = 0; m < 4; ++m) {
                const float f = rq[ai * HALF + m * 16];
#pragma unroll
                for (int bj = 0; bj < 2; ++bj) { acc[ai][bj][m][0] = acc[ai][bj][m][0] * f; acc[ai][bj][m][1] = acc[ai][bj][m][1] * f; }
            }
        if (t == 16) {
            const int row0 = u.pm * BM + wr * 64 + fr, col0 = u.pn * BM + wc * 32 + 8 * fq;
#pragma unroll
            for (int ai = 0; ai < 2; ++ai) {
                u32x4 g[4][2], d[4][2];
#pragma unroll
                for (int m = 0; m < 4; ++m) { const bf16_t* gp = proj + (size_t)(row0 + ai * HALF + m * 16) * DIN + 6144 + col0;
#pragma unroll
                    for (int bj = 0; bj < 2; ++bj) { g[m][bj] = *(const u32x4*)(gp + bj * HALF); d[m][bj] = *(const u32x4*)(gp + 1024 + bj * HALF); } }
                asm volatile("" ::: "memory");
#pragma unroll
                for (int m = 0; m < 4; ++m)
#pragma unroll
                    for (int bj = 0; bj < 2; ++bj) {
                        const u32x4 gg = g[m][bj], dd = d[m][bj];
                        f32x4 q0, q1;
                        q0[0] = bf_lo(gg.x) * __builtin_amdgcn_rcpf(bf_lo(dd.x)); q0[1] = bf_hi(gg.x) * __builtin_amdgcn_rcpf(bf_hi(dd.x));
                        q0[2] = bf_lo(gg.y) * __builtin_amdgcn_rcpf(bf_lo(dd.y)); q0[3] = bf_hi(gg.y) * __builtin_amdgcn_rcpf(bf_hi(dd.y));
                        q1[0] = bf_lo(gg.z) * __builtin_amdgcn_rcpf(bf_lo(dd.z)); q1[1] = bf_hi(gg.z) * __builtin_amdgcn_rcpf(bf_hi(dd.z));
                        q1[2] = bf_lo(gg.w) * __builtin_amdgcn_rcpf(bf_lo(dd.w)); q1[3] = bf_hi(gg.w) * __builtin_amdgcn_rcpf(bf_hi(dd.w));
                        acc[ai][bj][m][0] = acc[ai][bj][m][0] * q0; acc[ai][bj][m][1] = acc[ai][bj][m][1] * q1;
                    }
                asm volatile("" ::: "memory");
            }
        }
    }
    __device__ __forceinline__ void operator()(Acc& acc, const Unit& u, int wr, int wc, int fr, int fq) const {
        fr = launder_i(fr); fq = launder_i(fq);
        const int row0 = u.pm * BM + wr * 64 + fr, col0 = u.pn * BM + wc * 32 + 8 * fq;
        u32x4 d[2][4][2];
#pragma unroll
        for (int ai = 0; ai < 2; ++ai)
#pragma unroll
            for (int m = 0; m < 4; ++m) { const bf16_t* gp = proj + (size_t)(row0 + ai * HALF + m * 16) * DIN + 7168 + col0;
#pragma unroll
                for (int bj = 0; bj < 2; ++bj) d[ai][m][bj] = *(const u32x4*)(gp + bj * HALF); }
        asm volatile("" ::: "memory");
#pragma unroll
        for (int ai = 0; ai < 2; ++ai)
#pragma unroll
            for (int m = 0; m < 4; ++m) {
                const int row = row0 + ai * HALF + m * 16;
#pragma unroll
                for (int bj = 0; bj < 2; ++bj) {
                    const u32x4 dd = d[ai][m][bj];
                    f32x4 s0, s1; s0[0] = bf_lo(dd.x); s0[1] = bf_hi(dd.x); s0[2] = bf_lo(dd.y); s0[3] = bf_hi(dd.y); s1[0] = bf_lo(dd.z); s1[1] = bf_hi(dd.z); s1[2] = bf_lo(dd.w); s1[3] = bf_hi(dd.w);
                    store8(O + (size_t)row * D + col0 + bj * HALF, acc[ai][bj][m][0] * s0, acc[ai][bj][m][1] * s1);
                }
            }
        asm volatile("" ::: "memory");
    }
};
struct EpiWout {
    static constexpr bool MID = false;
    unsigned char* ws; const float* mod; int tbase;
    __device__ __forceinline__ bool mid_at(int) const { return false; }
    __device__ __forceinline__ void mid(Acc&, const Unit&, int, int, int, int, int) const {}
    __device__ __forceinline__ void operator()(Acc& acc, const Unit& u, int wr, int wc, int fr, int fq) const {
        fr = launder_i(fr); fq = launder_i(fq);
        const int row0 = tbase + u.pm * BM + wr * 64 + fr, col0 = u.pn * BM + wc * 32 + 8 * fq;
        const float* g1 = mod + (size_t)(row0 >> 12) * 6144 + 2048 + col0;
        f32x4 g[2][2];
#pragma unroll
        for (int bj = 0; bj < 2; ++bj) { g[bj][0] = *(const f32x4*)(g1 + bj * HALF); g[bj][1] = *(const f32x4*)(g1 + bj * HALF + 4); }
        bf16_t* base = (bf16_t*)(ws + delta_off(tbase + u.pm * BM)) + (size_t)(wr * 64 + fr) * D + col0;
#pragma unroll
        for (int ai = 0; ai < 2; ++ai)
#pragma unroll
            for (int m = 0; m < 4; ++m) {
                bf16_t* rowp = base + (size_t)(ai * HALF + m * 16) * D;
#pragma unroll
                for (int bj = 0; bj < 2; ++bj) store8(rowp + bj * HALF, g[bj][0] * acc[ai][bj][m][0], g[bj][1] * acc[ai][bj][m][1]);
            }
        asm volatile("" ::: "memory");
    }
};
struct EpiGU {
    static constexpr bool MID = false;
    unsigned char* act;
    __device__ __forceinline__ bool mid_at(int) const { return false; }
    __device__ __forceinline__ void mid(Acc&, const Unit&, int, int, int, int, int) const {}
    __device__ __forceinline__ void operator()(Acc& acc, const Unit& u, int wr, int wc, int fr, int fq) const {
        fr = launder_i(fr); fq = launder_i(fq);
        const int row0 = u.pm * BM + wr * 64 + fr, col0 = u.pn * 128 + wc * 16 + 4 * fq;
#pragma unroll
        for (int ai = 0; ai < 2; ++ai)
#pragma unroll
            for (int m = 0; m < 4; ++m) {
                unsigned char* rowp = act + (size_t)(row0 + ai * HALF + m * 16) * DEXP + col0;
#pragma unroll
                for (int bj = 0; bj < 2; ++bj) {
                    const f32x4 gt = acc[ai][bj][m][0] * 0.03125f, up = acc[ai][bj][m][1] * 0.03125f; f32x4 a;
#pragma unroll
                    for (int e = 0; e < 4; ++e) a[e] = gt[e] * fast_sigmoid(gt[e]) * up[e];
                    *(unsigned*)(rowp + bj * 64) = pk4_fp8(a[0], a[1], a[2], a[3]);
                }
            }
        asm volatile("" ::: "memory");
    }
};
struct EpiDown {
    static constexpr bool MID = false;
    unsigned char* y; const LAS float* wl;
    __device__ __forceinline__ bool mid_at(int) const { return false; }
    __device__ __forceinline__ void mid(Acc&, const Unit&, int, int, int, int, int) const {}
    __device__ __forceinline__ void operator()(Acc& acc, const Unit& u, int wr, int wc, int fr, int fq) const {
        fr = launder_i(fr); fq = launder_i(fq);
        const int r0 = wr * 64 + fr, col0 = u.pn * BM + wc * 32 + 8 * fq;
        const int colw = u.pn * BM + wc * 32 + 16 * (fq >> 1), odd = fq & 1;
#pragma unroll
        for (int ai = 0; ai < 2; ++ai)
#pragma unroll
            for (int mp = 0; mp < 2; ++mp) {
                unsigned char* rowp = y + (size_t)(u.pm * BM + r0 + ai * HALF + (2 * mp + odd) * 16) * D + colw;
                const float wA = wl[u.idx * 256 + r0 + ai * HALF + (2 * mp) * 16], wB = wl[u.idx * 256 + r0 + ai * HALF + (2 * mp + 1) * 16];
#pragma unroll
                for (int bj = 0; bj < 2; ++bj) {
                    u32x2 pa, pb;
                    { const int m = 2 * mp; const f32x4 v0 = acc[ai][bj][m][0] * wA, v1 = acc[ai][bj][m][1] * wA; pa.x = pk4_fp8(v0[0], v0[1], v0[2], v0[3]); pa.y = pk4_fp8(v1[0], v1[1], v1[2], v1[3]); }
                    { const int m = 2 * mp + 1; const f32x4 v0 = acc[ai][bj][m][0] * wB, v1 = acc[ai][bj][m][1] * wB; pb.x = pk4_fp8(v0[0], v0[1], v0[2], v0[3]); pb.y = pk4_fp8(v1[0], v1[1], v1[2], v1[3]); }
                    const auto sx = __builtin_amdgcn_permlane16_swap(pa.x, pb.x, false, false), sy = __builtin_amdgcn_permlane16_swap(pa.y, pb.y, false, false);
                    *(u32x4*)(rowp + bj * HALF) = (u32x4){(unsigned)sx[0], (unsigned)sy[0], (unsigned)sx[1], (unsigned)sy[1]};
                    asm volatile("" ::: "memory");
                }
            }
        asm volatile("" ::: "memory");
    }
};
}

__device__ __forceinline__ unsigned off_b(unsigned row, unsigned ch) { return 256u * row + 16u * (ch ^ (((row & 3u) << 2) | ((row >> 2) & 3u))); }
__device__ __forceinline__ int lds_addr(const LAS unsigned char* p) { return (int)(unsigned)(size_t)p; }
__device__ __forceinline__ int crow(int r, int hi) { return (r & 3) + 8 * (r >> 2) + 4 * hi; }
__device__ __forceinline__ s16x4 tr_read(const LAS unsigned char* p) { return __builtin_amdgcn_ds_read_tr16_b64_v4i16((LAS s16x4*)p); }
__device__ __forceinline__ bf16x8 tr_frag(const LAS unsigned char* tile, int r0, int r1, int c, int lane) {
    const int blk = (lane >> 4) & 1, q = (lane & 15) >> 2, p = lane & 3;
    const s16x4 a = tr_read(tile + off_b(r0 + q, 4 * c + 2 * blk + (p >> 1)) + 8 * (p & 1));
    const s16x4 b = tr_read(tile + off_b(r1 + q, 4 * c + 2 * blk + (p >> 1)) + 8 * (p & 1));
    return (bf16x8){a[0], a[1], a[2], a[3], b[0], b[1], b[2], b[3]};
}
__device__ __forceinline__ bf16x8 pack8(const f32x16& v, int base) {
    u32x4 w; w.x = cvt_pk_bf16(v[base + 0], v[base + 1]); w.y = cvt_pk_bf16(v[base + 2], v[base + 3]); w.z = cvt_pk_bf16(v[base + 4], v[base + 5]); w.w = cvt_pk_bf16(v[base + 6], v[base + 7]);
    return __builtin_bit_cast(bf16x8, w);
}
__device__ __forceinline__ int launder(int v) { asm volatile("" : "+v"(v)); return v; }
#define MFMA32(a, b, c) __builtin_amdgcn_mfma_f32_32x32x16_bf16(a, b, c, 0, 0, 0)

struct MixArgs { const bf16_t* proj; bf16_t* act; const float* diff_norm; float lam; float* ssq; };

template <int IMM> __device__ __forceinline__ void tr8_issue(s16x4 (&x)[8], const int (&ad)[8]) {
    asm volatile("ds_read_b64_tr_b16 %0, %8 offset:%16\n\tds_read_b64_tr_b16 %1, %9 offset:%16\n\tds_read_b64_tr_b16 %2, %10 offset:%16\n\tds_read_b64_tr_b16 %3, %11 offset:%16\n\t"
                 "ds_read_b64_tr_b16 %4, %12 offset:%16\n\tds_read_b64_tr_b16 %5, %13 offset:%16\n\tds_read_b64_tr_b16 %6, %14 offset:%16\n\tds_read_b64_tr_b16 %7, %15 offset:%16"
                 : "=&v"(x[0]), "=&v"(x[1]), "=&v"(x[2]), "=&v"(x[3]), "=&v"(x[4]), "=&v"(x[5]), "=&v"(x[6]), "=&v"(x[7])
                 : "v"(ad[0]), "v"(ad[1]), "v"(ad[2]), "v"(ad[3]), "v"(ad[4]), "v"(ad[5]), "v"(ad[6]), "v"(ad[7]), "n"(IMM) : "memory");
}
__device__ __forceinline__ void tr8_wait(s16x4 (&x)[8]) {
    asm volatile("s_waitcnt lgkmcnt(0)" : "+v"(x[0]), "+v"(x[1]), "+v"(x[2]), "+v"(x[3]), "+v"(x[4]), "+v"(x[5]), "+v"(x[6]), "+v"(x[7]) :: "memory");
}
template <int N> __device__ __forceinline__ void tr8_wait_n(s16x4 (&x)[8]) {
    asm volatile("s_waitcnt lgkmcnt(%8)" : "+v"(x[0]), "+v"(x[1]), "+v"(x[2]), "+v"(x[3]), "+v"(x[4]), "+v"(x[5]), "+v"(x[6]), "+v"(x[7]) : "n"(N) : "memory");
}
__device__ __forceinline__ void pv_mma(f32x16 (&O)[8], int ob, const s16x4 (&x)[8], const bf16x8& pf) {
    __builtin_amdgcn_s_setprio(2);
#pragma unroll
    for (int c = 0; c < 4; ++c) { const bf16x8 vf = {x[2 * c][0], x[2 * c][1], x[2 * c][2], x[2 * c][3], x[2 * c + 1][0], x[2 * c + 1][1], x[2 * c + 1][2], x[2 * c + 1][3]}; O[ob + c] = MFMA32(vf, pf, O[ob + c]); }
    __builtin_amdgcn_s_setprio(1);
}
template <int IMM> __device__ __forceinline__ void k4_issue(bf16x8 (&k)[4], int a0, int a1, int a2, int a3) {
    asm volatile("ds_read_b128 %0, %4 offset:%8\n\tds_read_b128 %1, %5 offset:%8\n\tds_read_b128 %2, %6 offset:%8\n\tds_read_b128 %3, %7 offset:%8"
                 : "=&v"(k[0]), "=&v"(k[1]), "=&v"(k[2]), "=&v"(k[3]) : "v"(a0), "v"(a1), "v"(a2), "v"(a3), "n"(IMM) : "memory");
}
__device__ __forceinline__ void tr4_issue(s16x4 (&x)[4], int a0, int a1, int a2, int a3) {
    asm volatile("ds_read_b64_tr_b16 %0, %4\n\tds_read_b64_tr_b16 %1, %5\n\tds_read_b64_tr_b16 %2, %6\n\tds_read_b64_tr_b16 %3, %7"
                 : "=&v"(x[0]), "=&v"(x[1]), "=&v"(x[2]), "=&v"(x[3]) : "v"(a0), "v"(a1), "v"(a2), "v"(a3) : "memory");
}
__device__ __forceinline__ void tr4_wait(s16x4 (&x)[4]) { asm volatile("s_waitcnt lgkmcnt(0)" : "+v"(x[0]), "+v"(x[1]), "+v"(x[2]), "+v"(x[3]) :: "memory"); }
__device__ __forceinline__ int tr_addr(const LAS unsigned char* tile, int r, int c, int lane) {
    const int blk = (lane >> 4) & 1, q = (lane & 15) >> 2, p = lane & 3;
    return lds_addr(tile) + (int)off_b(r + q, 4 * c + 2 * blk + (p >> 1)) + 8 * (p & 1);
}
__device__ __forceinline__ bf16x8 cat4(const s16x4& a, const s16x4& b) { return (bf16x8){a[0], a[1], a[2], a[3], b[0], b[1], b[2], b[3]}; }
template <int N> __device__ __forceinline__ void k4_wait(bf16x8 (&k)[4]) {
    asm volatile("s_waitcnt lgkmcnt(%4)" : "+v"(k[0]), "+v"(k[1]), "+v"(k[2]), "+v"(k[3]) : "n"(N) : "memory");
}
#define FENCE() __builtin_amdgcn_sched_barrier(0)
__device__ __forceinline__ bf16x8 lds_b128(int addr) { return *(const LAS bf16x8*)(size_t)(unsigned)addr; }
__device__ __forceinline__ s16x4 lds_tr(int addr) { return __builtin_amdgcn_ds_read_tr16_b64_v4i16((LAS s16x4*)(size_t)(unsigned)addr); }
template <int IMM> __device__ __forceinline__ s16x4 lds_tr_i(int addr) { return __builtin_amdgcn_ds_read_tr16_b64_v4i16((LAS s16x4*)((LAS unsigned char*)(size_t)(unsigned)addr + IMM)); }
__device__ __forceinline__ void dma16(const void* gptr, unsigned lds_base) {
    asm volatile("s_mov_b32 m0, %1\n\ts_nop 0\n\tglobal_load_lds_dwordx4 %0, off" :: "v"(gptr), "s"(lds_base) : "memory", "m0");
}
__device__ __forceinline__ void dma16s(unsigned long long sbase, unsigned voff, unsigned lds_base) {
    asm volatile("s_mov_b32 m0, %2\n\ts_nop 0\n\tglobal_load_lds_dwordx4 %0, %1" :: "v"(voff), "s"(sbase), "s"(lds_base) : "memory", "m0");
}
__device__ __forceinline__ unsigned attn_voff(int lane) { const int r4 = lane >> 4; return (unsigned)(r4 * DIN * 2 + (((lane & 15) ^ (r4 << 2)) * 16)); }
__device__ __forceinline__ void attn_issue(LAS unsigned char* buf, const bf16_t* proj, size_t trow0, int kcol0, int vcol0, int wid, unsigned voff0) {
    const int ti = wid >> 1;
    const int col = (ti < 2) ? kcol0 + ti * 128 : vcol0 + (ti - 2) * 128;
    const unsigned long long sb = (unsigned long long)(size_t)(proj + (trow0 + 32 * (wid & 1)) * DIN + col);
#pragma unroll
    for (int i = 0; i < 8; ++i)
        dma16s(sb + (unsigned long long)(4 * i) * DIN * 2, voff0 ^ (unsigned)(16 * (i & 3)), (unsigned)__builtin_amdgcn_readfirstlane(lds_addr(buf) + ti * 16384 + ((wid & 1) * 8 + i) * 1024));
}
__device__ __forceinline__ void attn_unit(LAS unsigned char* lds, const int wid, const MixArgs& A, int bl, int h, int qb, int pre, volatile LAS int* bcn) {
    const int lane0 = lane_now(), comp = wid >> 2, ri = wid & 3;
    const size_t tb = (size_t)bl * SEQ;
    const int kcol0 = 4096 + (2 * h) * 128, vcol0 = 5120 + h * 256;
    const int ntiles = 2 * (qb + 1);
    f32x16 O[8]; float mrun = -1e30f, lrun = 0.f;
    {
    const int lane = lane0, hh = lane >> 5, li = lane & 31;
    const unsigned voff0 = attn_voff(lane);
    attn_issue(lds, A.proj, tb, kcol0, vcol0, wid, voff0);
    const bf16_t* qrow = A.proj + (tb + qb * 128 + ri * 32 + li) * DIN + 3072 + (2 * h + comp) * 128;
    bf16x8 qf[8];
#pragma unroll
    for (int s = 0; s < 8; ++s) qf[s] = *(const bf16x8*)(qrow + 16 * s + 8 * hh);
    asm volatile("s_waitcnt vmcnt(0)" : "+v"(qf[0]), "+v"(qf[1]), "+v"(qf[2]), "+v"(qf[3]), "+v"(qf[4]), "+v"(qf[5]), "+v"(qf[6]), "+v"(qf[7]), "+v"(pre) :: "memory");
    if (wid == 0 && lane == 0) bcn[0] = pre;
#pragma unroll
    for (int i = 0; i < 8; ++i)
#pragma unroll
        for (int r = 0; r < 16; ++r) O[i][r] = 0.f;
    const int kadr = 256 * li + 16 * (hh ^ (((li & 3) << 2) | ((li >> 2) & 3)));
    const int blk = (lane >> 4) & 1, q = (lane & 15) >> 2, p = lane & 3, lo1 = (2 * blk + (p >> 1)) ^ hh;
    const int vb1 = 256 * (4 * hh + q) + 64 * q + 16 * lo1 + 8 * (p & 1), vb2 = 256 * (4 * hh + q + 8) + 64 * q + 16 * (lo1 ^ 2) + 8 * (p & 1);
    for (int kt = 0; kt < ntiles; ++kt) {
        asm volatile("s_waitcnt vmcnt(0)" ::: "memory");
        __builtin_amdgcn_s_barrier();
        asm volatile("" ::: "memory");
        if (kt + 1 < ntiles) attn_issue(lds + ((kt + 1) & 1) * 65536, A.proj, tb + (size_t)(kt + 1) * 64, kcol0, vcol0, wid, voff0);
        const int krel0 = (kt - 2 * qb) * 64;
        if (krel0 > ri * 32 + 31) continue;
        const LAS unsigned char* Kt = lds + (kt & 1) * 65536 + comp * 16384;
        const LAS unsigned char* Vt = lds + (kt & 1) * 65536 + 32768;
        f32x16 sc[2];
#pragma unroll
        for (int kb = 0; kb < 2; ++kb)
#pragma unroll
            for (int r = 0; r < 16; ++r) sc[kb][r] = 0.f;
        __builtin_amdgcn_s_setprio(1);
        {
            const int kbase = lds_addr(Kt);
            bf16x8 ka[2][4];
#pragma unroll
            for (int s = 0; s < 4; ++s) ka[0][s] = lds_b128(kbase + (kadr ^ (32 * s)));
#pragma unroll
            for (int grp = 0; grp < 4; ++grp) {
                const int s0 = 4 * (grp >> 1), kb = grp & 1;
                if (grp + 1 < 4) { const int s1 = 4 * ((grp + 1) >> 1), kb1 = (grp + 1) & 1;
#pragma unroll
                    for (int s = 0; s < 4; ++s) ka[(grp + 1) & 1][s] = lds_b128(kbase + 8192 * kb1 + (kadr ^ (32 * (s1 + s)))); }
                FENCE();
                __builtin_amdgcn_s_setprio(2);
#pragma unroll
                for (int s = 0; s < 4; ++s) sc[kb] = MFMA32(ka[grp & 1][s], qf[s0 + s], sc[kb]);
                __builtin_amdgcn_s_setprio(1);
                FENCE();
            }
        }
        __builtin_amdgcn_s_setprio(0);
        if (krel0 >= 0) {
            const int qrel = ri * 32 + li;
#pragma unroll
            for (int kb = 0; kb < 2; ++kb)
#pragma unroll
                for (int r = 0; r < 16; ++r) if (krel0 + 32 * kb + crow(r, hh) > qrel) sc[kb][r] = -INFINITY;
        }
        float pmax = sc[0][0];
#pragma unroll
        for (int r = 1; r < 16; ++r) pmax = fmaxf(pmax, sc[0][r]);
#pragma unroll
        for (int r = 0; r < 16; ++r) pmax = fmaxf(pmax, sc[1][r]);
        pmax = xor32_max(pmax);
        if (!__all(pmax <= mrun + 11.0f)) {
            const float mn = fmaxf(mrun, pmax), alpha = __builtin_amdgcn_exp2f(mrun - mn);
            mrun = mn; lrun *= alpha;
#pragma unroll
            for (int i = 0; i < 8; ++i)
#pragma unroll
                for (int r = 0; r < 16; ++r) O[i][r] *= alpha;
        }
        float ps = 0.f;
#pragma unroll
        for (int kb = 0; kb < 2; ++kb)
#pragma unroll
            for (int r = 0; r < 16; ++r) { const float pe = __builtin_amdgcn_exp2f(sc[kb][r] - mrun); sc[kb][r] = pe; ps += pe; }
        lrun += ps;
        {
            const int vbase = (int)(unsigned)(size_t)Vt;
            int ad[8];
#pragma unroll
            for (int c = 0; c < 4; ++c) { ad[2 * c] = vbase + (vb1 ^ (64 * c)); ad[2 * c + 1] = vbase + (vb2 ^ (64 * c)); }
            const bf16x8 pf0 = pack8(sc[0], 0), pf1 = pack8(sc[0], 8), pf2 = pack8(sc[1], 0), pf3 = pack8(sc[1], 8);
            s16x4 xa[8], xb[8];
            __builtin_amdgcn_s_setprio(1);
#define PV_LOAD(x, IMM) do { _Pragma("unroll") for (int c = 0; c < 8; ++c) x[c] = lds_tr_i<(IMM)>(ad[c]); } while (0)
            PV_LOAD(xa, 256 * 0);
            PV_LOAD(xb, 256 * 0 + 16384);  FENCE(); pv_mma(O, 0, xa, pf0); FENCE();
            PV_LOAD(xa, 256 * 16);         FENCE(); pv_mma(O, 4, xb, pf0); FENCE();
            PV_LOAD(xb, 256 * 16 + 16384); FENCE(); pv_mma(O, 0, xa, pf1); FENCE();
            PV_LOAD(xa, 256 * 32);         FENCE(); pv_mma(O, 4, xb, pf1); FENCE();
            PV_LOAD(xb, 256 * 32 + 16384); FENCE(); pv_mma(O, 0, xa, pf2); FENCE();
            PV_LOAD(xa, 256 * 48);         FENCE(); pv_mma(O, 4, xb, pf2); FENCE();
            PV_LOAD(xb, 256 * 48 + 16384); FENCE(); pv_mma(O, 0, xa, pf3); FENCE();
                                                    pv_mma(O, 4, xb, pf3);
            __builtin_amdgcn_s_setprio(0);
#undef PV_LOAD
        }
    }
    }
    __syncthreads();
    const float inv = 1.0f / xor32_sum(lrun);
    LAS f32x4* X = (LAS f32x4*)lds;
    const int lane = lane_now(), hh = lane >> 5, li = lane & 31;
    if (comp == 1) {
#pragma unroll
        for (int dvb = 0; dvb < 8; ++dvb)
#pragma unroll
            for (int g = 0; g < 4; ++g) X[((ri * 8 + dvb) * 4 + g) * 64 + lane] = (f32x4){O[dvb][4 * g] * inv, O[dvb][4 * g + 1] * inv, O[dvb][4 * g + 2] * inv, O[dvb][4 * g + 3] * inv};
    }
    __syncthreads();
    if (comp == 0) {
        float ss = 0.f;
#pragma unroll
        for (int dvb = 0; dvb < 8; ++dvb)
#pragma unroll
            for (int g = 0; g < 4; ++g) {
                const f32x4 o2 = X[((ri * 8 + dvb) * 4 + g) * 64 + lane];
#pragma unroll
                for (int e = 0; e < 4; ++e) { float d = O[dvb][4 * g + e] * inv - A.lam * o2[e]; asm volatile("" : "+v"(d)); O[dvb][4 * g + e] = d; ss += d * d; }
            }
        ss = xor32_sum(ss);
        const float rstd = 0.8f / sqrtf(ss * (1.0f / 256.0f) + EPS);
        LAS unsigned char* stg = lds + ri * 32768;
#pragma unroll
        for (int dh = 0; dh < 2; ++dh) {
            asm volatile("" ::: "memory");
            f32x4 gn[4][4];
#pragma unroll
            for (int d4 = 0; d4 < 4; ++d4)
#pragma unroll
                for (int g = 0; g < 4; ++g) gn[d4][g] = *(const f32x4*)(A.diff_norm + 32 * (4 * dh + d4) + 8 * g + 4 * hh);
            asm volatile("" ::: "memory");
#pragma unroll
            for (int d4 = 0; d4 < 4; ++d4) {
                const int dvb = 4 * dh + d4;
#pragma unroll
                for (int g = 0; g < 4; ++g) {
                    u32x2 w; w.x = cvt_pk_bf16(O[dvb][4 * g] * rstd * gn[d4][g][0], O[dvb][4 * g + 1] * rstd * gn[d4][g][1]); w.y = cvt_pk_bf16(O[dvb][4 * g + 2] * rstd * gn[d4][g][2], O[dvb][4 * g + 3] * rstd * gn[d4][g][3]);
                    *(LAS u32x2*)(stg + li * 528 + 64 * dvb + 16 * g + 8 * hh) = w;
                }
            }
        }
        asm volatile("s_waitcnt lgkmcnt(0)" ::: "memory");
        bf16_t* obase = A.act + (tb + qb * 128 + ri * 32 + hh) * 2048 + 1024 + h * 256 + 8 * li;
#pragma unroll
        for (int i4 = 0; i4 < 4; ++i4) {
            u32x4 v[4];
#pragma unroll
            for (int q = 0; q < 4; ++q) v[q] = *(const LAS u32x4*)(stg + (2 * (4 * i4 + q) + hh) * 528 + 16 * li);
#pragma unroll
            for (int q = 0; q < 4; ++q) *(u32x4*)(obase + (size_t)(2 * (4 * i4 + q)) * 2048) = v[q];
        }
    }
    __syncthreads();
}

#define MFMA_DEP(acc, zs) (__builtin_amdgcn_readfirstlane(__float_as_int((acc)[15])) & (zs))
#define MFMA_DEP2(a, b, zs) ((__builtin_amdgcn_readfirstlane(__float_as_int((a)[15])) | __builtin_amdgcn_readfirstlane(__float_as_int((b)[15]))) & (zs))
#define MFMA_DEP4(a, b, c, d, zs) ((__builtin_amdgcn_readfirstlane(__float_as_int((a)[15])) | __builtin_amdgcn_readfirstlane(__float_as_int((b)[15])) | __builtin_amdgcn_readfirstlane(__float_as_int((c)[15])) | __builtin_amdgcn_readfirstlane(__float_as_int((d)[15]))) & (zs))
#define RET_BAR() do { asm volatile("s_waitcnt lgkmcnt(0)" ::: "memory"); __builtin_amdgcn_s_barrier(); asm volatile("" ::: "memory"); } while (0)
template <int J2> __device__ __forceinline__ void ret_step34(f32x16 (&Oa)[2], f32x16 (&St)[2], const int (&tv)[2], const int (&tk)[2][2], int pa0, int pa1, int pb0, int pb1, int ib0, int ib1) {
    constexpr int R = 256 * 32 * J2;
    s16x4 xv[4], xk0[4], xk1[4]; bf16x8 pp[4];
    xv[0] = lds_tr_i<R>(tv[0]); xv[1] = lds_tr_i<R + 1024>(tv[1]); xv[2] = lds_tr_i<R + 4096>(tv[0]); xv[3] = lds_tr_i<R + 5120>(tv[1]);
    xk0[0] = lds_tr_i<R>(tk[0][0]); xk0[1] = lds_tr_i<R + 1024>(tk[0][1]); xk0[2] = lds_tr_i<R + 4096>(tk[0][0]); xk0[3] = lds_tr_i<R + 5120>(tk[0][1]);
    xk1[0] = lds_tr_i<R>(tk[1][0]); xk1[1] = lds_tr_i<R + 1024>(tk[1][1]); xk1[2] = lds_tr_i<R + 4096>(tk[1][0]); xk1[3] = lds_tr_i<R + 5120>(tk[1][1]);
    pp[0] = lds_b128(pa0); pp[1] = lds_b128(pb0); pp[2] = lds_b128(pa1); pp[3] = lds_b128(pb1);
    FENCE();
    const bf16x8 z = {0, 0, 0, 0, 0, 0, 0, 0};
#pragma unroll
    for (int q = 0; q < 2; ++q) {
        const bf16x8 vf = cat4(xv[2 * q], xv[2 * q + 1]);
        Oa[0] = MFMA32(vf, (J2 <= ib0) ? pp[2 * q] : z, Oa[0]); Oa[1] = MFMA32(vf, (J2 <= ib1) ? pp[2 * q + 1] : z, Oa[1]);
        St[0] = MFMA32(cat4(xk0[2 * q], xk0[2 * q + 1]), vf, St[0]); St[1] = MFMA32(cat4(xk1[2 * q], xk1[2 * q + 1]), vf, St[1]);
    }
    FENCE();
}
__device__ __forceinline__ void ret_unit(LAS unsigned char* lds, const int wid, const MixArgs& A, int bl, int h, int dvh) {
    const int lane = lane_now(), tid = wid * 64 + lane, eb = wid & 3, hf = wid >> 2;
    const int ib0 = hf ? 1 : 0, ib1 = hf ? 2 : 3, li = lane & 31, hh = lane >> 5;
    const size_t tb = (size_t)bl * SEQ;
    const float gamma = 1.0f - __builtin_amdgcn_exp2f(-5.0f - (float)h), lg = __builtin_amdgcn_logf(gamma);
    const float cdecay = __builtin_amdgcn_exp2f(128.0f * lg), cinv = __builtin_amdgcn_exp2f(-128.0f * lg);
    const int L0 = lds_addr(lds), X = ((li & 3) << 2) | ((li >> 2) & 3);
    int rb[8];
#pragma unroll
    for (int s = 0; s < 8; ++s) rb[s] = L0 + 256 * li + 16 * ((2 * s + hh) ^ X);
    int wb[4];
#pragma unroll
    for (int g = 0; g < 4; ++g) wb[g] = L0 + 256 * li + 16 * (g ^ (X & 3)) + 8 * hh;
    const int xh = X >> 2;
    const int tq = (lane & 15) >> 2, tp = lane & 3, tblk = (lane >> 4) & 1;
    int tv[2], tk[2][2];
#pragma unroll
    for (int t = 0; t < 2; ++t) {
        const int lp = 2048 * hh + 256 * tq + 16 * ((2 * tblk + (tp >> 1)) ^ (2 * hh + t)) + 8 * (tp & 1);
        tv[t] = L0 + 65536 + lp + 64 * (eb ^ tq);
#pragma unroll
        for (int k = 0; k < 2; ++k) tk[k][t] = L0 + 32768 + lp + 64 * ((2 * hf + k) ^ tq);
    }
    const int sS0 = 98304 + 8192 * eb, sA0 = 8192 * ib0, sB0 = 8192 * ib1;
    const int sw = 256 * (tid >> 4) + 16 * ((tid & 15) ^ ((((tid >> 4) & 3) << 2) | ((tid >> 6) & 3)));
    const unsigned gq = (unsigned)(((tid >> 4) * DIN + (tid & 15) * 8) * 2);
    const unsigned colb[3] = {(unsigned)(h * 128 * 2), (unsigned)((512 + h * 128) * 2), (unsigned)((1024 + h * 256 + dvh * 128) * 2)};
    const unsigned go0 = (unsigned)(((32 * ib0 + li) * DIN + 4 * hh) * 2), go1 = (unsigned)(((32 * ib1 + li) * DIN + 4 * hh) * 2);
    const unsigned oo0 = (unsigned)(((32 * ib0 + li) * 2048 + 4 * hh) * 2), oo1 = (unsigned)(((32 * ib1 + li) * 2048 + 4 * hh) * 2);
    f32x16 St[2];
#pragma unroll
    for (int i = 0; i < 2; ++i)
#pragma unroll
        for (int r = 0; r < 16; ++r) St[i][r] = 0.f;
    u32x4 pre[12];
    {
        const char* cb = (const char*)(A.proj + tb * DIN);
#pragma unroll
        for (int i = 0; i < 12; ++i) pre[i] = *(const u32x4*)(cb + (size_t)(i & 3) * 32 * DIN * 2 + (gq + colb[i >> 2]));
#pragma unroll
        for (int i = 0; i < 12; ++i) *(LAS u32x4*)(lds + (i >> 2) * 32768 + (i & 3) * 8192 + sw) = pre[i];
    }
    RET_BAR();
    for (int n = 0; n < 32; ++n) {
        const size_t t0 = tb + (size_t)n * 128;
        int sS = sS0, sA = sA0, sB = sB0, wl = wid;
        asm volatile("" : "+s"(sS), "+s"(sA), "+s"(sB), "+s"(wl));
        if (n + 1 < 32) {
            const char* cb = (const char*)(A.proj + (t0 + 128) * DIN);
#pragma unroll
            for (int i = 0; i < 12; ++i) pre[i] = *(const u32x4*)(cb + (size_t)(i & 3) * 32 * DIN * 2 + (gq + colb[i >> 2]));
        }
        f32x16 Oa[2];
#pragma unroll
        for (int i = 0; i < 2; ++i)
#pragma unroll
            for (int r = 0; r < 16; ++r) Oa[i][r] = 0.f;
        if (n > 0) {
#pragma unroll
            for (int s4 = 0; s4 < 2; ++s4) {
                bf16x8 sa[4], qa[4], qb[4];
#pragma unroll
                for (int s = 0; s < 4; ++s) { sa[s] = lds_b128(rb[4 * s4 + s] + sS); qa[s] = lds_b128(rb[4 * s4 + s] + sA); qb[s] = lds_b128(rb[4 * s4 + s] + sB); }
                FENCE();
#pragma unroll
                for (int s = 0; s < 4; ++s) { Oa[0] = MFMA32(sa[s], qa[s], Oa[0]); Oa[1] = MFMA32(sa[s], qb[s], Oa[1]); }
                FENCE();
            }
        }
        f32x16 sb[2]; int jbs[2], ibs[2];
#pragma unroll
        for (int u = 0; u < 2; ++u) {
            const int id = wl + 8 * u;
            const int ib = (id >= 6) ? 3 : (id >= 3) ? 2 : (id >= 1) ? 1 : 0, jb = id - (ib * (ib + 1)) / 2;
            ibs[u] = ib; jbs[u] = jb;
#pragma unroll
            for (int r = 0; r < 16; ++r) sb[u][r] = 0.f;
            if (id < 10) {
                bf16x8 fa[4], fb[4];
                const int ok = 32768 + 8192 * jb, oq = 8192 * ib;
#pragma unroll
                for (int h2 = 0; h2 < 2; ++h2) {
#pragma unroll
                    for (int s = 0; s < 4; ++s) { fa[s] = lds_b128(rb[4 * h2 + s] + ok); fb[s] = lds_b128(rb[4 * h2 + s] + oq); }
                    FENCE();
#pragma unroll
                    for (int s = 0; s < 4; ++s) sb[u] = MFMA32(fa[s], fb[s], sb[u]);
                    FENCE();
                }
            }
        }
        RET_BAR();
#pragma unroll
        for (int u = 0; u < 2; ++u) {
            const int id = wl + 8 * u;
            if (id < 10) {
                const int ib = ibs[u], jb = jbs[u], wo = 8192 * ib + 64 * (jb ^ xh);
#pragma unroll
                for (int g = 0; g < 4; ++g) {
                    float p[4];
#pragma unroll
                    for (int e = 0; e < 4; ++e) { const int j = 8 * g + 4 * hh + e; p[e] = (ib == jb && j > li) ? 0.f : sb[u][4 * g + e] * cinv; }
                    u32x2 w; w.x = cvt_pk_bf16(p[0], p[1]); w.y = cvt_pk_bf16(p[2], p[3]);
                    *(LAS u32x2*)(size_t)(unsigned)(wb[g] + wo) = w;
                }
            }
        }
        RET_BAR();
        u32x2 gg[2][4];
        { const char* gbp = (const char*)(A.proj + t0 * DIN + 2048 + h * 256 + dvh * 128 + 32 * eb);
#pragma unroll
          for (int g = 0; g < 4; ++g) { gg[0][g] = *(const u32x2*)(gbp + go0 + 16 * g); gg[1][g] = *(const u32x2*)(gbp + go1 + 16 * g); } }
#pragma unroll
        for (int k = 0; k < 2; ++k)
#pragma unroll
            for (int r = 0; r < 16; ++r) St[k][r] *= cdecay;
        ret_step34<0>(Oa, St, tv, tk, rb[0] + sA, rb[1] + sA, rb[0] + sB, rb[1] + sB, ib0, ib1);
        ret_step34<1>(Oa, St, tv, tk, rb[2] + sA, rb[3] + sA, rb[2] + sB, rb[3] + sB, ib0, ib1);
        ret_step34<2>(Oa, St, tv, tk, rb[4] + sA, rb[5] + sA, rb[4] + sB, rb[5] + sB, ib0, ib1);
        ret_step34<3>(Oa, St, tv, tk, rb[6] + sA, rb[7] + sA, rb[6] + sB, rb[7] + sB, ib0, ib1);
        RET_BAR();
#pragma unroll
        for (int k = 0; k < 2; ++k) {
            const int so = sS + 64 * ((2 * (wl >> 2) + k) ^ xh);
#pragma unroll
            for (int g = 0; g < 4; ++g) {
                u32x2 w; w.x = cvt_pk_bf16(St[k][4 * g], St[k][4 * g + 1]); w.y = cvt_pk_bf16(St[k][4 * g + 2], St[k][4 * g + 3]);
                *(LAS u32x2*)(size_t)(unsigned)(wb[g] + so) = w;
            }
        }
        if (n + 1 < 32) {
#pragma unroll
            for (int i = 0; i < 12; ++i) *(LAS u32x4*)(lds + (i >> 2) * 32768 + (i & 3) * 8192 + sw) = pre[i];
        }
        {
            char* obp = (char*)(A.act + t0 * 2048 + h * 256 + dvh * 128 + 32 * eb);
            float* sqp = A.ssq + (t0 * 4 + h) * 8 + dvh * 4 + eb;
#pragma unroll
            for (int k = 0; k < 2; ++k) {
                float sq = 0.f;
#pragma unroll
                for (int r = 0; r < 16; ++r) sq += Oa[k][r] * Oa[k][r];
                sq = xor32_sum(sq);
                if (hh == 0) sqp[(size_t)(32 * (k ? ib1 : ib0) + li) * 32] = sq;
                const unsigned oo = k ? oo1 : oo0;
                u32x2 w[4];
#pragma unroll
                for (int g = 0; g < 4; ++g) {
                    const u32x2 gv = gg[k][g];
                    w[g].x = cvt_pk_bf16(Oa[k][4 * g] * bf_lo(gv.x), Oa[k][4 * g + 1] * bf_hi(gv.x)); w[g].y = cvt_pk_bf16(Oa[k][4 * g + 2] * bf_lo(gv.y), Oa[k][4 * g + 3] * bf_hi(gv.y));
                }
#pragma unroll
                for (int g = 0; g < 4; g += 2) {
                    const auto sx = __builtin_amdgcn_permlane32_swap(w[g].x, w[g + 1].x, false, false), sy = __builtin_amdgcn_permlane32_swap(w[g].y, w[g + 1].y, false, false);
                    *(u32x4*)(obp + (oo - 8 * hh) + 16 * (g + hh)) = (u32x4){(unsigned)sx[0], (unsigned)sy[0], (unsigned)sx[1], (unsigned)sy[1]};
                }
            }
        }
        RET_BAR();
    }
    __syncthreads();
}

struct Args { const void* in[24]; float* out; unsigned char* ws; int ph_lo, ph_hi; };
struct Frame {
    LAS unsigned char* lds; int tid, lane, wave, G, vcu;
    const float *x, *c, *w_ada, *b_ada, *norm_mix, *w_in, *w_ret_o, *w_diff_o, *lq1, *lk1, *lq2, *lk2, *diff_norm, *w_out, *norm_ffn, *w_rg, *b_rg, *w_re, *b_re, *w_eg, *w_eu, *w_ed, *norm_final;
    const int* positions; float* out; unsigned char* ws;
};
__device__ __forceinline__ unsigned f2bf(float f) { unsigned u = __builtin_bit_cast(unsigned, f); return (u + 0x7fffu + ((u >> 16) & 1u)) >> 16; }
__device__ __forceinline__ unsigned pk2(float lo, float hi) { return f2bf(lo) | (f2bf(hi) << 16); }

template <int MODE>
__device__ __forceinline__ void p0_transpose_item(const float* W, int N, bf16_t* WT, int ldk, int koff, LAS float* scr, int item, int lane) {
    const int nblk = N / 32, kb = item / nblk, nb = item % nblk, k0 = 64 * kb, n0 = 32 * nb;
    { float wv[32];
#pragma unroll
      for (int i = 0; i < 32; ++i) { const int kk = 2 * i + (lane >> 5); wv[i] = W[(size_t)(k0 + kk) * N + n0 + (lane & 31)]; }
#pragma unroll
      for (int i = 0; i < 32; ++i) { const int kk = 2 * i + (lane >> 5); scr[kk * 33 + (lane & 31)] = wv[i]; } }
    LDS_WAIT(); asm volatile("" ::: "memory");
    const int c = lane & 7;
#pragma unroll
    for (int j = 0; j < 4; ++j) {
        const int nl = (lane >> 3) + 8 * j, n = n0 + nl; const LAS float* s = scr + (8 * c) * 33 + nl;
        int np = n; float sc = 1.f;
        if (MODE == 1) {
            const bool rope = (n < 1024) || (n >= 3072 && n < 5120);
            if (rope) { const int f = n & 127; np = (n & ~127) + 8 * ((f & 63) >> 2) + 4 * (f >> 6) + (f & 3); }
            if ((n >= 512 && n < 1024) || (n >= 4096 && n < 5120)) sc = 0.08838834764831845f;
            else if (n >= 3072 && n < 4096) sc = 1.4426950408889634f;
        } else if (MODE == 2) np = 8 * (n >> 2) + (n & 3);
        else if (MODE == 3) np = 8 * (n >> 2) + 4 + (n & 3);
        u32x4 o; o.x = pk2(s[0 * 33] * sc, s[1 * 33] * sc); o.y = pk2(s[2 * 33] * sc, s[3 * 33] * sc); o.z = pk2(s[4 * 33] * sc, s[5 * 33] * sc); o.w = pk2(s[6 * 33] * sc, s[7 * 33] * sc);
        *(u32x4*)(WT + (size_t)np * ldk + koff + k0 + 8 * c) = o;
    }
    LDS_WAIT(); asm volatile("" ::: "memory");
}

template <int MODE>
__device__ __forceinline__ void p0_transpose_item8(const float* W, int N, unsigned char* WT8, int ldk, LAS float* scr, int item, int lane) {
    const int nblk = N / 32, kb = item / nblk, nb = item % nblk, k0 = 64 * kb, n0 = 32 * nb;
    { float wv[32];
#pragma unroll
      for (int i = 0; i < 32; ++i) { const int kk = 2 * i + (lane >> 5); wv[i] = W[(size_t)(k0 + kk) * N + n0 + (lane & 31)]; }
#pragma unroll
      for (int i = 0; i < 32; ++i) { const int kk = 2 * i + (lane >> 5); scr[kk * 33 + (lane & 31)] = wv[i]; } }
    LDS_WAIT(); asm volatile("" ::: "memory");
    const int c = lane & 7;
#pragma unroll
    for (int j = 0; j < 4; ++j) {
        const int nl = (lane >> 3) + 8 * j, n = n0 + nl; const LAS float* s = scr + (8 * c) * 33 + nl;
        const int np = (MODE == 2) ? 8 * (n >> 2) + (n & 3) : (MODE == 3) ? 8 * (n >> 2) + 4 + (n & 3) : n;
        u32x2 o; o.x = pk4_fp8(s[0 * 33] * 32.f, s[1 * 33] * 32.f, s[2 * 33] * 32.f, s[3 * 33] * 32.f); o.y = pk4_fp8(s[4 * 33] * 32.f, s[5 * 33] * 32.f, s[6 * 33] * 32.f, s[7 * 33] * 32.f);
        *(u32x2*)(WT8 + (size_t)np * ldk + k0 + 8 * c) = o;
    }
    LDS_WAIT(); asm volatile("" ::: "memory");
}
template <int MODE>
__device__ __forceinline__ void p0_transpose_pair8(const float* W, int N, unsigned char* WT8, int ldk, LAS float* scr, int item, int lane) {
    const int nblk = N / 32;
    float wa[32], wb[32];
    { const int kb = item / nblk, nb = item % nblk, k0 = 64 * kb, n0 = 32 * nb;
#pragma unroll
      for (int i = 0; i < 32; ++i) { const int kk = 2 * i + (lane >> 5); wa[i] = W[(size_t)(k0 + kk) * N + n0 + (lane & 31)]; } }
    { const int kb = (item + 1) / nblk, nb = (item + 1) % nblk, k0 = 64 * kb, n0 = 32 * nb;
#pragma unroll
      for (int i = 0; i < 32; ++i) { const int kk = 2 * i + (lane >> 5); wb[i] = W[(size_t)(k0 + kk) * N + n0 + (lane & 31)]; } }
#pragma unroll
    for (int h = 0; h < 2; ++h) {
        const int it = item + h, kb = it / nblk, nb = it % nblk, k0 = 64 * kb, n0 = 32 * nb;
#pragma unroll
        for (int i = 0; i < 32; ++i) { const int kk = 2 * i + (lane >> 5); scr[kk * 33 + (lane & 31)] = h ? wb[i] : wa[i]; }
        LDS_WAIT(); asm volatile("" ::: "memory");
        const int c = lane & 7;
#pragma unroll
        for (int j = 0; j < 4; ++j) {
            const int nl = (lane >> 3) + 8 * j, n = n0 + nl; const LAS float* sp = scr + (8 * c) * 33 + nl;
            const int np = (MODE == 2) ? 8 * (n >> 2) + (n & 3) : (MODE == 3) ? 8 * (n >> 2) + 4 + (n & 3) : n;
            u32x2 o; o.x = pk4_fp8(sp[0 * 33] * 32.f, sp[1 * 33] * 32.f, sp[2 * 33] * 32.f, sp[3 * 33] * 32.f); o.y = pk4_fp8(sp[4 * 33] * 32.f, sp[5 * 33] * 32.f, sp[6 * 33] * 32.f, sp[7 * 33] * 32.f);
            *(u32x2*)(WT8 + (size_t)np * ldk + k0 + 8 * c) = o;
        }
        LDS_WAIT(); asm volatile("" ::: "memory");
    }
}

__device__ __forceinline__ void p0_prologue(Frame& F) {
    F.lane = lane_now(); F.tid = F.wave * 64 + F.lane;
    float* mod = (float*)(F.ws + WS_MOD);
    LAS float* sc = (LAS float*)F.lds;
    for (int i = F.tid; i < NB * D; i += NTHR) { const float v = F.c[i]; sc[(i & 1023) * 8 + (i >> 10)] = v / (1.0f + __expf(-v)); }
    __syncthreads();
    LAS float* red = (LAS float*)(F.lds + 32768);
    for (int item = blockIdx.x; item < 192; item += F.G) {
        const int cl = F.tid & 31, kg = F.tid >> 5, col = item * 32 + cl;
        const float* wp = F.w_ada + (size_t)(kg * 64) * 6144 + col;
        float w[64];
#pragma unroll
        for (int k = 0; k < 64; ++k) w[k] = wp[(size_t)k * 6144];
        float a[8];
#pragma unroll
        for (int b = 0; b < 8; ++b) a[b] = 0.f;
#pragma unroll
        for (int k = 0; k < 64; ++k) { const f32x4 s0 = *(const LAS f32x4*)(sc + (kg * 64 + k) * 8), s1 = *(const LAS f32x4*)(sc + (kg * 64 + k) * 8 + 4);
            a[0] += s0.x * w[k]; a[1] += s0.y * w[k]; a[2] += s0.z * w[k]; a[3] += s0.w * w[k]; a[4] += s1.x * w[k]; a[5] += s1.y * w[k]; a[6] += s1.z * w[k]; a[7] += s1.w * w[k]; }
#pragma unroll
        for (int b = 0; b < 8; ++b) red[(kg * 8 + b) * 32 + cl] = a[b];
        __syncthreads();
        if (F.tid < 256) { const int b = F.tid >> 5; float s = 0.f;
#pragma unroll
          for (int g = 0; g < 16; ++g) s += red[(g * 8 + b) * 32 + cl];
          mod[(size_t)b * 6144 + col] = s + F.b_ada[col]; }
        __syncthreads();
    }
    if (blockIdx.x == 0 && F.wave == 0) {
        float s1 = F.lq1[F.lane] * F.lk1[F.lane] + F.lq1[F.lane + 64] * F.lk1[F.lane + 64], s2 = F.lq2[F.lane] * F.lk2[F.lane] + F.lq2[F.lane + 64] * F.lk2[F.lane + 64];
        s1 = wave_sum(s1); s2 = wave_sum(s2);
        if (F.lane == 0) *(float*)(F.ws + WS_MOD + 256 * 1024) = __expf(s1) - __expf(s2) + 0.2f;
    }
    { bf16_t* rth = (bf16_t*)(F.ws + WS_MOD + 512 * 1024); bf16_t* rtl = rth + 48 * D;
      for (int i = blockIdx.x * NTHR + F.tid; i < 48 * D; i += F.G * NTHR) { const int o = i >> 10, k = i & 1023; const float w = (o < 4) ? F.w_rg[k * 4 + o] : (o < 36) ? F.w_re[k * 32 + (o - 4)] : 0.f;
          const unsigned h = f2bf(w); rth[i] = (bf16_t)h; rtl[i] = (bf16_t)f2bf(w - __uint_as_float(h << 16)); } }
    __syncthreads();
    LAS float* scr = (LAS float*)(F.lds + F.wave * 16384);
    const int gw = launder_s(F.vcu * NWAVES + F.wave), NGW = F.G * NWAVES;
    constexpr int I_IN = 16 * 256, I_SQ = 16 * 32;
    constexpr int NITEMS = I_IN + 3 * I_SQ;
    bf16_t* Win = (bf16_t*)(F.ws + WS_WIN); bf16_t* Wmix = (bf16_t*)(F.ws + WS_WMIX); bf16_t* Wout = (bf16_t*)(F.ws + WS_WOUT);
    for (int it = gw; it < NITEMS; it += NGW) {
        int r = it;
        if (r < I_IN) { p0_transpose_item<1>(F.w_in, DIN, Win, 1024, 0, scr, r, F.lane); continue; } r -= I_IN;
        if (r < I_SQ) { p0_transpose_item<0>(F.w_ret_o, D, Wmix, 2048, 0, scr, r, F.lane); continue; } r -= I_SQ;
        if (r < I_SQ) { p0_transpose_item<0>(F.w_diff_o, D, Wmix, 2048, 1024, scr, r, F.lane); continue; } r -= I_SQ;
        p0_transpose_item<0>(F.w_out, D, Wout, 1024, 0, scr, r, F.lane);
    }
    float* cosT = (float*)(F.ws + WS_COS); float* sinT = (float*)(F.ws + WS_SIN);
    {
        constexpr int RIT = 16;
        const int stride = F.G * NTHR;
        for (int base = blockIdx.x * NTHR + F.tid; base < T * 64; base += stride * RIT) {
            int pos[RIT];
#pragma unroll
            for (int q = 0; q < RIT; ++q) { const int i = base + q * stride; pos[q] = (i < T * 64) ? F.positions[i >> 6] : 0; }
#pragma unroll
            for (int q = 0; q < RIT; ++q) {
                const int i = base + q * stride; if (i >= T * 64) break;
                const int j = i & 63;
                const float inv = __builtin_amdgcn_exp2f(-(float)j * (13.287712379549449f / 64.0f));
                const float ang = (float)pos[q] * inv;
                double rev = (double)ang * 0.15915494309189535; rev -= __builtin_rint(rev);
                const float rf = (float)rev;
                cosT[i] = __builtin_amdgcn_cosf(rf); sinT[i] = __builtin_amdgcn_sinf(rf);
            }
        }
    }
}

__device__ __forceinline__ void convert_experts(Frame& F) {
    constexpr int I_G = 32 * 256, NCH = (3 * I_G) / 32;
    unsigned* q2 = (unsigned*)(F.ws + WS_CTL) + CW_Q + 64 * 8;
    volatile LAS int* bc = (volatile LAS int*)(F.lds + LDSCTL_OFF + 64);
    LAS float* scr = (LAS float*)(F.lds + F.wave * 16384);
    unsigned char* Wgu = F.ws + WS_WGU; unsigned char* Wdn = F.ws + WS_WDN;
    const int lane = lane_now();
    for (;;) {
        __syncthreads();
        if (F.wave == 0 && lane_now() == 0) bc[0] = (int)__hip_atomic_fetch_add(q2, 1u, __ATOMIC_RELAXED, __HIP_MEMORY_SCOPE_AGENT);
        __syncthreads();
        const int c = bc[0];
        if (c >= NCH) break;
        for (int k = 0; k < 4; k += 2) {
            int r = c * 32 + F.wave * 4 + k;
            if (r < I_G) { const int e = r >> 8; p0_transpose_pair8<2>(F.w_eg + (size_t)e * D * DEXP, DEXP, Wgu + (size_t)e * 1024 * 1024, 1024, scr, r & 255, lane); continue; } r -= I_G;
            if (r < I_G) { const int e = r >> 8; p0_transpose_pair8<3>(F.w_eu + (size_t)e * D * DEXP, DEXP, Wgu + (size_t)e * 1024 * 1024, 1024, scr, r & 255, lane); continue; } r -= I_G;
            { const int e = r >> 8; p0_transpose_pair8<0>(F.w_ed + (size_t)e * DEXP * D, D, Wdn + (size_t)e * 1024 * 512, 512, scr, r & 255, lane); }
        }
    }
    __syncthreads();
}

__device__ __forceinline__ void p1_norm_mod(Frame& F) {
    F.lane = lane_now(); F.tid = F.wave * 64 + F.lane;
    const float* mod = (const float*)(F.ws + WS_MOD); bf16_t* H0 = (bf16_t*)(F.ws + WS_H); bf16_t* H1 = (bf16_t*)(F.out + (size_t)TH * D);
    const int gw = launder_s(F.vcu * NWAVES + F.wave), NGW = F.G * NWAVES;
    f32x4 v[4], vn[4];
    if (gw < T) { const f32x4* xr = (const f32x4*)(F.x + (size_t)gw * D) + F.lane;
#pragma unroll
        for (int j = 0; j < 4; ++j) v[j] = xr[64 * j]; }
    for (int t = gw; t < T; t += NGW) {
        const int b = t >> 12;
        f32x4 gs[4], sh[4];
#pragma unroll
        for (int j = 0; j < 4; ++j) { const int col = 4 * F.lane + 256 * j;
            const f32x4 g = *(const f32x4*)(F.norm_mix + col), sc = *(const f32x4*)(mod + (size_t)b * 6144 + 1024 + col); sh[j] = *(const f32x4*)(mod + (size_t)b * 6144 + col); gs[j] = g * (sc + 1.0f); }
        if (t + NGW < T) { const f32x4* xr = (const f32x4*)(F.x + (size_t)(t + NGW) * D) + F.lane;
#pragma unroll
            for (int j = 0; j < 4; ++j) vn[j] = xr[64 * j]; }
        float s = 0.f;
#pragma unroll
        for (int j = 0; j < 4; ++j) s += (v[j].x * v[j].x + v[j].y * v[j].y) + (v[j].z * v[j].z + v[j].w * v[j].w);
        const float rstd = 1.0f / sqrtf(wave_sum(s) * (1.0f / D) + EPS);
        u32x2* o8 = (u32x2*)((t < TH ? H0 : H1) + (size_t)(t & (TH - 1)) * D) + F.lane;
#pragma unroll
        for (int j = 0; j < 4; ++j) { const f32x4 y = (v[j] * rstd) * gs[j] + sh[j]; u32x2 w; w.x = cvt_pk_bf16(y.x, y.y); w.y = cvt_pk_bf16(y.z, y.w);
            o8[64 * j] = w; }
#pragma unroll
        for (int j = 0; j < 4; ++j) v[j] = vn[j];
    }
}

__device__ __forceinline__ void p3_mix(Frame& F, int hf) {
    F.lane = lane_now(); F.tid = F.wave * 64 + F.lane;
    MixArgs A; A.proj = (const bf16_t*)(F.ws + WS_PROJ); A.act = (bf16_t*)(F.ws + WS_ACT); A.diff_norm = F.diff_norm; A.ssq = (float*)(F.ws + WS_SSQ);
    A.lam = __uint_as_float(__builtin_amdgcn_readfirstlane(*(const unsigned*)(F.ws + WS_MOD + 256 * 1024)));
    unsigned* qbase = (unsigned*)(F.ws + WS_CTL) + CW_Q + 64 * 16 + 64 * 8 * hf;
    volatile LAS int* bc = (volatile LAS int*)(F.lds + LDSCTL_OFF + 64);
    const int x0 = (int)(xb_xcc_id() & 7u);
    int curk = 0; bool havepre = false;
    for (;;) {
        __syncthreads();
        if (F.wave == 0) {
            const int lane = lane_now();
            int u = -1, xq = (x0 + curk) & 7;
            for (int it = 0; it < 64; ++it) {
                int got = -1;
                if (havepre) got = bc[2];
                else if (lane == 0) got = (int)__hip_atomic_fetch_add(qbase + 64 * xq, 1u, __ATOMIC_RELAXED, __HIP_MEMORY_SCOPE_AGENT);
                havepre = false;
                got = __builtin_amdgcn_readfirstlane(got);
                if (got < 4 + 64) { u = got; break; }
                unsigned c = 4u + 64u;
                if (lane < 8) c = __hip_atomic_load(qbase + 64 * ((x0 + lane) & 7), __ATOMIC_RELAXED, __HIP_MEMORY_SCOPE_AGENT);
                const unsigned long long m = __builtin_amdgcn_ballot_w64(lane < 8 && c < 4u + 64u);
                if (m == 0ull) break;
                xq = (x0 + (int)__builtin_ctzll(m)) & 7;
            }
            curk = (xq - x0) & 7;
            if (lane == 0) { bc[0] = u; bc[1] = xq; }
        }
        __syncthreads();
        const int u = __builtin_amdgcn_readfirstlane(bc[0]), xq = __builtin_amdgcn_readfirstlane(bc[1]);
        if (u < 0) break;
#ifndef MIX_NO_RET
        if (u < 4) { const int bh = 2 * xq + (u >> 1); ret_unit(F.lds, F.wave, A, bh >> 2, bh & 3, u & 1); }
#endif
#ifndef MIX_NO_ATTN
        if (u >= 4) { const int v = u - 4, qb = 31 - (v >> 1), bh = 2 * xq + (v & 1);
            int pre = 0;
            if (F.wave == 0 && lane_now() == 0) pre = (int)__hip_atomic_fetch_add(qbase + 64 * xq, 1u, __ATOMIC_RELAXED, __HIP_MEMORY_SCOPE_AGENT);
            attn_unit(F.lds, F.wave, A, bh >> 2, bh & 3, qb, pre, bc + 2);
            havepre = true; }
#endif
    }
    convert_experts(F);
}

typedef float f32x4v __attribute__((ext_vector_type(4)));
__device__ __forceinline__ void p6_router(Frame& F, bool dummy) {
    F.lane = lane_now(); F.tid = F.wave * 64 + F.lane;
    const float* mod = (const float*)(F.ws + WS_MOD); const bf16_t* rth = (const bf16_t*)(F.ws + WS_MOD + 512 * 1024); const bf16_t* rtl = rth + 48 * D;
    unsigned char* H2 = F.ws + WS_H2; const float* x1 = F.x;
    const size_t rbase = dummy ? WS_EACT : WS_ROUT;
    int* tok_e = (int*)(F.ws + rbase); float* tok_w = (float*)(F.ws + rbase + 256 * 1024); int* tok_slot = (int*)(F.ws + rbase + 512 * 1024); int* list = (int*)(F.ws + rbase + 1024 * 1024);
    unsigned* cnt = (unsigned*)(F.ws + WS_CTL) + CW_CNT + (dummy ? 64 : 0);
    LAS int* hist = (LAS int*)(F.lds + LDSCTL_OFF + 256);
    constexpr int RSTR = 4112;
    LAS unsigned char* Xt = F.lds;
    LAS float* part = (LAS float*)(F.lds + 65792);
    LAS float* lgt = (LAS float*)(F.lds + 65792 + 24576);
    unsigned* ghist = (unsigned*)(F.ws + rbase + 768 * 1024);
    for (int tb = blockIdx.x; tb < T / 128; tb += F.G) {
        if (F.tid < 64) hist[F.tid] = 0;
        bf16x8 bwh[4][3], bwl[4][3];
        { const int ln = launder_i(F.lane), r = ln & 15, kq = ln >> 4, k0 = 128 * F.wave + 8 * kq;
#pragma unroll
          for (int g = 0; g < 4; ++g)
#pragma unroll
              for (int nb = 0; nb < 3; ++nb) { const unsigned wi = (unsigned)((16 * nb + r) * D + k0 + 32 * g); bwh[g][nb] = *(const bf16x8*)(rth + wi); bwl[g][nb] = *(const bf16x8*)(rtl + wi); } }
        f32x4 v[2][4]; u32x2 dv[2][4];
        const unsigned char* dbase = F.ws + delta_off(tb * 128);
#pragma unroll
        for (int q = 0; q < 2; ++q) { const f32x4* xr = (const f32x4*)(x1 + (size_t)(tb * 128 + 2 * F.wave + q) * D) + F.lane; const u32x2* dr = (const u32x2*)(dbase + (size_t)(2 * F.wave + q) * 2048) + F.lane;
#pragma unroll
            for (int j = 0; j < 4; ++j) { v[q][j] = xr[64 * j]; dv[q][j] = dr[64 * j]; } }
        LAS f32x4* gsl = (LAS f32x4*)(F.lds + 114944);
        if (F.wave == 0) { const int b = (tb * 128) >> 12;
#pragma unroll
          for (int j = 0; j < 4; ++j) { const int col = 4 * F.lane + 256 * j;
              const f32x4 g = *(const f32x4*)(F.norm_ffn + col), sc = *(const f32x4*)(mod + (size_t)b * 6144 + 4096 + col), sh = *(const f32x4*)(mod + (size_t)b * 6144 + 3072 + col);
              gsl[F.lane + 64 * j] = g * (sc + 1.0f); gsl[256 + F.lane + 64 * j] = sh; } }
        __syncthreads();
        for (int ps = 0; ps < 8; ++ps) {
#pragma unroll
            for (int q = 0; q < 2; ++q) {
                const int tk = 2 * F.wave + q, t = tb * 128 + ps * 16 + tk;
#pragma unroll
                for (int j = 0; j < 4; ++j) { const u32x2 d = dv[q][j]; v[q][j].x += bf_lo(d.x); v[q][j].y += bf_hi(d.x); v[q][j].z += bf_lo(d.y); v[q][j].w += bf_hi(d.y); }
                float s = 0.f;
#pragma unroll
                for (int j = 0; j < 4; ++j) s += (v[q][j].x * v[q][j].x + v[q][j].y * v[q][j].y) + (v[q][j].z * v[q][j].z + v[q][j].w * v[q][j].w);
                const float rstd = 1.0f / sqrtf(wave_sum(s) * (1.0f / D) + EPS);
                unsigned* o4 = (unsigned*)(H2 + (size_t)t * D) + F.lane;
#pragma unroll
                for (int j = 0; j < 4; ++j) {
                    const int col = 4 * F.lane + 256 * j;
                    const f32x4 y = (v[q][j] * rstd) * gsl[F.lane + 64 * j] + gsl[256 + F.lane + 64 * j];
                    o4[64 * j] = pk4_fp8(y.x, y.y, y.z, y.w);
                    *(LAS f32x4*)(Xt + tk * RSTR + col * 4) = y;
                }
            }
            if (ps + 1 < 8) {
#pragma unroll
                for (int q = 0; q < 2; ++q) { const f32x4* xr = (const f32x4*)(x1 + (size_t)(tb * 128 + (ps + 1) * 16 + 2 * F.wave + q) * D) + F.lane; const u32x2* dr = (const u32x2*)(dbase + (size_t)((ps + 1) * 16 + 2 * F.wave + q) * 2048) + F.lane;
#pragma unroll
                    for (int j = 0; j < 4; ++j) { v[q][j] = xr[64 * j]; dv[q][j] = dr[64 * j]; } }
            }
            __syncthreads();
            {
                const int r = F.lane & 15, kq = F.lane >> 4, k0 = 128 * F.wave + 8 * kq;
                f32x4v acc[3];
#pragma unroll
                for (int nb = 0; nb < 3; ++nb) acc[nb] = (f32x4v){0.f, 0.f, 0.f, 0.f};
#pragma unroll
                for (int g = 0; g < 4; ++g) {
                    const f32x4 a0 = *(const LAS f32x4*)(Xt + r * RSTR + (k0 + 32 * g) * 4), a1 = *(const LAS f32x4*)(Xt + r * RSTR + (k0 + 32 * g + 4) * 4);
                    unsigned hp[4], lp[4];
#pragma unroll
                    for (int q = 0; q < 4; ++q) { const float x0 = (q < 2) ? a0[2 * q] : a1[2 * q - 4], x1 = (q < 2) ? a0[2 * q + 1] : a1[2 * q - 3];
                        hp[q] = cvt_pk_bf16(x0, x1); lp[q] = cvt_pk_bf16(x0 - bf_lo(hp[q]), x1 - bf_hi(hp[q])); }
                    const bf16x8 ah = __builtin_bit_cast(bf16x8, (u32x4){hp[0], hp[1], hp[2], hp[3]}), al = __builtin_bit_cast(bf16x8, (u32x4){lp[0], lp[1], lp[2], lp[3]});
#pragma unroll
                    for (int nb = 0; nb < 3; ++nb) {
                        acc[nb] = __builtin_amdgcn_mfma_f32_16x16x32_bf16(ah, bwh[g][nb], acc[nb], 0, 0, 0);
                        acc[nb] = __builtin_amdgcn_mfma_f32_16x16x32_bf16(ah, bwl[g][nb], acc[nb], 0, 0, 0);
                        acc[nb] = __builtin_amdgcn_mfma_f32_16x16x32_bf16(al, bwh[g][nb], acc[nb], 0, 0, 0);
                    }
                }
#pragma unroll
                for (int nb = 0; nb < 3; ++nb)
#pragma unroll
                    for (int e = 0; e < 4; ++e) part[(F.wave * 16 + 4 * kq + e) * 48 + 16 * nb + r] = acc[nb][e];
            }
            __syncthreads();
            for (int idx = F.tid; idx < 16 * 36; idx += NTHR) { const int tk = idx / 36, o = idx - tk * 36; float s = 0.f;
#pragma unroll
                for (int w = 0; w < 8; ++w) s += part[(w * 16 + tk) * 48 + o];
                lgt[(ps * 16 + tk) * 48 + o] = s; }
        }
        __syncthreads();
        if (F.tid < 128) {
            const int t = tb * 128 + F.tid;
            float lg[36];
#pragma unroll
            for (int o = 0; o < 36; ++o) lg[o] = lgt[F.tid * 48 + o];
            float gl[4];
#pragma unroll
            for (int g = 0; g < 4; ++g) gl[g] = lg[g] + F.b_rg[g];
            int gs = 0; float gm = gl[0];
#pragma unroll
            for (int g = 1; g < 4; ++g) if (gl[g] > gm) { gm = gl[g]; gs = g; }
            float gden = 0.f;
#pragma unroll
            for (int g = 0; g < 4; ++g) gden += __expf(gl[g] - gm);
            const float gtop = 1.0f / gden;
            float el[8];
#pragma unroll
            for (int j = 0; j < 8; ++j) {
                const float v0 = lg[4 + j], v1 = lg[12 + j], v2 = lg[20 + j], v3 = lg[28 + j];
                el[j] = ((gs == 0) ? v0 : (gs == 1) ? v1 : (gs == 2) ? v2 : v3) + F.b_re[gs * 8 + j];
            }
            int e1 = 0; float m1 = el[0];
#pragma unroll
            for (int j = 1; j < 8; ++j) if (el[j] > m1) { m1 = el[j]; e1 = j; }
            int e2 = -1; float m2 = -INFINITY;
#pragma unroll
            for (int j = 0; j < 8; ++j) if (j != e1 && el[j] > m2) { m2 = el[j]; e2 = j; }
            const float w1 = 1.0f / (1.0f + __expf(m2 - m1)), w2 = 1.0f - w1;
            const int ea = gs * 8 + e1, eb = gs * 8 + e2;
            tok_e[2 * t] = ea; tok_e[2 * t + 1] = eb; tok_w[2 * t] = gtop * w1; tok_w[2 * t + 1] = gtop * w2;
            tok_slot[2 * t] = __hip_atomic_fetch_add(&hist[ea], 1, __ATOMIC_RELAXED, __HIP_MEMORY_SCOPE_WORKGROUP); tok_slot[2 * t + 1] = __hip_atomic_fetch_add(&hist[eb], 1, __ATOMIC_RELAXED, __HIP_MEMORY_SCOPE_WORKGROUP);
        }
        __syncthreads();
        if (F.tid < 32) ghist[tb * 32 + F.tid] = (unsigned)hist[F.tid];
        __syncthreads();
    }
}
__device__ __forceinline__ void p6b_lists(Frame& F) {
    F.lane = lane_now(); F.tid = F.wave * 64 + F.lane;
    const int* tok_e = (const int*)(F.ws + WS_ROUT); int* tok_slot = (int*)(F.ws + WS_ROUT + 512 * 1024); int* list = (int*)(F.ws + WS_ROUT + 1024 * 1024);
    const unsigned* ghist = (const unsigned*)(F.ws + WS_ROUT + 768 * 1024);
    unsigned* cnt = (unsigned*)(F.ws + WS_CTL) + CW_CNT;
    LAS int* red = (LAS int*)(F.lds + LDSCTL_OFF + 256);
    for (int tb = blockIdx.x; tb < T / 128; tb += F.G) {
        __syncthreads();
        { const int e = F.tid & 31, pt = F.tid >> 5; int s = 0, tot = 0;
          int cv[T / 128 / 16];
#pragma unroll
          for (int q = 0; q < T / 128 / 16; ++q) cv[q] = (int)ghist[(pt + 16 * q) * 32 + e];
#pragma unroll
          for (int q = 0; q < T / 128 / 16; ++q) { tot += cv[q]; if (pt + 16 * q < tb) s += cv[q]; }
          red[pt * 32 + e] = s; red[1024 + pt * 32 + e] = tot; }
        __syncthreads();
        if (F.tid < 32) { int s = 0, tot = 0;
#pragma unroll
            for (int pt = 0; pt < 16; ++pt) { s += red[pt * 32 + F.tid]; tot += red[1024 + pt * 32 + F.tid]; }
            red[512 + F.tid] = s; if (tb == 0) cnt[F.tid] = (unsigned)tot; }
        __syncthreads();
        if (F.tid < 256) {
            const int a = tb * 256 + F.tid, e = tok_e[a], slot = red[512 + e] + tok_slot[a];
            tok_slot[a] = slot; list[(size_t)e * T + slot] = a;
        }
    }
}

__device__ __forceinline__ void moe_table(Frame& F, LAS int* rbs) {
    F.lane = lane_now(); F.tid = F.wave * 64 + F.lane;
    const unsigned* cnt = (const unsigned*)(F.ws + WS_CTL) + CW_CNT;
    if (F.wave == 0) {
        const int e = F.lane;
        int c = 0;
        if (e < NEXP) { c = (int)__hip_atomic_load(cnt + e, __ATOMIC_RELAXED, __HIP_MEMORY_SCOPE_AGENT); rbs[64 + e] = c; }
        asm volatile("s_waitcnt lgkmcnt(0)" ::: "memory");
        if (e < NEXP) {
            int a = 0;
            for (int j = 0; j < e; ++j) a += (rbs[64 + j] + 255) >> 8;
            const int nb = (c + 255) >> 8;
            rbs[e] = a;
            for (int q = 0; q < nb; ++q) rbs[128 + a + q] = e;
            if (e == NEXP - 1) rbs[32] = a + nb;
        }
    }
    __syncthreads();
}

__device__ __forceinline__ void p9_final(Frame& F, const LAS int* rbs, bool dummy) {
    F.lane = lane_now(); F.tid = F.wave * 64 + F.lane;
    const float* mod = (const float*)(F.ws + WS_MOD); const unsigned char* Y = F.ws + WS_Y;
    const float* X = F.x;
    const int* tok_e = (const int*)(F.ws + WS_ROUT); const int* tok_slot = (const int*)(F.ws + WS_ROUT + 512 * 1024);
    const int gw = launder_s(F.vcu * NWAVES + F.wave), NGW = F.G * NWAVES;
    f32x4 ng[4];
#pragma unroll
    for (int j = 0; j < 4; ++j) ng[j] = *(const f32x4*)(F.norm_final + 4 * F.lane + 256 * j);
    f32x4 xv[4], xn[4]; unsigned ya[4], yb[4], yan[4], ybn[4]; u32x2 da[4], dn[4];
    int e0n = 0, e1n = 0, s0n = 0, s1n = 0;
    if (gw < T) {
        const int p0 = rbs[tok_e[2 * gw]] * 256 + tok_slot[2 * gw], p1 = rbs[tok_e[2 * gw + 1]] * 256 + tok_slot[2 * gw + 1];
        const f32x4* xr = (const f32x4*)(X + (size_t)gw * D) + F.lane; const unsigned* y0 = (const unsigned*)(Y + (size_t)p0 * D) + F.lane; const unsigned* y1 = (const unsigned*)(Y + (size_t)p1 * D) + F.lane;
        const u32x2* dr = (const u32x2*)(F.ws + delta_off(gw)) + F.lane;
#pragma unroll
        for (int j = 0; j < 4; ++j) { xv[j] = xr[64 * j]; ya[j] = y0[64 * j]; yb[j] = y1[64 * j]; da[j] = dr[64 * j]; }
        if (gw + NGW < T) { const int tn = gw + NGW; e0n = tok_e[2 * tn]; e1n = tok_e[2 * tn + 1]; s0n = tok_slot[2 * tn]; s1n = tok_slot[2 * tn + 1]; }
    }
    for (int t = gw; t < T; t += NGW) {
        const int b = t >> 12;
        f32x4 g2[4];
#pragma unroll
        for (int j = 0; j < 4; ++j) g2[j] = *(const f32x4*)(mod + (size_t)b * 6144 + 5120 + 4 * F.lane + 256 * j);
        if (t + NGW < T) {
            const int tn = t + NGW, p0 = rbs[e0n] * 256 + s0n, p1 = rbs[e1n] * 256 + s1n;
            const f32x4* xr = (const f32x4*)(X + (size_t)tn * D) + F.lane; const unsigned* y0 = (const unsigned*)(Y + (size_t)p0 * D) + F.lane; const unsigned* y1 = (const unsigned*)(Y + (size_t)p1 * D) + F.lane;
            const u32x2* dr = (const u32x2*)(F.ws + delta_off(tn)) + F.lane;
#pragma unroll
            for (int j = 0; j < 4; ++j) { xn[j] = xr[64 * j]; yan[j] = y0[64 * j]; ybn[j] = y1[64 * j]; dn[j] = dr[64 * j]; }
            if (tn + NGW < T) { const int t2 = tn + NGW; e0n = tok_e[2 * t2]; e1n = tok_e[2 * t2 + 1]; s0n = tok_slot[2 * t2]; s1n = tok_slot[2 * t2 + 1]; }
        }
        f32x4 v[4]; float s = 0.f;
#pragma unroll
        for (int j = 0; j < 4; ++j) {
            const int a = (int)ya[j], c = (int)yb[j];
            const f32x2 a0 = __builtin_amdgcn_cvt_pk_f32_fp8(a, false), a1 = __builtin_amdgcn_cvt_pk_f32_fp8(a, true), c0 = __builtin_amdgcn_cvt_pk_f32_fp8(c, false), c1 = __builtin_amdgcn_cvt_pk_f32_fp8(c, true);
            f32x4 y; y.x = (a0.x + c0.x) * 0.0625f; y.y = (a0.y + c0.y) * 0.0625f; y.z = (a1.x + c1.x) * 0.0625f; y.w = (a1.y + c1.y) * 0.0625f;
            const u32x2 dd = da[j]; const f32x4 dl = {bf_lo(dd.x), bf_hi(dd.x), bf_lo(dd.y), bf_hi(dd.y)};
            v[j] = (xv[j] + dl) + g2[j] * y;
            s += (v[j].x * v[j].x + v[j].y * v[j].y) + (v[j].z * v[j].z + v[j].w * v[j].w);
        }
        const float rstd = 1.0f / sqrtf(wave_sum(s) * (1.0f / D) + EPS);
        f32x4* xo = dummy ? (f32x4*)((float*)(F.ws + WS_H2) + (size_t)t * D) + F.lane : (f32x4*)(F.out + (size_t)t * D) + F.lane;
#pragma unroll
        for (int j = 0; j < 4; ++j) __builtin_nontemporal_store(v[j] * rstd * ng[j], xo + 64 * j);
#pragma unroll
        for (int j = 0; j < 4; ++j) { xv[j] = xn[j]; ya[j] = yan[j]; yb[j] = ybn[j]; da[j] = dn[j]; }
    }
}

constexpr int MOE_MAXU = 8;
__device__ __forceinline__ void moe_unit_tables(Frame& F, const LAS int* rbs, int nunits, bool weights) {
    const int tid = tid_now(F.wave);
    const int* list = (const int*)(F.ws + WS_ROUT + 1024 * 1024); const float* tokw = (const float*)(F.ws + WS_ROUT + 256 * 1024);
    LAS unsigned short* tokl = (LAS unsigned short*)(F.lds + LDSCTL_OFF + 4096); LAS float* wl = (LAS float*)(F.lds + LDSCTL_OFF + 8192);
    int av[MOE_MAXU / 2]; bool live[MOE_MAXU / 2], inr[MOE_MAXU / 2];
#pragma unroll
    for (int q = 0; q < MOE_MAXU / 2; ++q) {
        const int j = 2 * q + (tid >> 8), r = tid & 255, L = j * F.G + F.vcu;
        live[q] = L < nunits; inr[q] = false; av[q] = 0;
        if (live[q]) {
            const int rbi = L >> 2, e = rbs[128 + rbi], sl = (rbi - rbs[e]) * 256 + r, ce = rbs[64 + e];
            inr[q] = sl < ce;
            av[q] = list[(size_t)e * T + (inr[q] ? sl : 0)];
        }
    }
    float wv[MOE_MAXU / 2];
#pragma unroll
    for (int q = 0; q < MOE_MAXU / 2; ++q) wv[q] = (weights && live[q] && inr[q]) ? tokw[av[q]] * 0.5f : 0.f;
#pragma unroll
    for (int q = 0; q < MOE_MAXU / 2; ++q) {
        const int j = 2 * q + (tid >> 8), r = tid & 255;
        if (live[q]) { if (weights) wl[j * 256 + r] = wv[q]; else tokl[j * 256 + r] = (unsigned short)(av[q] >> 1); }
    }
    __syncthreads();
}

constexpr int N_PHASES = 16;
template <unsigned PHM>
__global__ void __launch_bounds__(NTHR, 2) fwd(Args args) {
    extern __shared__ __attribute__((aligned(16))) unsigned char lds_raw[];
    Frame F;
    F.lds = (LAS unsigned char*)lds_raw;
    F.tid = threadIdx.x; F.lane = F.tid & 63; F.wave = __builtin_amdgcn_readfirstlane(F.tid >> 6);
    F.G = gridDim.x; { const int bx = blockIdx.x; F.vcu = (F.G % 8 == 0) ? (bx % 8) * (F.G / 8) + bx / 8 : bx; }
    F.x = (const float*)args.in[0]; F.c = (const float*)args.in[1]; F.positions = (const int*)args.in[2]; F.w_ada = (const float*)args.in[3]; F.b_ada = (const float*)args.in[4];
    F.norm_mix = (const float*)args.in[5]; F.w_in = (const float*)args.in[6]; F.w_ret_o = (const float*)args.in[7]; F.w_diff_o = (const float*)args.in[8];
    F.lq1 = (const float*)args.in[9]; F.lk1 = (const float*)args.in[10]; F.lq2 = (const float*)args.in[11]; F.lk2 = (const float*)args.in[12]; F.diff_norm = (const float*)args.in[13];
    F.w_out = (const float*)args.in[14]; F.norm_ffn = (const float*)args.in[15]; F.w_rg = (const float*)args.in[16]; F.b_rg = (const float*)args.in[17]; F.w_re = (const float*)args.in[18]; F.b_re = (const float*)args.in[19];
    F.w_eg = (const float*)args.in[20]; F.w_eu = (const float*)args.in[21]; F.w_ed = (const float*)args.in[22]; F.norm_final = (const float*)args.in[23];
    F.out = args.out; F.ws = args.ws;
    for (int u = F.tid; u < (LDS_BYTES - LDSCTL_OFF) / 4; u += NTHR) ((LAS unsigned*)(F.lds + LDSCTL_OFF))[u] = 0u;
    __syncthreads();
    const int lo = args.ph_lo, hi = args.ph_hi;
    const bool use_bar = (hi - lo) > 1;
    XcdBarrier bar; bar.bar = (unsigned*)(F.ws + WS_CTL) + CW_BAR; bar.x = 0; bar.st = (volatile LAS unsigned*)(F.lds + LDSCTL_OFF);
    if (use_bar) bar = xcd_barrier_post((unsigned*)(F.ws + WS_CTL) + CW_BAR, (volatile LAS unsigned*)(F.lds + LDSCTL_OFF));
    bar.wave = F.wave;
#ifndef PROBE_DUP
#define PROBE_DUP 0u
#endif
#ifndef PROBE_MODE
#define PROBE_MODE 0
#endif
#define NREP(ty) ((((PROBE_DUP) >> (ty)) & 1u) ? 2 : 1)
#define INP(ty, k) ((((PHM) >> (ty)) & 1u) && lo <= (k) && (k) < hi)
#define INPL(ty, k) ((((PHM) >> (ty)) & 1u) && launder_s(lo) <= (k) && (k) < launder_s(hi))
#define IN(k) (lo <= (k) && (k) < hi)
#define SEAM(k) do { if (IN(k) && IN((k) + 1)) xcd_barrier(bar); } while (0)
    LAS int* rbs = (LAS int*)(F.lds + LDSCTL_OFF + 1024);

    if (INP(0, 0)) { for (int rep = 0; rep < NREP(0); ++rep) p0_prologue(F); SEAM(0); }
    for (int hf = 0; hf < 2; ++hf) {
        const int pb = 1 + 5 * hf;
        if (INP(1, pb) && hf == 0) { for (int rep = 0; rep < NREP(1); ++rep) p1_norm_mod(F); SEAM(pb); }
        if (INP(2, pb + 1)) {
            pg8::StaticOrder S; S.init(hf ? (const void*)(F.out + (size_t)TH * D) : (const void*)(F.ws + WS_H), F.ws + WS_WIN, TH, DIN, D, F.G, (int)blockIdx.x);
            pg8::EpiProj E{(bf16_t*)(F.ws + WS_PROJ), (const float*)(F.ws + WS_COS) + (size_t)hf * TH * 64, (const float*)(F.ws + WS_SIN) + (size_t)hf * TH * 64, 0};
            for (int rep = 0; rep < NREP(2); ++rep) { E.pmode = (rep + 1 < NREP(2)) ? PROBE_MODE : 0; pg8::gemm_phase<pg8::EpiProj, pg8::StaticOrder, true, false>(F.lds, F.wave, D, S, E); }
            SEAM(pb + 1);
        }
        if (INP(3, pb + 2)) { for (int rep = 0; rep < NREP(3); ++rep) p3_mix(F, hf + 2 * rep); SEAM(pb + 2); }
        if (INP(4, pb + 3)) {
            pg8::StaticOrder S; S.init(F.ws + WS_ACT, F.ws + WS_WMIX, TH, D, 2048, F.G, (int)blockIdx.x);
            LAS float* rst = (LAS float*)(F.lds + LDSCTL_OFF + 8192);
            for (int ui = 0; ; ++ui) {
                pg8::Unit u0; if (!S.next(ui, u0)) break;
                const int tl = tid_now(F.wave);
                { const float* sq = (const float*)(F.ws + WS_SSQ);
                  if (tl < 256) { float r[4];
#pragma unroll
                    for (int hd = 0; hd < 4; ++hd) { const f32x4* p = (const f32x4*)(sq + ((size_t)(u0.pm * 256 + tl) * 4 + hd) * 8); const f32x4 a = p[0], b = p[1];
                        r[hd] = 1.0f / sqrtf((((a.x + a.y) + (a.z + a.w)) + ((b.x + b.y) + (b.z + b.w))) * (1.0f / 256.0f) + EPS); }
                    rst[tl] = r[0] / r[1]; rst[256 + tl] = r[1] / r[2]; rst[512 + tl] = r[2] / r[3]; rst[768 + tl] = r[3]; } }
                __syncthreads();
                pg8::EpiMerged E{(const bf16_t*)(F.ws + WS_PROJ), (bf16_t*)(F.ws + WS_H), (const LAS float*)rst};
                pg8::OneUnit<pg8::StaticOrder> S1{S, ui};
                for (int rep = 0; rep < NREP(4); ++rep) pg8::gemm_phase<pg8::EpiMerged, pg8::OneUnit<pg8::StaticOrder>, false, false>(F.lds, F.wave, 2048, S1, E);
                __syncthreads();
            }
            SEAM(pb + 3);
        }
        if (INP(5, pb + 4)) {
            pg8::StaticOrder S; S.init(F.ws + WS_H, F.ws + WS_WOUT, TH, D, D, F.G, (int)blockIdx.x);
            pg8::EpiWout E{F.ws, (const float*)(F.ws + WS_MOD), hf * TH};
            for (int rep = 0; rep < NREP(5); ++rep) pg8::gemm_phase<pg8::EpiWout, pg8::StaticOrder, false, false>(F.lds, F.wave, D, S, E);
            if (hf == 1) SEAM(pb + 4);
        }
    }
    if (INPL(6, 11)) { for (int rep = 0; rep < NREP(6); ++rep) p6_router(F, rep + 1 < NREP(6)); SEAM(11); }
    if (INPL(10, 12)) { convert_experts(F); p6b_lists(F); SEAM(12); }
    if (INPL(7, 13)) {
        moe_table(F, rbs);
        const int nunits = __builtin_amdgcn_readfirstlane(rbs[32]) * 4;
        moe_unit_tables(F, rbs, nunits, false);
        pg8::MoeOrder S{F.G, F.vcu, 512, nunits, 1, rbs, (const LAS unsigned short*)(F.lds + LDSCTL_OFF + 4096), (const char*)(F.ws + WS_H2), (const char*)(F.ws + WS_WGU), (size_t)1024 * 1024};
        pg8::EpiGU E{F.ws + WS_EACT};
        for (int rep = 0; rep < NREP(7); ++rep) pg8::gemm_phase<pg8::EpiGU, pg8::MoeOrder, true, true, true>(F.lds, F.wave, launder_s(512), S, E);
        SEAM(13);
    }
    if (INPL(8, 14)) {
        moe_table(F, rbs);
        const int nunits = __builtin_amdgcn_readfirstlane(rbs[32]) * 4;
        moe_unit_tables(F, rbs, nunits, true);
        pg8::MoeOrder S{F.G, F.vcu, 256, nunits, 0, rbs, (const LAS unsigned short*)(F.lds + LDSCTL_OFF + 4096), (const char*)(F.ws + WS_EACT), (const char*)(F.ws + WS_WDN), (size_t)1024 * 512};
        pg8::EpiDown E{F.ws + WS_Y, (const LAS float*)(F.lds + LDSCTL_OFF + 8192)};
        for (int rep = 0; rep < NREP(8); ++rep) pg8::gemm_phase<pg8::EpiDown, pg8::MoeOrder, true, false, true>(F.lds, F.wave, launder_s(256), S, E);
        SEAM(14);
    }
    if (INPL(9, 15)) { moe_table(F, rbs); for (int rep = 0; rep < NREP(9); ++rep) p9_final(F, rbs, rep + 1 < NREP(9)); }
#undef IN
#undef INP
#undef INPL
#undef SEAM
}

#ifndef MK_ONE_LAUNCH
#define MK_ONE_LAUNCH 1
#endif
#if !MK_ONE_LAUNCH
typedef void (*KernFn)(Args);
static KernFn phase_kernel(int p) {
    const int ty = (p == 0) ? 0 : (p <= 10) ? 1 + (p - 1) % 5 : (p == 11) ? 6 : (p == 12) ? 10 : p - 6;
    switch (ty) {
        case 0: return fwd<1u << 0>; case 1: return fwd<1u << 1>; case 2: return fwd<1u << 2>; case 3: return fwd<1u << 3>; case 4: return fwd<1u << 4>;
        case 5: return fwd<1u << 5>; case 6: return fwd<1u << 6>; case 7: return fwd<1u << 7>; case 8: return fwd<1u << 8>; case 9: return fwd<1u << 9>; default: return fwd<1u << 10>;
    }
}
#endif
extern "C" void kernel_launch(void* const* d_in, const int* in_sizes, int n_in, void* d_out, int out_size, void* d_ws, size_t ws_size, hipStream_t stream) {
    static int grid = 0;
    if (grid == 0) {
        if (n_in != 24 || out_size != T * D || ws_size < WS_END) { fprintf(stderr, "kernel_launch: unexpected problem (n_in %d, out %d, ws %zu < %zu); nothing launched\n", n_in, out_size, ws_size, (size_t)WS_END); grid = -1; return; }
        int dev = 0, cus = 0;
        if (hipGetDevice(&dev) != hipSuccess || hipDeviceGetAttribute(&cus, hipDeviceAttributeMultiprocessorCount, dev) != hipSuccess) { grid = -1; return; }
#if MK_ONE_LAUNCH
        if (hipFuncSetAttribute((const void*)fwd<0x7FFu>, hipFuncAttributeMaxDynamicSharedMemorySize, LDS_BYTES) != hipSuccess) { grid = -1; return; }
#else
        for (int p = 0; p < N_PHASES; ++p)
            if (hipFuncSetAttribute((const void*)phase_kernel(p), hipFuncAttributeMaxDynamicSharedMemorySize, LDS_BYTES) != hipSuccess) { fprintf(stderr, "kernel_launch: hipFuncSetAttribute failed\n"); grid = -1; return; }
#endif
        (void)hipGetLastError();
        grid = cus;
    }
    if (grid < 0) return;
    (void)hipMemsetAsync((char*)d_ws + WS_CTL, 0, CTL_ZERO_BYTES, stream);
    Args a{};
    for (int i = 0; i < 24; ++i) a.in[i] = d_in[i];
    a.out = (float*)d_out; a.ws = (unsigned char*)d_ws;
#if MK_ONE_LAUNCH
    a.ph_lo = 0; a.ph_hi = N_PHASES;
    hipLaunchKernelGGL(fwd<0x7FFu>, dim3(grid), dim3(NTHR), LDS_BYTES, stream, a);
#else
    for (int p = 0; p < N_PHASES; ++p) { a.ph_lo = p; a.ph_hi = p + 1; hipLaunchKernelGGL(phase_kernel(p), dim3(grid), dim3(NTHR), LDS_BYTES, stream, a); }
#endif
}
```

```cpp
#include <hip/hip_runtime.h>
#include <cstdio>
#include <cstdint>

#define GAS __attribute__((address_space(1)))
#define LAS __attribute__((address_space(3)))
typedef unsigned short bf16_t;
typedef short bf16x8 __attribute__((ext_vector_type(8)));
typedef short s16x4 __attribute__((ext_vector_type(4)));
typedef float f32x4 __attribute__((ext_vector_type(4)));
typedef float f32x2 __attribute__((ext_vector_type(2)));
typedef float f32x16 __attribute__((ext_vector_type(16)));
typedef unsigned u32x4 __attribute__((ext_vector_type(4)));
typedef unsigned u32x2 __attribute__((ext_vector_type(2)));

constexpr int T = 32768, D = 1024, SEQ = 4096, NB = 8, DIN = 8192, TH = 16384, NWAVES = 8, NTHR = 512;
constexpr int NEXP = 32, DEXP = 512;
constexpr float EPS = 1e-6f;
constexpr int PROW_MAX = 65536 + NEXP * 256;

constexpr size_t MiB = 1u << 20;
constexpr size_t WS_CTL = 0, CTL_ZERO_BYTES = 64 * 1024;
constexpr size_t WS_MOD = 1 * MiB;
constexpr size_t WS_COS = 2 * MiB, WS_SIN = 10 * MiB;
constexpr size_t WS_WIN = 18 * MiB;
constexpr size_t WS_WMIX = 34 * MiB;
constexpr size_t WS_WOUT = 38 * MiB;
constexpr size_t WS_WGU = 40 * MiB;
constexpr size_t WS_WDN = 104 * MiB;
constexpr size_t WS_H = 136 * MiB;
constexpr size_t WS_ACT = 168 * MiB;
constexpr size_t WS_PROJ = 232 * MiB;
constexpr size_t WS_H2 = 168 * MiB;
constexpr size_t WS_EACT = 232 * MiB;
constexpr size_t WS_Y = 304 * MiB;
constexpr size_t WS_ROUT = 488 * MiB;
constexpr size_t WS_SSQ = 494 * MiB;
constexpr size_t WS_DELTA_A = 72 * MiB, WS_DELTA_B = 120 * MiB, WS_DELTA_C = 496 * MiB;
constexpr size_t WS_END = 512 * MiB;
constexpr int CW_BAR = 0;
constexpr int CW_CNT = 4096;
constexpr int CW_Q = 4224;

constexpr int RING_BYTES = 131072;
constexpr int LDSCTL_OFF = RING_BYTES;
constexpr int LDS_BYTES = 147456;

__device__ __forceinline__ unsigned cvt_pk_bf16(float lo, float hi) { unsigned r; asm("v_cvt_pk_bf16_f32 %0, %1, %2" : "=v"(r) : "v"(lo), "v"(hi)); return r; }
__device__ __forceinline__ unsigned pk4_fp8(float a, float b, float c, float d) {
    a = __builtin_amdgcn_fmed3f(a, -448.f, 448.f); b = __builtin_amdgcn_fmed3f(b, -448.f, 448.f); c = __builtin_amdgcn_fmed3f(c, -448.f, 448.f); d = __builtin_amdgcn_fmed3f(d, -448.f, 448.f);
    int w = __builtin_amdgcn_cvt_pk_fp8_f32(a, b, 0, false); w = __builtin_amdgcn_cvt_pk_fp8_f32(c, d, w, true); return (unsigned)w;
}
__device__ __forceinline__ float bf_lo(unsigned w) { return __uint_as_float(w << 16); }
__device__ __forceinline__ float bf_hi(unsigned w) { return __uint_as_float(w & 0xffff0000u); }
__device__ __forceinline__ float xor32_sum(float v) { const unsigned u = __builtin_bit_cast(unsigned, v); const auto r = __builtin_amdgcn_permlane32_swap(u, u, false, false);
    return __builtin_bit_cast(float, (unsigned)r[0]) + __builtin_bit_cast(float, (unsigned)r[1]); }
__device__ __forceinline__ float xor32_max(float v) { const unsigned u = __builtin_bit_cast(unsigned, v); const auto r = __builtin_amdgcn_permlane32_swap(u, u, false, false);
    return fmaxf(__builtin_bit_cast(float, (unsigned)r[0]), __builtin_bit_cast(float, (unsigned)r[1])); }
template <int O> __device__ __forceinline__ float swz_xor(float v) { return __builtin_bit_cast(float, __builtin_amdgcn_ds_swizzle(__builtin_bit_cast(int, v), 0x1F | (O << 10))); }
__device__ __forceinline__ float wave_sum(float v) { v += swz_xor<1>(v); v += swz_xor<2>(v); v += swz_xor<4>(v); v += swz_xor<8>(v); v += swz_xor<16>(v); return xor32_sum(v); }
__device__ __forceinline__ size_t delta_off(int t) { return (t < 16384) ? WS_DELTA_A + (size_t)t * 2048 : (t < 24576) ? WS_DELTA_B + (size_t)(t - 16384) * 2048 : WS_DELTA_C + (size_t)(t - 24576) * 2048; }
__device__ __forceinline__ float fast_sigmoid(float v) { return __builtin_amdgcn_rcpf(1.0f + __builtin_amdgcn_exp2f(-1.4426950408889634f * v)); }
__device__ __forceinline__ int launder_i(int v) { asm volatile("" : "+v"(v)); return v; }
__device__ __forceinline__ int launder_s(int v) { asm volatile("" : "+s"(v)); return v; }
__device__ __forceinline__ int lane_now() { int l; asm volatile("v_mbcnt_lo_u32_b32 %0, -1, 0\n\tv_mbcnt_hi_u32_b32 %0, -1, %0" : "=v"(l)); return l; }
__device__ __forceinline__ int tid_now(int wave) { return wave * 64 + lane_now(); }
#define LDS_WAIT() asm volatile("s_waitcnt lgkmcnt(0)" ::: "memory")
#define VM_WAIT() asm volatile("s_waitcnt vmcnt(0)" ::: "memory")

#define XB_TMO      128
#define XB_XCNT(j)  (256  + 64 * (j))
#define XB_XSUB(j)  (1280 + 64 * (j))
#define XB_XGEN(j)  (2304 + 64 * (j))
#define XB_TOP      3328
#define XB_TOPGEN   3392
#define XCD_BAR_WORDS 3456
#define XB_SPIN_CAP (1u << 18)
__device__ __forceinline__ unsigned xb_ld(unsigned* p)              { return __hip_atomic_load(p, __ATOMIC_RELAXED, __HIP_MEMORY_SCOPE_AGENT); }
__device__ __forceinline__ unsigned xb_add(unsigned* p, unsigned v) { return __hip_atomic_fetch_add(p, v, __ATOMIC_RELAXED, __HIP_MEMORY_SCOPE_AGENT); }
__device__ __forceinline__ unsigned xb_xcc_id() { return (unsigned)__builtin_amdgcn_s_getreg((3 << 11) | 20) & 0xFu; }
#define XB_SPIN(cond, bar) do { unsigned _sp = 0; while (cond) { __builtin_amdgcn_s_sleep(1); \
    if ((++_sp & 255u) == 0u) { if (xb_ld(&(bar)[XB_TMO])) break; if (_sp > XB_SPIN_CAP) { atomicAdd(&(bar)[XB_TMO], 1u); break; } } } } while (0)
struct XcdBarrier { unsigned* bar; unsigned x; volatile LAS unsigned* st; int wave; };
__device__ __forceinline__ XcdBarrier xcd_barrier_post(unsigned* bar, volatile LAS unsigned* st) {
    XcdBarrier b; b.bar = bar; b.x = xb_xcc_id(); b.st = st; b.wave = 0;
    if (threadIdx.x == 0) (void)xb_add(&bar[XB_XCNT(b.x)], 1u);
    return b;
}
__device__ __forceinline__ void xcd_barrier_complete(unsigned* bar, unsigned x, unsigned& nloc, unsigned& nx) {
    const unsigned G = gridDim.x * gridDim.y * gridDim.z;
    unsigned sum, cnt, mine, sp = 0u;
    for (;;) {
        sum = 0u; cnt = 0u; mine = 0u;
#pragma unroll
        for (unsigned j = 0; j < 16; ++j) { const unsigned c = xb_ld(&bar[XB_XCNT(j)]); sum += c; cnt += (c > 0u) ? 1u : 0u; mine = (j == x) ? c : mine; }
        if (sum == G) break;
        __builtin_amdgcn_s_sleep(1);
        if ((++sp & 255u) == 0u) { if (xb_ld(&bar[XB_TMO])) break; if (sp > XB_SPIN_CAP) { atomicAdd(&bar[XB_TMO], 1u); break; } }
    }
    nloc = mine > 0u ? mine : 1u; nx = cnt > 0u ? cnt : 1u;
}
__device__ __forceinline__ void xcd_barrier(const XcdBarrier& b) {
    asm volatile("s_waitcnt vmcnt(0)" ::: "memory");
    __syncthreads();
    if (b.wave == 0 && lane_now() == 0) {
        unsigned* bar = b.bar;
        __builtin_amdgcn_s_waitcnt(0);
        unsigned nloc = b.st[0], nx = b.st[1];
        if (nloc == 0u) { xcd_barrier_complete(bar, b.x, nloc, nx); b.st[0] = nloc; b.st[1] = nx; }
        const unsigned old = xb_add(&bar[XB_XSUB(b.x)], 1u);
        const unsigned gen = old / nloc;
        if (old + 1u == (gen + 1u) * nloc) {
            __builtin_amdgcn_fence(__ATOMIC_RELEASE, "agent");
            asm volatile("s_waitcnt vmcnt(0)" ::: "memory");
            const unsigned og = xb_add(&bar[XB_TOP], 1u);
            const unsigned tg = og / nx;
            if (og + 1u == (tg + 1u) * nx) xb_add(&bar[XB_TOPGEN], 1u);
            else XB_SPIN(xb_ld(&bar[XB_TOPGEN]) == tg, bar);
            __builtin_amdgcn_fence(__ATOMIC_ACQUIRE, "agent");
            xb_add(&bar[XB_XGEN(b.x)], 1u);
            asm volatile("s_waitcnt vmcnt(0)" ::: "memory");
        } else {
            XB_SPIN(xb_ld(&bar[XB_XGEN(b.x)]) == gen, bar);
            __builtin_amdgcn_fence(__ATOMIC_ACQUIRE, "agent");
            asm volatile("s_waitcnt vmcnt(0)" ::: "memory");
        }
    }
    __syncthreads();
}

namespace pg8 {
constexpr int BM = 256, BK = 64, HALF = 128, HTB = HALF * BK * 2, STAGE_BYTES = 8 * HTB, NXCD = 8, WGM = 8;
__host__ __device__ __forceinline__ int lds_byte(int r, int c) { const int st = (r >> 4) * 2 + (c >> 5), rr = r & 15, cc = c & 31, ob = rr * 64 + cc * 2; return st * 1024 + (ob ^ (((ob >> 9) & 1) << 5)); }
__host__ __device__ __forceinline__ void stage_rc(int b, int& R, int& C) { const int st = b / 1024, sb = b % 1024, swz = sb ^ (((sb >> 9) & 1) << 5); R = (st >> 1) * 16 + swz / 64; C = (st & 1) * 32 + (swz % 64) / 2; }
__host__ __device__ __forceinline__ int perm32(int rho) { const int n = rho >> 4, i = rho & 15; return 8 * (i >> 2) + 4 * n + (i & 3); }

struct Unit { int pm, pn, e, rb, idx; const char* A; const char* B; };

struct StaticOrder {
    int nM, nN, nwg, G, c, K; const char* A; const char* Bt;
    __device__ __forceinline__ void init(const void* A_, const void* Bt_, int M, int N, int K_, int G_, int c_) { A = (const char*)A_; Bt = (const char*)Bt_; K = K_; nM = M / BM; nN = N / BM; nwg = nM * nN; G = G_; c = c_; }
    __device__ __forceinline__ bool next(int i, Unit& u) const {
        const int L = i * G + c; if (L >= nwg) return false;
        int wgid = L; { const int q = nwg / NXCD, r = nwg % NXCD, xcd = wgid % NXCD, off = wgid / NXCD; wgid = (xcd < r ? xcd * (q + 1) : r * (q + 1) + (xcd - r) * q) + off; }
        const int nig = WGM * nN, gid = wgid / nig, fm = gid * WGM, gsz = (nM - fm) < WGM ? (nM - fm) : WGM;
        u.pm = fm + ((wgid % nig) % gsz); u.pn = (wgid % nig) / gsz; u.e = 0; u.rb = 0; u.idx = i;
        u.A = A + (size_t)u.pm * BM * K * 2; u.B = Bt + (size_t)u.pn * BM * K * 2; return true;
    }
    __device__ __forceinline__ int tok(const Unit&, int) const { return 0; }
};
template <class Sched> struct OneUnit {
    const Sched& S; int i;
    __device__ __forceinline__ bool next(int j, Unit& u) const { return j == 0 ? S.next(i, u) : false; }
    __device__ __forceinline__ int tok(const Unit& u, int r) const { return S.tok(u, r); }
};
struct MoeOrder {
    int G, vcu, K, nunits, gather; const LAS int* rbs; const LAS unsigned short* tokl; const char* A; const char* Bt; size_t bstride;
    __device__ __forceinline__ bool next(int i, Unit& u) const {
        const int L = i * G + vcu; if (L >= nunits) return false;
        const int rbi = L >> 2; const int e = __builtin_amdgcn_readfirstlane(rbs[128 + rbi]);
        u.pm = rbi; u.pn = L & 3; u.e = e; u.rb = rbi - __builtin_amdgcn_readfirstlane(rbs[e]); u.idx = i;
        u.A = gather ? A : A + (size_t)rbi * BM * K * 2; u.B = Bt + (size_t)e * bstride + (size_t)u.pn * BM * K * 2; return true;
    }
    __device__ __forceinline__ int tok(const Unit& u, int r) const { return (int)tokl[u.idx * 256 + r]; }
};

typedef f32x4 Acc[2][2][4][2];
typedef int v8i32 __attribute__((ext_vector_type(8)));
__device__ __forceinline__ v8i32 cat8(const bf16x8& a, const bf16x8& b) { const u32x4 x = __builtin_bit_cast(u32x4, a), y = __builtin_bit_cast(u32x4, b); return (v8i32){(int)x.x, (int)x.y, (int)x.z, (int)x.w, (int)y.x, (int)y.y, (int)y.z, (int)y.w}; }

template <class Epi, class Sched, bool ALIGN_EPI, bool GATHER, bool F8 = false>
__device__ __forceinline__ void gemm_phase(LAS unsigned char* lds, const int wid, const int K, const Sched& S, const Epi& E) {
    const int lane = lane_now(), tid = wid * 64 + lane, wr = wid >> 2, wc = wid & 3, fr = lane & 15, fq = lane >> 4;
    const int nt = K / BK;
    unsigned voffA[2], voffB[2];
#pragma unroll
    for (int i = 0; i < 2; ++i) { int R, C; stage_rc(tid * 16 + i * 8192, R, C); const int Rb = (R & ~31) + perm32(R & 31);
        voffA[i] = GATHER ? (unsigned)(C * 2) : (unsigned)(R * K + C) * 2u; voffB[i] = (unsigned)(Rb * K + C) * 2u; }
    unsigned gAc[2] = {0u, 0u};
    const unsigned K2 = (unsigned)(K * 2);
    const size_t kstep = (size_t)(BK * 2);
    const size_t hstep = (size_t)HALF * K * 2;
    const unsigned ldsw = (unsigned)wid * 1024u;
    const int aoff = lds_byte(wr * 64 + fr, fq * 8), boff = lds_byte(wc * 32 + fr, fq * 8);
    const LAS unsigned char* ldsB = lds + 4 * HTB + boff; asm volatile("" : "+v"(ldsB));
#define PG8_SA(b, h) (((b) * 2 + (h)) * HTB)
#define PG8_SB(b, h) ((4 + (b) * 2 + (h)) * HTB)
#define PG8_STAGEB(bufoff, gbase) do { _Pragma("unroll") for (int _i = 0; _i < 2; ++_i) { asm volatile("" : "+v"(voffB[_i])); \
        __builtin_amdgcn_global_load_lds((const unsigned*)((const char*)(gbase) + voffB[_i]), (LAS unsigned*)(lds + (bufoff) + ldsw + _i * 8192), 16, 0, 0); } } while (0)
#define PG8_STAGEA(bufoff, gbase, h, nx) do { _Pragma("unroll") for (int _i = 0; _i < 2; ++_i) { \
        unsigned _o; if constexpr (GATHER) { unsigned _pk = gAc[h]; asm volatile("" : "+v"(_pk)); _o = __umul24((_pk >> (16 * _i)) & 0xffffu, K2) + voffA[0]; } else { asm volatile("" : "+v"(voffA[_i])); _o = voffA[_i]; } \
        const char* _p = GATHER ? (const char*)(gbase) + _o : (const char*)(gbase) + (h) * hstep + _o; \
        __builtin_amdgcn_global_load_lds((const unsigned*)_p, (LAS unsigned*)(lds + (bufoff) + ldsw + _i * 8192), 16, 0, 0); } } while (0)
#define PG8_LDA(dst, b, h) do { _Pragma("unroll") for (int m = 0; m < 4; ++m) { \
        if constexpr (F8) { const u32x4 x_ = *(const LAS u32x4*)(lds + PG8_SA(b, h) + aoff + m * 2048), y_ = *(const LAS u32x4*)(lds + PG8_SA(b, h) + aoff + m * 2048 + 1024); \
            dst##8[m] = (v8i32){(int)x_.x, (int)x_.y, (int)x_.z, (int)x_.w, (int)y_.x, (int)y_.y, (int)y_.z, (int)y_.w}; } \
        else { _Pragma("unroll") for (int k = 0; k < 2; ++k) dst[m][k] = *(const LAS bf16x8*)(lds + PG8_SA(b, h) + aoff + m * 2048 + k * 1024); } } } while (0)
#define PG8_LDB(dst, b, h) do { _Pragma("unroll") for (int n = 0; n < 2; ++n) { \
        if constexpr (F8) { const u32x4 x_ = *(const LAS u32x4*)(ldsB + (PG8_SB(b, h) - 4 * HTB) + n * 2048), y_ = *(const LAS u32x4*)(ldsB + (PG8_SB(b, h) - 4 * HTB) + n * 2048 + 1024); \
            dst##8[n] = (v8i32){(int)x_.x, (int)x_.y, (int)x_.z, (int)x_.w, (int)y_.x, (int)y_.y, (int)y_.z, (int)y_.w}; } \
        else { _Pragma("unroll") for (int k = 0; k < 2; ++k) dst[n][k] = *(const LAS bf16x8*)(ldsB + (PG8_SB(b, h) - 4 * HTB) + n * 2048 + k * 1024); } } } while (0)
#define PG8_MMA(ai, bj, At, Bt) do { __builtin_amdgcn_s_setprio(1); \
        if constexpr (F8) { _Pragma("unroll") for (int m = 0; m < 4; ++m) _Pragma("unroll") for (int n = 0; n < 2; ++n) \
            acc[ai][bj][m][n] = __builtin_amdgcn_mfma_scale_f32_16x16x128_f8f6f4(Bt##8[n], At##8[m], acc[ai][bj][m][n], 0, 0, 0, 0x7F7F7F7F, 0, 0x7F7F7F7F); } \
        else { _Pragma("unroll") for (int m = 0; m < 4; ++m) _Pragma("unroll") for (int n = 0; n < 2; ++n) _Pragma("unroll") for (int k = 0; k < 2; ++k) \
            acc[ai][bj][m][n] = __builtin_amdgcn_mfma_f32_16x16x32_bf16(Bt[n][k], At[m][k], acc[ai][bj][m][n], 0, 0, 0); } __builtin_amdgcn_s_setprio(0); } while (0)
#define PG8_WAIT_V(n) asm volatile("s_waitcnt vmcnt(" #n ")" ::: "memory")
#define PG8_WAIT_L(n) asm volatile("s_waitcnt lgkmcnt(" #n ")" ::: "memory")
#define PG8_BAR __builtin_amdgcn_s_barrier()
#define PG8_SCHED __builtin_amdgcn_sched_barrier(0)
    Unit cur, nxt; int ui = 0;
    if (!S.next(0, cur)) return;
    if constexpr (GATHER) {
        int R0, C0; stage_rc(tid * 16, R0, C0);
#pragma unroll
        for (int h = 0; h < 2; ++h) gAc[h] = (unsigned)S.tok(cur, h * HALF + R0) | ((unsigned)S.tok(cur, h * HALF + R0 + 64) << 16);
    }
    Acc acc;
#pragma unroll
    for (int a = 0; a < 2; ++a)
#pragma unroll
        for (int b = 0; b < 2; ++b)
#pragma unroll
            for (int m = 0; m < 4; ++m)
#pragma unroll
                for (int n = 0; n < 2; ++n) acc[a][b][m][n] = (f32x4){0.f, 0.f, 0.f, 0.f};
    bf16x8 At[4][2], B0[2][2], B1[2][2]; v8i32 At8[4], B08[2], B18[2];
    const char* cA = cur.A; const char* cB = cur.B;
    PG8_STAGEB(PG8_SB(0, 0), cB); PG8_STAGEB(PG8_SB(0, 1), cB + hstep); PG8_STAGEA(PG8_SA(0, 0), cA, 0, false); PG8_STAGEA(PG8_SA(0, 1), cA, 1, false);
    if (wr == 1) PG8_BAR;
    PG8_WAIT_V(2); PG8_BAR;
    PG8_STAGEB(PG8_SB(1, 0), cB + kstep); PG8_STAGEA(PG8_SA(1, 0), cA + kstep, 0, false); PG8_STAGEB(PG8_SB(1, 1), cB + hstep + kstep);
    PG8_WAIT_V(6); PG8_BAR;
    for (;;) {
        const bool has_next = S.next(ui + 1, nxt);
        const char* nA = has_next ? nxt.A : cA; const char* nB = has_next ? nxt.B : cB;
        for (int t = 0; t < nt; t += 2) {
            const bool last = (t == nt - 2);
            if constexpr (Epi::MID) { if (E.mid_at(t)) { const int l_ = lane_now(); E.mid(acc, cur, t, wr, wc, l_ & 15, l_ >> 4); } }
            const char* a1 = cA + (size_t)(t + 1) * kstep;
            const char* a2 = last ? nA : cA + (size_t)(t + 2) * kstep; const char* b2 = last ? nB : cB + (size_t)(t + 2) * kstep;
            const char* a3 = a2 + kstep; const char* b3 = b2 + kstep;
            PG8_LDB(B0, 0, 0); PG8_LDB(B1, 0, 1); PG8_SCHED; PG8_LDA(At, 0, 0); PG8_STAGEA(PG8_SA(1, 1), a1, 1, false);
            if constexpr (GATHER) { if (last && has_next) {
                int R0, C0; stage_rc((wid * 64 + lane_now()) * 16, R0, C0);
#pragma unroll
                for (int h = 0; h < 2; ++h) gAc[h] = (unsigned)S.tok(nxt, h * HALF + R0) | ((unsigned)S.tok(nxt, h * HALF + R0 + 64) << 16); } }
            PG8_WAIT_V(8); PG8_WAIT_L(0); PG8_BAR; PG8_MMA(0, 0, At, B0); PG8_MMA(0, 1, At, B1); PG8_BAR; PG8_SCHED;
            PG8_LDA(At, 0, 1); PG8_STAGEB(PG8_SB(0, 0), b2); PG8_STAGEB(PG8_SB(0, 1), b2 + hstep); PG8_STAGEA(PG8_SA(0, 0), a2, 0, last);
            PG8_WAIT_V(8); PG8_WAIT_L(0); PG8_BAR; PG8_MMA(1, 0, At, B0); PG8_MMA(1, 1, At, B1); PG8_BAR; PG8_SCHED;
            PG8_LDB(B0, 1, 0); PG8_LDB(B1, 1, 1); PG8_SCHED; PG8_LDA(At, 1, 0); PG8_STAGEA(PG8_SA(0, 1), a2, 1, last);
            PG8_WAIT_V(8); PG8_WAIT_L(0); PG8_BAR; PG8_MMA(0, 0, At, B0); PG8_MMA(0, 1, At, B1); PG8_BAR; PG8_SCHED;
            PG8_LDA(At, 1, 1); PG8_STAGEB(PG8_SB(1, 0), b3); PG8_STAGEB(PG8_SB(1, 1), b3 + hstep); PG8_STAGEA(PG8_SA(1, 0), a3, 0, last);
            PG8_WAIT_V(8); PG8_WAIT_L(0); PG8_BAR; PG8_MMA(1, 0, At, B0); PG8_MMA(1, 1, At, B1); PG8_BAR; PG8_SCHED;
        }
        if constexpr (ALIGN_EPI) { if (wr == 0) PG8_BAR; }
        { const int l_ = lane_now(); E(acc, cur, wr, wc, l_ & 15, l_ >> 4); }
        if (!has_next) break;
#pragma unroll
        for (int a = 0; a < 2; ++a)
#pragma unroll
            for (int b = 0; b < 2; ++b)
#pragma unroll
                for (int m = 0; m < 4; ++m)
#pragma unroll
                    for (int n = 0; n < 2; ++n) acc[a][b][m][n] = (f32x4){0.f, 0.f, 0.f, 0.f};
        cur = nxt; cA = nA; cB = nB; ++ui;
        if constexpr (ALIGN_EPI) { if (wr == 1) PG8_BAR; }
    }
    PG8_WAIT_V(0);
    if constexpr (!ALIGN_EPI) { if (wr == 0) PG8_BAR; }
    PG8_BAR;
#undef PG8_SA
#undef PG8_SB
#undef PG8_STAGEA
#undef PG8_STAGEB
#undef PG8_LDA
#undef PG8_LDB
#undef PG8_MMA
#undef PG8_WAIT_V
#undef PG8_WAIT_L
#undef PG8_BAR
#undef PG8_SCHED
}

__device__ __forceinline__ void store8(bf16_t* p, const f32x4& v0, const f32x4& v1) {
    u32x4 w; w.x = cvt_pk_bf16(v0[0], v0[1]); w.y = cvt_pk_bf16(v0[2], v0[3]); w.z = cvt_pk_bf16(v1[0], v1[1]); w.w = cvt_pk_bf16(v1[2], v1[3]);
    *(u32x4*)p = w;
}
struct EpiProj {
    static constexpr bool MID = false;
    bf16_t* O; const float* cosT; const float* sinT; int pmode;
    __device__ __forceinline__ bool mid_at(int) const { return false; }
    __device__ __forceinline__ void mid(Acc&, const Unit&, int, int, int, int, int) const {}
    __device__ __forceinline__ void operator()(Acc& acc, const Unit& u, int wr, int wc, int fr, int fq) const {
        if (pmode == 3) return;
        const int pn = u.pn; fr = launder_i(fr); fq = launder_i(fq);
        const int mode = (pn < 4) ? 1 : (pn < 8) ? 0 : (pn < 12) ? 2 : (pn < 20) ? 1 : (pn < 24) ? 0 : 3;
        const int row0 = u.pm * BM + wr * 64 + fr, col0 = pn * BM + wc * 32 + 8 * fq;
        if (mode == 1) {
            const int q4 = 4 * (4 * wc + fq);
            f32x4 cs[2][4], sn[2][4];
#pragma unroll
            for (int ai = 0; ai < 2; ++ai)
#pragma unroll
                for (int m = 0; m < 4; ++m) { const size_t ro = (size_t)(row0 + ai * HALF + m * 16) * 64 + q4; cs[ai][m] = *(const f32x4*)(cosT + ro); sn[ai][m] = *(const f32x4*)(sinT + ro); }
            asm volatile("" ::: "memory");
#pragma unroll
            for (int ai = 0; ai < 2; ++ai)
#pragma unroll
                for (int m = 0; m < 4; ++m) {
                    bf16_t* rowp = O + (size_t)(row0 + ai * HALF + m * 16) * DIN + col0;
                    const int ic = (wr * 64 + m * 16 + fr) & 127;
#pragma unroll
                    for (int bj = 0; bj < 2; ++bj) {
                        float f = 1.f;
                        if (pn < 4) { const int hd = (2 * pn + bj) & 3; const float lg = __builtin_amdgcn_logf(1.0f - __builtin_amdgcn_exp2f(-5.0f - (float)hd));
                            f = __builtin_amdgcn_exp2f(lg * (pn < 2 ? (float)(ic + 1) : (float)(127 - ic))); }
                        const f32x4 t1 = acc[ai][bj][m][0], t2 = acc[ai][bj][m][1];
                        const f32x4 o1 = (t1 * cs[ai][m] - t2 * sn[ai][m]) * f, o2 = (t2 * cs[ai][m] + t1 * sn[ai][m]) * f;
                        if (pmode != 1) store8(rowp + bj * HALF, o1, o2);
                    }
                }
        } else {
#pragma unroll
            for (int ai = 0; ai < 2; ++ai)
#pragma unroll
                for (int m = 0; m < 4; ++m) {
                    bf16_t* rowp = O + (size_t)(row0 + ai * HALF + m * 16) * DIN + col0;
#pragma unroll
                    for (int bj = 0; bj < 2; ++bj) {
                        f32x4 v0 = acc[ai][bj][m][0], v1 = acc[ai][bj][m][1];
                        if (mode == 2) {
#pragma unroll
                            for (int e = 0; e < 4; ++e) { v0[e] = v0[e] * fast_sigmoid(v0[e]); v1[e] = v1[e] * fast_sigmoid(v1[e]); }
                        } else if (mode == 3) {
#pragma unroll
                            for (int e = 0; e < 4; ++e) { v0[e] = fast_sigmoid(v0[e]); v1[e] = fast_sigmoid(v1[e]); }
                        }
                        if (pmode != 1) store8(rowp + bj * HALF, v0, v1);
                    }
                }
        }
        asm volatile("" ::: "memory");
    }
};
struct EpiMerged {
    static constexpr bool MID = true;
    const bf16_t* proj; bf16_t* O; const LAS float* rst;
    __device__ __forceinline__ bool mid_at(int t) const { return t == 4 || t == 8 || t == 12 || t == 16; }
    __device__ __forceinline__ void mid(Acc& acc, const Unit& u, int t, int wr, int wc, int fr, int fq) const {
        fr = launder_i(fr); fq = launder_i(fq);
        const LAS float* rq = (const LAS float*)rst + ((t >> 2) - 1) * 256 + wr * 64 + fr;
#pragma unroll
        for (int ai = 0; ai < 2; ++ai)
#pragma unroll
            for (int m = 0; m < 4; ++m) {
                const float f = rq[ai * HALF + m * 16];
#pragma unroll
                for (int bj = 0; bj < 2; ++bj) { acc[ai][bj][m][0] = acc[ai][bj][m][0] * f; acc[ai][bj][m][1] = acc[ai][bj][m][1] * f; }
            }
        if (t == 16) {
            const int row0 = u.pm * BM + wr * 64 + fr, col0 = u.pn * BM + wc * 32 + 8 * fq;
#pragma unroll
            for (int ai = 0; ai < 2; ++ai) {
                u32x4 g[4][2], d[4][2];
#pragma unroll
                for (int m = 0; m < 4; ++m) { const bf16_t* gp = proj + (size_t)(row0 + ai * HALF + m * 16) * DIN + 6144 + col0;
#pragma unroll
                    for (int bj = 0; bj < 2; ++bj) { g[m][bj] = *(const u32x4*)(gp + bj * HALF); d[m][bj] = *(const u32x4*)(gp + 1024 + bj * HALF); } }
                asm volatile("" ::: "memory");
#pragma unroll
                for (int m = 0; m < 4; ++m)
#pragma unroll
                    for (int bj = 0; bj < 2; ++bj) {
                        const u32x4 gg = g[m][bj], dd = d[m][bj];
                        f32x4 q0, q1;
                        q0[0] = bf_lo(gg.x) * __builtin_amdgcn_rcpf(bf_lo(dd.x)); q0[1] = bf_hi(gg.x) * __builtin_amdgcn_rcpf(bf_hi(dd.x));
                        q0[2] = bf_lo(gg.y) * __builtin_amdgcn_rcpf(bf_lo(dd.y)); q0[3] = bf_hi(gg.y) * __builtin_amdgcn_rcpf(bf_hi(dd.y));
                        q1[0] = bf_lo(gg.z) * __builtin_amdgcn_rcpf(bf_lo(dd.z)); q1[1] = bf_hi(gg.z) * __builtin_amdgcn_rcpf(bf_hi(dd.z));
                        q1[2] = bf_lo(gg.w) * __builtin_amdgcn_rcpf(bf_lo(dd.w)); q1[3] = bf_hi(gg.w) * __builtin_amdgcn_rcpf(bf_hi(dd.w));
                        acc[ai][bj][m][0] = acc[ai][bj][m][0] * q0; acc[ai][bj][m][1] = acc[ai][bj][m][1] * q1;
                    }
                asm volatile("" ::: "memory");
            }
        }
    }
    __device__ __forceinline__ void operator()(Acc& acc, const Unit& u, int wr, int wc, int fr, int fq) const {
        fr = launder_i(fr); fq = launder_i(fq);
        const int row0 = u.pm * BM + wr * 64 + fr, col0 = u.pn * BM + wc * 32 + 8 * fq;
        u32x4 d[2][4][2];
#pragma unroll
        for (int ai = 0; ai < 2; ++ai)
#pragma unroll
            for (int m = 0; m < 4; ++m) { const bf16_t* gp = proj + (size_t)(row0 + ai * HALF + m * 16) * DIN + 7168 + col0;
#pragma unroll
                for (int bj = 0; bj < 2; ++bj) d[ai][m][bj] = *(const u32x4*)(gp + bj * HALF); }
        asm volatile("" ::: "memory");
#pragma unroll
        for (int ai = 0; ai < 2; ++ai)
#pragma unroll
            for (int m = 0; m < 4; ++m) {
                const int row = row0 + ai * HALF + m * 16;
#pragma unroll
                for (int bj = 0; bj < 2; ++bj) {
                    const u32x4 dd = d[ai][m][bj];
                    f32x4 s0, s1; s0[0] = bf_lo(dd.x); s0[1] = bf_hi(dd.x); s0[2] = bf_lo(dd.y); s0[3] = bf_hi(dd.y); s1[0] = bf_lo(dd.z); s1[1] = bf_hi(dd.z); s1[2] = bf_lo(dd.w); s1[3] = bf_hi(dd.w);
                    store8(O + (size_t)row * D + col0 + bj * HALF, acc[ai][bj][m][0] * s0, acc[ai][bj][m][1] * s1);
                }
            }
        asm volatile("" ::: "memory");
    }
};
struct EpiWout {
    static constexpr bool MID = false;
    unsigned char* ws; const float* mod; int tbase;
    __device__ __forceinline__ bool mid_at(int) const { return false; }
    __device__ __forceinline__ void mid(Acc&, const Unit&, int, int, int, int, int) const {}
    __device__ __forceinline__ void operator()(Acc& acc, const Unit& u, int wr, int wc, int fr, int fq) const {
        fr = launder_i(fr); fq = launder_i(fq);
        const int row0 = tbase + u.pm * BM + wr * 64 + fr, col0 = u.pn * BM + wc * 32 + 8 * fq;
        const float* g1 = mod + (size_t)(row0 >> 12) * 6144 + 2048 + col0;
        f32x4 g[2][2];
#pragma unroll
        for (int bj = 0; bj < 2; ++bj) { g[bj][0] = *(const f32x4*)(g1 + bj * HALF); g[bj][1] = *(const f32x4*)(g1 + bj * HALF + 4); }
        bf16_t* base = (bf16_t*)(ws + delta_off(tbase + u.pm * BM)) + (size_t)(wr * 64 + fr) * D + col0;
#pragma unroll
        for (int ai = 0; ai < 2; ++ai)
#pragma unroll
            for (int m = 0; m < 4; ++m) {
                bf16_t* rowp = base + (size_t)(ai * HALF + m * 16) * D;
#pragma unroll
                for (int bj = 0; bj < 2; ++bj) store8(rowp + bj * HALF, g[bj][0] * acc[ai][bj][m][0], g[bj][1] * acc[ai][bj][m][1]);
            }
        asm volatile("" ::: "memory");
    }
};
struct EpiGU {
    static constexpr bool MID = false;
    unsigned char* act;
    __device__ __forceinline__ bool mid_at(int) const { return false; }
    __device__ __forceinline__ void mid(Acc&, const Unit&, int, int, int, int, int) const {}
    __device__ __forceinline__ void operator()(Acc& acc, const Unit& u, int wr, int wc, int fr, int fq) const {
        fr = launder_i(fr); fq = launder_i(fq);
        const int row0 = u.pm * BM + wr * 64 + fr, col0 = u.pn * 128 + wc * 16 + 4 * fq;
#pragma unroll
        for (int ai = 0; ai < 2; ++ai)
#pragma unroll
            for (int m = 0; m < 4; ++m) {
                unsigned char* rowp = act + (size_t)(row0 + ai * HALF + m * 16) * DEXP + col0;
#pragma unroll
                for (int bj = 0; bj < 2; ++bj) {
                    const f32x4 G = acc[ai][bj][m][0], U = acc[ai][bj][m][1]; f32x4 a;
#pragma unroll
                    for (int e = 0; e < 4; e += 2) {
                        const f32x2 g2 = {G[e], G[e + 1]}, u2 = {U[e], U[e + 1]};
                        const f32x2 t = g2 * (f32x2){-1.4426950408889634f * 0.03125f, -1.4426950408889634f * 0.03125f};
                        const f32x2 d = (f32x2){__builtin_amdgcn_exp2f(t.x), __builtin_amdgcn_exp2f(t.y)} + (f32x2){1.0f, 1.0f};
                        const f32x2 r = {__builtin_amdgcn_rcpf(d.x), __builtin_amdgcn_rcpf(d.y)};
                        const f32x2 o = ((g2 * u2) * r) * (f32x2){0.0009765625f, 0.0009765625f};
                        a[e] = o.x; a[e + 1] = o.y;
                    }
                    *(unsigned*)(rowp + bj * 64) = pk4_fp8(a[0], a[1], a[2], a[3]);
                }
            }
        asm volatile("" ::: "memory");
    }
};
struct EpiDown {
    static constexpr bool MID = false;
    unsigned char* y; const LAS float* wl;
    __device__ __forceinline__ bool mid_at(int) const { return false; }
    __device__ __forceinline__ void mid(Acc&, const Unit&, int, int, int, int, int) const {}
    __device__ __forceinline__ void operator()(Acc& acc, const Unit& u, int wr, int wc, int fr, int fq) const {
        fr = launder_i(fr); fq = launder_i(fq);
        const int r0 = wr * 64 + fr, col0 = u.pn * BM + wc * 32 + 8 * fq;
        const int colw = u.pn * BM + wc * 32 + 16 * (fq >> 1), odd = fq & 1;
#pragma unroll
        for (int ai = 0; ai < 2; ++ai)
#pragma unroll
            for (int mp = 0; mp < 2; ++mp) {
                unsigned char* rowp = y + (size_t)(u.pm * BM + r0 + ai * HALF + (2 * mp + odd) * 16) * D + colw;
                const float wA = wl[u.idx * 256 + r0 + ai * HALF + (2 * mp) * 16], wB = wl[u.idx * 256 + r0 + ai * HALF + (2 * mp + 1) * 16];
#pragma unroll
                for (int bj = 0; bj < 2; ++bj) {
                    u32x2 pa, pb;
                    { const int m = 2 * mp; const f32x4 v0 = acc[ai][bj][m][0] * wA, v1 = acc[ai][bj][m][1] * wA; pa.x = pk4_fp8(v0[0], v0[1], v0[2], v0[3]); pa.y = pk4_fp8(v1[0], v1[1], v1[2], v1[3]); }
                    { const int m = 2 * mp + 1; const f32x4 v0 = acc[ai][bj][m][0] * wB, v1 = acc[ai][bj][m][1] * wB; pb.x = pk4_fp8(v0[0], v0[1], v0[2], v0[3]); pb.y = pk4_fp8(v1[0], v1[1], v1[2], v1[3]); }
                    const auto sx = __builtin_amdgcn_permlane16_swap(pa.x, pb.x, false, false), sy = __builtin_amdgcn_permlane16_swap(pa.y, pb.y, false, false);
                    *(u32x4*)(rowp + bj * HALF) = (u32x4){(unsigned)sx[0], (unsigned)sy[0], (unsigned)sx[1], (unsigned)sy[1]};
                    asm volatile("" ::: "memory");
                }
            }
        asm volatile("" ::: "memory");
    }
};
}

__device__ __forceinline__ unsigned off_b(unsigned row, unsigned ch) { return 256u * row + 16u * (ch ^ (((row & 3u) << 2) | ((row >> 2) & 3u))); }
__device__ __forceinline__ int lds_addr(const LAS unsigned char* p) { return (int)(unsigned)(size_t)p; }
__device__ __forceinline__ int crow(int r, int hi) { return (r & 3) + 8 * (r >> 2) + 4 * hi; }
__device__ __forceinline__ s16x4 tr_read(const LAS unsigned char* p) { return __builtin_amdgcn_ds_read_tr16_b64_v4i16((LAS s16x4*)p); }
__device__ __forceinline__ bf16x8 tr_frag(const LAS unsigned char* tile, int r0, int r1, int c, int lane) {
    const int blk = (lane >> 4) & 1, q = (lane & 15) >> 2, p = lane & 3;
    const s16x4 a = tr_read(tile + off_b(r0 + q, 4 * c + 2 * blk + (p >> 1)) + 8 * (p & 1));
    const s16x4 b = tr_read(tile + off_b(r1 + q, 4 * c + 2 * blk + (p >> 1)) + 8 * (p & 1));
    return (bf16x8){a[0], a[1], a[2], a[3], b[0], b[1], b[2], b[3]};
}
__device__ __forceinline__ bf16x8 pack8(const f32x16& v, int base) {
    u32x4 w; w.x = cvt_pk_bf16(v[base + 0], v[base + 1]); w.y = cvt_pk_bf16(v[base + 2], v[base + 3]); w.z = cvt_pk_bf16(v[base + 4], v[base + 5]); w.w = cvt_pk_bf16(v[base + 6], v[base + 7]);
    return __builtin_bit_cast(bf16x8, w);
}
__device__ __forceinline__ int launder(int v) { asm volatile("" : "+v"(v)); return v; }
#define MFMA32(a, b, c) __builtin_amdgcn_mfma_f32_32x32x16_bf16(a, b, c, 0, 0, 0)

struct MixArgs { const bf16_t* proj; bf16_t* act; const float* diff_norm; float lam; float* ssq; };

template <int IMM> __device__ __forceinline__ void tr8_issue(s16x4 (&x)[8], const int (&ad)[8]) {
    asm volatile("ds_read_b64_tr_b16 %0, %8 offset:%16\n\tds_read_b64_tr_b16 %1, %9 offset:%16\n\tds_read_b64_tr_b16 %2, %10 offset:%16\n\tds_read_b64_tr_b16 %3, %11 offset:%16\n\t"
                 "ds_read_b64_tr_b16 %4, %12 offset:%16\n\tds_read_b64_tr_b16 %5, %13 offset:%16\n\tds_read_b64_tr_b16 %6, %14 offset:%16\n\tds_read_b64_tr_b16 %7, %15 offset:%16"
                 : "=&v"(x[0]), "=&v"(x[1]), "=&v"(x[2]), "=&v"(x[3]), "=&v"(x[4]), "=&v"(x[5]), "=&v"(x[6]), "=&v"(x[7])
                 : "v"(ad[0]), "v"(ad[1]), "v"(ad[2]), "v"(ad[3]), "v"(ad[4]), "v"(ad[5]), "v"(ad[6]), "v"(ad[7]), "n"(IMM) : "memory");
}
__device__ __forceinline__ void tr8_wait(s16x4 (&x)[8]) {
    asm volatile("s_waitcnt lgkmcnt(0)" : "+v"(x[0]), "+v"(x[1]), "+v"(x[2]), "+v"(x[3]), "+v"(x[4]), "+v"(x[5]), "+v"(x[6]), "+v"(x[7]) :: "memory");
}
template <int N> __device__ __forceinline__ void tr8_wait_n(s16x4 (&x)[8]) {
    asm volatile("s_waitcnt lgkmcnt(%8)" : "+v"(x[0]), "+v"(x[1]), "+v"(x[2]), "+v"(x[3]), "+v"(x[4]), "+v"(x[5]), "+v"(x[6]), "+v"(x[7]) : "n"(N) : "memory");
}
__device__ __forceinline__ void pv_mma(f32x16 (&O)[8], int ob, const s16x4 (&x)[8], const bf16x8& pf) {
    __builtin_amdgcn_s_setprio(2);
#pragma unroll
    for (int c = 0; c < 4; ++c) { const bf16x8 vf = {x[2 * c][0], x[2 * c][1], x[2 * c][2], x[2 * c][3], x[2 * c + 1][0], x[2 * c + 1][1], x[2 * c + 1][2], x[2 * c + 1][3]}; O[ob + c] = MFMA32(vf, pf, O[ob + c]); }
    __builtin_amdgcn_s_setprio(1);
}
template <int IMM> __device__ __forceinline__ void k4_issue(bf16x8 (&k)[4], int a0, int a1, int a2, int a3) {
    asm volatile("ds_read_b128 %0, %4 offset:%8\n\tds_read_b128 %1, %5 offset:%8\n\tds_read_b128 %2, %6 offset:%8\n\tds_read_b128 %3, %7 offset:%8"
                 : "=&v"(k[0]), "=&v"(k[1]), "=&v"(k[2]), "=&v"(k[3]) : "v"(a0), "v"(a1), "v"(a2), "v"(a3), "n"(IMM) : "memory");
}
__device__ __forceinline__ void tr4_issue(s16x4 (&x)[4], int a0, int a1, int a2, int a3) {
    asm volatile("ds_read_b64_tr_b16 %0, %4\n\tds_read_b64_tr_b16 %1, %5\n\tds_read_b64_tr_b16 %2, %6\n\tds_read_b64_tr_b16 %3, %7"
                 : "=&v"(x[0]), "=&v"(x[1]), "=&v"(x[2]), "=&v"(x[3]) : "v"(a0), "v"(a1), "v"(a2), "v"(a3) : "memory");
}
__device__ __forceinline__ void tr4_wait(s16x4 (&x)[4]) { asm volatile("s_waitcnt lgkmcnt(0)" : "+v"(x[0]), "+v"(x[1]), "+v"(x[2]), "+v"(x[3]) :: "memory"); }
__device__ __forceinline__ int tr_addr(const LAS unsigned char* tile, int r, int c, int lane) {
    const int blk = (lane >> 4) & 1, q = (lane & 15) >> 2, p = lane & 3;
    return lds_addr(tile) + (int)off_b(r + q, 4 * c + 2 * blk + (p >> 1)) + 8 * (p & 1);
}
__device__ __forceinline__ bf16x8 cat4(const s16x4& a, const s16x4& b) { return (bf16x8){a[0], a[1], a[2], a[3], b[0], b[1], b[2], b[3]}; }
template <int N> __device__ __forceinline__ void k4_wait(bf16x8 (&k)[4]) {
    asm volatile("s_waitcnt lgkmcnt(%4)" : "+v"(k[0]), "+v"(k[1]), "+v"(k[2]), "+v"(k[3]) : "n"(N) : "memory");
}
#define FENCE() __builtin_amdgcn_sched_barrier(0)
__device__ __forceinline__ bf16x8 lds_b128(int addr) { return *(const LAS bf16x8*)(size_t)(unsigned)addr; }
__device__ __forceinline__ s16x4 lds_tr(int addr) { return __builtin_amdgcn_ds_read_tr16_b64_v4i16((LAS s16x4*)(size_t)(unsigned)addr); }
template <int IMM> __device__ __forceinline__ s16x4 lds_tr_i(int addr) { return __builtin_amdgcn_ds_read_tr16_b64_v4i16((LAS s16x4*)((LAS unsigned char*)(size_t)(unsigned)addr + IMM)); }
__device__ __forceinline__ void dma16(const void* gptr, unsigned lds_base) {
    asm volatile("s_mov_b32 m0, %1\n\ts_nop 0\n\tglobal_load_lds_dwordx4 %0, off" :: "v"(gptr), "s"(lds_base) : "memory", "m0");
}
__device__ __forceinline__ void dma16s(unsigned long long sbase, unsigned voff, unsigned lds_base) {
    asm volatile("s_mov_b32 m0, %2\n\ts_nop 0\n\tglobal_load_lds_dwordx4 %0, %1" :: "v"(voff), "s"(sbase), "s"(lds_base) : "memory", "m0");
}
__device__ __forceinline__ unsigned attn_voff(int lane) { const int r4 = lane >> 4; return (unsigned)(r4 * DIN * 2 + (((lane & 15) ^ (r4 << 2)) * 16)); }
__device__ __forceinline__ void attn_issue(LAS unsigned char* buf, const bf16_t* proj, size_t trow0, int kcol0, int vcol0, int wid, unsigned voff0) {
    const int ti = wid >> 1;
    const int col = (ti < 2) ? kcol0 + ti * 128 : vcol0 + (ti - 2) * 128;
    const unsigned long long sb = (unsigned long long)(size_t)(proj + (trow0 + 32 * (wid & 1)) * DIN + col);
#pragma unroll
    for (int i = 0; i < 8; ++i)
        dma16s(sb + (unsigned long long)(4 * i) * DIN * 2, voff0 ^ (unsigned)(16 * (i & 3)), (unsigned)__builtin_amdgcn_readfirstlane(lds_addr(buf) + ti * 16384 + ((wid & 1) * 8 + i) * 1024));
}
__device__ __forceinline__ void attn_unit(LAS unsigned char* lds, const int wid, const MixArgs& A, int bl, int h, int qb, int pre, volatile LAS int* bcn) {
    const int lane0 = lane_now(), comp = wid >> 2, ri = wid & 3;
    const size_t tb = (size_t)bl * SEQ;
    const int kcol0 = 4096 + (2 * h) * 128, vcol0 = 5120 + h * 256;
    const int ntiles = 2 * (qb + 1);
    f32x16 O[8]; float mrun = -1e30f, lrun = 0.f;
    {
    const int lane = lane0, hh = lane >> 5, li = lane & 31;
    const unsigned voff0 = attn_voff(lane);
    attn_issue(lds, A.proj, tb, kcol0, vcol0, wid, voff0);
    const bf16_t* qrow = A.proj + (tb + qb * 128 + ri * 32 + li) * DIN + 3072 + (2 * h + comp) * 128;
    bf16x8 qf[8];
#pragma unroll
    for (int s = 0; s < 8; ++s) qf[s] = *(const bf16x8*)(qrow + 16 * s + 8 * hh);
    asm volatile("s_waitcnt vmcnt(0)" : "+v"(qf[0]), "+v"(qf[1]), "+v"(qf[2]), "+v"(qf[3]), "+v"(qf[4]), "+v"(qf[5]), "+v"(qf[6]), "+v"(qf[7]), "+v"(pre) :: "memory");
    if (wid == 0 && lane == 0) bcn[0] = pre;
#pragma unroll
    for (int i = 0; i < 8; ++i)
#pragma unroll
        for (int r = 0; r < 16; ++r) O[i][r] = 0.f;
    const int kadr = 256 * li + 16 * (hh ^ (((li & 3) << 2) | ((li >> 2) & 3)));
    const int blk = (lane >> 4) & 1, q = (lane & 15) >> 2, p = lane & 3, lo1 = (2 * blk + (p >> 1)) ^ hh;
    const int vb1 = 256 * (4 * hh + q) + 64 * q + 16 * lo1 + 8 * (p & 1), vb2 = 256 * (4 * hh + q + 8) + 64 * q + 16 * (lo1 ^ 2) + 8 * (p & 1);
    for (int kt = 0; kt < ntiles; ++kt) {
        asm volatile("s_waitcnt vmcnt(0)" ::: "memory");
        __builtin_amdgcn_s_barrier();
        asm volatile("" ::: "memory");
        if (kt + 1 < ntiles) attn_issue(lds + ((kt + 1) & 1) * 65536, A.proj, tb + (size_t)(kt + 1) * 64, kcol0, vcol0, wid, voff0);
        const int krel0 = (kt - 2 * qb) * 64;
        if (krel0 > ri * 32 + 31) continue;
        const LAS unsigned char* Kt = lds + (kt & 1) * 65536 + comp * 16384;
        const LAS unsigned char* Vt = lds + (kt & 1) * 65536 + 32768;
        f32x16 sc[2];
#pragma unroll
        for (int kb = 0; kb < 2; ++kb)
#pragma unroll
            for (int r = 0; r < 16; ++r) sc[kb][r] = 0.f;
        __builtin_amdgcn_s_setprio(1);
        {
            const int kbase = lds_addr(Kt);
            bf16x8 ka[2][4];
#pragma unroll
            for (int s = 0; s < 4; ++s) ka[0][s] = lds_b128(kbase + (kadr ^ (32 * s)));
#pragma unroll
            for (int grp = 0; grp < 4; ++grp) {
                const int s0 = 4 * (grp >> 1), kb = grp & 1;
                if (grp + 1 < 4) { const int s1 = 4 * ((grp + 1) >> 1), kb1 = (grp + 1) & 1;
#pragma unroll
                    for (int s = 0; s < 4; ++s) ka[(grp + 1) & 1][s] = lds_b128(kbase + 8192 * kb1 + (kadr ^ (32 * (s1 + s)))); }
                FENCE();
                __builtin_amdgcn_s_setprio(2);
#pragma unroll
                for (int s = 0; s < 4; ++s) sc[kb] = MFMA32(ka[grp & 1][s], qf[s0 + s], sc[kb]);
                __builtin_amdgcn_s_setprio(1);
                FENCE();
            }
        }
        __builtin_amdgcn_s_setprio(0);
        if (krel0 >= 0) {
            const int qrel = ri * 32 + li;
#pragma unroll
            for (int kb = 0; kb < 2; ++kb)
#pragma unroll
                for (int r = 0; r < 16; ++r) if (krel0 + 32 * kb + crow(r, hh) > qrel) sc[kb][r] = -INFINITY;
        }
        float pmax = sc[0][0];
#pragma unroll
        for (int r = 1; r < 16; ++r) pmax = fmaxf(pmax, sc[0][r]);
#pragma unroll
        for (int r = 0; r < 16; ++r) pmax = fmaxf(pmax, sc[1][r]);
        pmax = xor32_max(pmax);
        if (!__all(pmax <= mrun + 11.0f)) {
            const float mn = fmaxf(mrun, pmax), alpha = __builtin_amdgcn_exp2f(mrun - mn);
            mrun = mn; lrun *= alpha;
#pragma unroll
            for (int i = 0; i < 8; ++i)
#pragma unroll
                for (int r = 0; r < 16; ++r) O[i][r] *= alpha;
        }
        float ps = 0.f;
#pragma unroll
        for (int kb = 0; kb < 2; ++kb)
#pragma unroll
            for (int r = 0; r < 16; ++r) { const float pe = __builtin_amdgcn_exp2f(sc[kb][r] - mrun); sc[kb][r] = pe; ps += pe; }
        lrun += ps;
        {
            const int vbase = (int)(unsigned)(size_t)Vt;
            int ad[8];
#pragma unroll
            for (int c = 0; c < 4; ++c) { ad[2 * c] = vbase + (vb1 ^ (64 * c)); ad[2 * c + 1] = vbase + (vb2 ^ (64 * c)); }
            const bf16x8 pf0 = pack8(sc[0], 0), pf1 = pack8(sc[0], 8), pf2 = pack8(sc[1], 0), pf3 = pack8(sc[1], 8);
            s16x4 xa[8], xb[8];
            __builtin_amdgcn_s_setprio(1);
#define PV_LOAD(x, IMM) do { _Pragma("unroll") for (int c = 0; c < 8; ++c) x[c] = lds_tr_i<(IMM)>(ad[c]); } while (0)
            PV_LOAD(xa, 256 * 0);
            PV_LOAD(xb, 256 * 0 + 16384);  FENCE(); pv_mma(O, 0, xa, pf0); FENCE();
            PV_LOAD(xa, 256 * 16);         FENCE(); pv_mma(O, 4, xb, pf0); FENCE();
            PV_LOAD(xb, 256 * 16 + 16384); FENCE(); pv_mma(O, 0, xa, pf1); FENCE();
            PV_LOAD(xa, 256 * 32);         FENCE(); pv_mma(O, 4, xb, pf1); FENCE();
            PV_LOAD(xb, 256 * 32 + 16384); FENCE(); pv_mma(O, 0, xa, pf2); FENCE();
            PV_LOAD(xa, 256 * 48);         FENCE(); pv_mma(O, 4, xb, pf2); FENCE();
            PV_LOAD(xb, 256 * 48 + 16384); FENCE(); pv_mma(O, 0, xa, pf3); FENCE();
                                                    pv_mma(O, 4, xb, pf3);
            __builtin_amdgcn_s_setprio(0);
#undef PV_LOAD
        }
    }
    }
    __syncthreads();
    const float inv = 1.0f / xor32_sum(lrun);
    LAS f32x4* X = (LAS f32x4*)lds;
    const int lane = lane_now(), hh = lane >> 5, li = lane & 31;
    if (comp == 1) {
#pragma unroll
        for (int dvb = 0; dvb < 8; ++dvb)
#pragma unroll
            for (int g = 0; g < 4; ++g) X[((ri * 8 + dvb) * 4 + g) * 64 + lane] = (f32x4){O[dvb][4 * g] * inv, O[dvb][4 * g + 1] * inv, O[dvb][4 * g + 2] * inv, O[dvb][4 * g + 3] * inv};
    }
    __syncthreads();
    if (comp == 0) {
        float ss = 0.f;
#pragma unroll
        for (int dvb = 0; dvb < 8; ++dvb)
#pragma unroll
            for (int g = 0; g < 4; ++g) {
                const f32x4 o2 = X[((ri * 8 + dvb) * 4 + g) * 64 + lane];
#pragma unroll
                for (int e = 0; e < 4; ++e) { float d = O[dvb][4 * g + e] * inv - A.lam * o2[e]; asm volatile("" : "+v"(d)); O[dvb][4 * g + e] = d; ss += d * d; }
            }
        ss = xor32_sum(ss);
        const float rstd = 0.8f / sqrtf(ss * (1.0f / 256.0f) + EPS);
        LAS unsigned char* stg = lds + ri * 32768;
#pragma unroll
        for (int dh = 0; dh < 2; ++dh) {
            asm volatile("" ::: "memory");
            f32x4 gn[4][4];
#pragma unroll
            for (int d4 = 0; d4 < 4; ++d4)
#pragma unroll
                for (int g = 0; g < 4; ++g) gn[d4][g] = *(const f32x4*)(A.diff_norm + 32 * (4 * dh + d4) + 8 * g + 4 * hh);
            asm volatile("" ::: "memory");
#pragma unroll
            for (int d4 = 0; d4 < 4; ++d4) {
                const int dvb = 4 * dh + d4;
#pragma unroll
                for (int g = 0; g < 4; ++g) {
                    u32x2 w; w.x = cvt_pk_bf16(O[dvb][4 * g] * rstd * gn[d4][g][0], O[dvb][4 * g + 1] * rstd * gn[d4][g][1]); w.y = cvt_pk_bf16(O[dvb][4 * g + 2] * rstd * gn[d4][g][2], O[dvb][4 * g + 3] * rstd * gn[d4][g][3]);
                    *(LAS u32x2*)(stg + li * 528 + 64 * dvb + 16 * g + 8 * hh) = w;
                }
            }
        }
        asm volatile("s_waitcnt lgkmcnt(0)" ::: "memory");
        bf16_t* obase = A.act + (tb + qb * 128 + ri * 32 + hh) * 2048 + 1024 + h * 256 + 8 * li;
#pragma unroll
        for (int i4 = 0; i4 < 4; ++i4) {
            u32x4 v[4];
#pragma unroll
            for (int q = 0; q < 4; ++q) v[q] = *(const LAS u32x4*)(stg + (2 * (4 * i4 + q) + hh) * 528 + 16 * li);
#pragma unroll
            for (int q = 0; q < 4; ++q) *(u32x4*)(obase + (size_t)(2 * (4 * i4 + q)) * 2048) = v[q];
        }
    }
    __syncthreads();
}

#define MFMA_DEP(acc, zs) (__builtin_amdgcn_readfirstlane(__float_as_int((acc)[15])) & (zs))
#define MFMA_DEP2(a, b, zs) ((__builtin_amdgcn_readfirstlane(__float_as_int((a)[15])) | __builtin_amdgcn_readfirstlane(__float_as_int((b)[15]))) & (zs))
#define MFMA_DEP4(a, b, c, d, zs) ((__builtin_amdgcn_readfirstlane(__float_as_int((a)[15])) | __builtin_amdgcn_readfirstlane(__float_as_int((b)[15])) | __builtin_amdgcn_readfirstlane(__float_as_int((c)[15])) | __builtin_amdgcn_readfirstlane(__float_as_int((d)[15]))) & (zs))
#define RET_BAR() do { asm volatile("s_waitcnt lgkmcnt(0)" ::: "memory"); __builtin_amdgcn_s_barrier(); asm volatile("" ::: "memory"); } while (0)
template <int J2> __device__ __forceinline__ void ret_step34(f32x16 (&Oa)[2], f32x16 (&St)[2], const int (&tv)[2], const int (&tk)[2][2], int pa0, int pa1, int pb0, int pb1, int ib0, int ib1) {
    constexpr int R = 256 * 32 * J2;
    s16x4 xv[4], xk0[4], xk1[4]; bf16x8 pp[4];
    xv[0] = lds_tr_i<R>(tv[0]); xv[1] = lds_tr_i<R + 1024>(tv[1]); xv[2] = lds_tr_i<R + 4096>(tv[0]); xv[3] = lds_tr_i<R + 5120>(tv[1]);
    xk0[0] = lds_tr_i<R>(tk[0][0]); xk0[1] = lds_tr_i<R + 1024>(tk[0][1]); xk0[2] = lds_tr_i<R + 4096>(tk[0][0]); xk0[3] = lds_tr_i<R + 5120>(tk[0][1]);
    xk1[0] = lds_tr_i<R>(tk[1][0]); xk1[1] = lds_tr_i<R + 1024>(tk[1][1]); xk1[2] = lds_tr_i<R + 4096>(tk[1][0]); xk1[3] = lds_tr_i<R + 5120>(tk[1][1]);
    pp[0] = lds_b128(pa0); pp[1] = lds_b128(pb0); pp[2] = lds_b128(pa1); pp[3] = lds_b128(pb1);
    FENCE();
    const bf16x8 z = {0, 0, 0, 0, 0, 0, 0, 0};
#pragma unroll
    for (int q = 0; q < 2; ++q) {
        const bf16x8 vf = cat4(xv[2 * q], xv[2 * q + 1]);
        Oa[0] = MFMA32(vf, (J2 <= ib0) ? pp[2 * q] : z, Oa[0]); Oa[1] = MFMA32(vf, (J2 <= ib1) ? pp[2 * q + 1] : z, Oa[1]);
        St[0] = MFMA32(cat4(xk0[2 * q], xk0[2 * q + 1]), vf, St[0]); St[1] = MFMA32(cat4(xk1[2 * q], xk1[2 * q + 1]), vf, St[1]);
    }
    FENCE();
}
__device__ __forceinline__ void ret_unit(LAS unsigned char* lds, const int wid, const MixArgs& A, int bl, int h, int dvh) {
    const int lane = lane_now(), tid = wid * 64 + lane, eb = wid & 3, hf = wid >> 2;
    const int ib0 = hf ? 1 : 0, ib1 = hf ? 2 : 3, li = lane & 31, hh = lane >> 5;
    const size_t tb = (size_t)bl * SEQ;
    const float gamma = 1.0f - __builtin_amdgcn_exp2f(-5.0f - (float)h), lg = __builtin_amdgcn_logf(gamma);
    const float cdecay = __builtin_amdgcn_exp2f(128.0f * lg), cinv = __builtin_amdgcn_exp2f(-128.0f * lg);
    const int L0 = lds_addr(lds), X = ((li & 3) << 2) | ((li >> 2) & 3);
    int rb[8];
#pragma unroll
    for (int s = 0; s < 8; ++s) rb[s] = L0 + 256 * li + 16 * ((2 * s + hh) ^ X);
    int wb[4];
#pragma unroll
    for (int g = 0; g < 4; ++g) wb[g] = L0 + 256 * li + 16 * (g ^ (X & 3)) + 8 * hh;
    const int xh = X >> 2;
    const int tq = (lane & 15) >> 2, tp = lane & 3, tblk = (lane >> 4) & 1;
    int tv[2], tk[2][2];
#pragma unroll
    for (int t = 0; t < 2; ++t) {
        const int lp = 2048 * hh + 256 * tq + 16 * ((2 * tblk + (tp >> 1)) ^ (2 * hh + t)) + 8 * (tp & 1);
        tv[t] = L0 + 65536 + lp + 64 * (eb ^ tq);
#pragma unroll
        for (int k = 0; k < 2; ++k) tk[k][t] = L0 + 32768 + lp + 64 * ((2 * hf + k) ^ tq);
    }
    const int sS0 = 98304 + 8192 * eb, sA0 = 8192 * ib0, sB0 = 8192 * ib1;
    const int sw = 256 * (tid >> 4) + 16 * ((tid & 15) ^ ((((tid >> 4) & 3) << 2) | ((tid >> 6) & 3)));
    const unsigned gq = (unsigned)(((tid >> 4) * DIN + (tid & 15) * 8) * 2);
    const unsigned colb[3] = {(unsigned)(h * 128 * 2), (unsigned)((512 + h * 128) * 2), (unsigned)((1024 + h * 256 + dvh * 128) * 2)};
    const unsigned go0 = (unsigned)(((32 * ib0 + li) * DIN + 4 * hh) * 2), go1 = (unsigned)(((32 * ib1 + li) * DIN + 4 * hh) * 2);
    const unsigned oo0 = (unsigned)(((32 * ib0 + li) * 2048 + 4 * hh) * 2), oo1 = (unsigned)(((32 * ib1 + li) * 2048 + 4 * hh) * 2);
    f32x16 St[2];
#pragma unroll
    for (int i = 0; i < 2; ++i)
#pragma unroll
        for (int r = 0; r < 16; ++r) St[i][r] = 0.f;
    u32x4 pre[12];
    {
        const char* cb = (const char*)(A.proj + tb * DIN);
#pragma unroll
        for (int i = 0; i < 12; ++i) pre[i] = *(const u32x4*)(cb + (size_t)(i & 3) * 32 * DIN * 2 + (gq + colb[i >> 2]));
#pragma unroll
        for (int i = 0; i < 12; ++i) *(LAS u32x4*)(lds + (i >> 2) * 32768 + (i & 3) * 8192 + sw) = pre[i];
    }
    RET_BAR();
    for (int n = 0; n < 32; ++n) {
        const size_t t0 = tb + (size_t)n * 128;
        int sS = sS0, sA = sA0, sB = sB0, wl = wid;
        asm volatile("" : "+s"(sS), "+s"(sA), "+s"(sB), "+s"(wl));
        if (n + 1 < 32) {
            const char* cb = (const char*)(A.proj + (t0 + 128) * DIN);
#pragma unroll
            for (int i = 0; i < 12; ++i) pre[i] = *(const u32x4*)(cb + (size_t)(i & 3) * 32 * DIN * 2 + (gq + colb[i >> 2]));
        }
        f32x16 Oa[2];
#pragma unroll
        for (int i = 0; i < 2; ++i)
#pragma unroll
            for (int r = 0; r < 16; ++r) Oa[i][r] = 0.f;
        if (n > 0) {
#pragma unroll
            for (int s4 = 0; s4 < 2; ++s4) {
                bf16x8 sa[4], qa[4], qb[4];
#pragma unroll
                for (int s = 0; s < 4; ++s) { sa[s] = lds_b128(rb[4 * s4 + s] + sS); qa[s] = lds_b128(rb[4 * s4 + s] + sA); qb[s] = lds_b128(rb[4 * s4 + s] + sB); }
                FENCE();
#pragma unroll
                for (int s = 0; s < 4; ++s) { Oa[0] = MFMA32(sa[s], qa[s], Oa[0]); Oa[1] = MFMA32(sa[s], qb[s], Oa[1]); }
                FENCE();
            }
        }
        f32x16 sb[2]; int jbs[2], ibs[2];
#pragma unroll
        for (int u = 0; u < 2; ++u) {
            const int id = wl + 8 * u;
            const int ib = (id >= 6) ? 3 : (id >= 3) ? 2 : (id >= 1) ? 1 : 0, jb = id - (ib * (ib + 1)) / 2;
            ibs[u] = ib; jbs[u] = jb;
#pragma unroll
            for (int r = 0; r < 16; ++r) sb[u][r] = 0.f;
            if (id < 10) {
                bf16x8 fa[4], fb[4];
                const int ok = 32768 + 8192 * jb, oq = 8192 * ib;
#pragma unroll
                for (int h2 = 0; h2 < 2; ++h2) {
#pragma unroll
                    for (int s = 0; s < 4; ++s) { fa[s] = lds_b128(rb[4 * h2 + s] + ok); fb[s] = lds_b128(rb[4 * h2 + s] + oq); }
                    FENCE();
#pragma unroll
                    for (int s = 0; s < 4; ++s) sb[u] = MFMA32(fa[s], fb[s], sb[u]);
                    FENCE();
                }
            }
        }
        RET_BAR();
#pragma unroll
        for (int u = 0; u < 2; ++u) {
            const int id = wl + 8 * u;
            if (id < 10) {
                const int ib = ibs[u], jb = jbs[u], wo = 8192 * ib + 64 * (jb ^ xh);
#pragma unroll
                for (int g = 0; g < 4; ++g) {
                    float p[4];
#pragma unroll
                    for (int e = 0; e < 4; ++e) { const int j = 8 * g + 4 * hh + e; p[e] = (ib == jb && j > li) ? 0.f : sb[u][4 * g + e] * cinv; }
                    u32x2 w; w.x = cvt_pk_bf16(p[0], p[1]); w.y = cvt_pk_bf16(p[2], p[3]);
                    *(LAS u32x2*)(size_t)(unsigned)(wb[g] + wo) = w;
                }
            }
        }
        RET_BAR();
        u32x2 gg[2][4];
        { const char* gbp = (const char*)(A.proj + t0 * DIN + 2048 + h * 256 + dvh * 128 + 32 * eb);
#pragma unroll
          for (int g = 0; g < 4; ++g) { gg[0][g] = *(const u32x2*)(gbp + go0 + 16 * g); gg[1][g] = *(const u32x2*)(gbp + go1 + 16 * g); } }
#pragma unroll
        for (int k = 0; k < 2; ++k)
#pragma unroll
            for (int r = 0; r < 16; ++r) St[k][r] *= cdecay;
        ret_step34<0>(Oa, St, tv, tk, rb[0] + sA, rb[1] + sA, rb[0] + sB, rb[1] + sB, ib0, ib1);
        ret_step34<1>(Oa, St, tv, tk, rb[2] + sA, rb[3] + sA, rb[2] + sB, rb[3] + sB, ib0, ib1);
        ret_step34<2>(Oa, St, tv, tk, rb[4] + sA, rb[5] + sA, rb[4] + sB, rb[5] + sB, ib0, ib1);
        ret_step34<3>(Oa, St, tv, tk, rb[6] + sA, rb[7] + sA, rb[6] + sB, rb[7] + sB, ib0, ib1);
        RET_BAR();
#pragma unroll
        for (int k = 0; k < 2; ++k) {
            const int so = sS + 64 * ((2 * (wl >> 2) + k) ^ xh);
#pragma unroll
            for (int g = 0; g < 4; ++g) {
                u32x2 w; w.x = cvt_pk_bf16(St[k][4 * g], St[k][4 * g + 1]); w.y = cvt_pk_bf16(St[k][4 * g + 2], St[k][4 * g + 3]);
                *(LAS u32x2*)(size_t)(unsigned)(wb[g] + so) = w;
            }
        }
        if (n + 1 < 32) {
#pragma unroll
            for (int i = 0; i < 12; ++i) *(LAS u32x4*)(lds + (i >> 2) * 32768 + (i & 3) * 8192 + sw) = pre[i];
        }
        {
            char* obp = (char*)(A.act + t0 * 2048 + h * 256 + dvh * 128 + 32 * eb);
            float* sqp = A.ssq + (t0 * 4 + h) * 8 + dvh * 4 + eb;
#pragma unroll
            for (int k = 0; k < 2; ++k) {
                float sq = 0.f;
#pragma unroll
                for (int r = 0; r < 16; ++r) sq += Oa[k][r] * Oa[k][r];
                sq = xor32_sum(sq);
                if (hh == 0) sqp[(size_t)(32 * (k ? ib1 : ib0) + li) * 32] = sq;
                const unsigned oo = k ? oo1 : oo0;
                u32x2 w[4];
#pragma unroll
                for (int g = 0; g < 4; ++g) {
                    const u32x2 gv = gg[k][g];
                    w[g].x = cvt_pk_bf16(Oa[k][4 * g] * bf_lo(gv.x), Oa[k][4 * g + 1] * bf_hi(gv.x)); w[g].y = cvt_pk_bf16(Oa[k][4 * g + 2] * bf_lo(gv.y), Oa[k][4 * g + 3] * bf_hi(gv.y));
                }
#pragma unroll
                for (int g = 0; g < 4; g += 2) {
                    const auto sx = __builtin_amdgcn_permlane32_swap(w[g].x, w[g + 1].x, false, false), sy = __builtin_amdgcn_permlane32_swap(w[g].y, w[g + 1].y, false, false);
                    *(u32x4*)(obp + (oo - 8 * hh) + 16 * (g + hh)) = (u32x4){(unsigned)sx[0], (unsigned)sy[0], (unsigned)sx[1], (unsigned)sy[1]};
                }
            }
        }
        RET_BAR();
    }
    __syncthreads();
}

struct Args { const void* in[24]; float* out; unsigned char* ws; int ph_lo, ph_hi; };
struct Frame {
    LAS unsigned char* lds; int tid, lane, wave, G, vcu;
    const float *x, *c, *w_ada, *b_ada, *norm_mix, *w_in, *w_ret_o, *w_diff_o, *lq1, *lk1, *lq2, *lk2, *diff_norm, *w_out, *norm_ffn, *w_rg, *b_rg, *w_re, *b_re, *w_eg, *w_eu, *w_ed, *norm_final;
    const int* positions; float* out; unsigned char* ws;
};
__device__ __forceinline__ unsigned f2bf(float f) { unsigned u = __builtin_bit_cast(unsigned, f); return (u + 0x7fffu + ((u >> 16) & 1u)) >> 16; }
__device__ __forceinline__ unsigned pk2(float lo, float hi) { return f2bf(lo) | (f2bf(hi) << 16); }

template <int MODE>
__device__ __forceinline__ void p0_transpose_item(const float* W, int N, bf16_t* WT, int ldk, int koff, LAS float* scr, int item, int lane) {
    const int nblk = N / 32, kb = item / nblk, nb = item % nblk, k0 = 64 * kb, n0 = 32 * nb;
    { float wv[32];
#pragma unroll
      for (int i = 0; i < 32; ++i) { const int kk = 2 * i + (lane >> 5); wv[i] = W[(size_t)(k0 + kk) * N + n0 + (lane & 31)]; }
#pragma unroll
      for (int i = 0; i < 32; ++i) { const int kk = 2 * i + (lane >> 5); scr[kk * 33 + (lane & 31)] = wv[i]; } }
    LDS_WAIT(); asm volatile("" ::: "memory");
    const int c = lane & 7;
#pragma unroll
    for (int j = 0; j < 4; ++j) {
        const int nl = (lane >> 3) + 8 * j, n = n0 + nl; const LAS float* s = scr + (8 * c) * 33 + nl;
        int np = n; float sc = 1.f;
        if (MODE == 1) {
            const bool rope = (n < 1024) || (n >= 3072 && n < 5120);
            if (rope) { const int f = n & 127; np = (n & ~127) + 8 * ((f & 63) >> 2) + 4 * (f >> 6) + (f & 3); }
            if ((n >= 512 && n < 1024) || (n >= 4096 && n < 5120)) sc = 0.08838834764831845f;
            else if (n >= 3072 && n < 4096) sc = 1.4426950408889634f;
        } else if (MODE == 2) np = 8 * (n >> 2) + (n & 3);
        else if (MODE == 3) np = 8 * (n >> 2) + 4 + (n & 3);
        u32x4 o; o.x = pk2(s[0 * 33] * sc, s[1 * 33] * sc); o.y = pk2(s[2 * 33] * sc, s[3 * 33] * sc); o.z = pk2(s[4 * 33] * sc, s[5 * 33] * sc); o.w = pk2(s[6 * 33] * sc, s[7 * 33] * sc);
        *(u32x4*)(WT + (size_t)np * ldk + koff + k0 + 8 * c) = o;
    }
    LDS_WAIT(); asm volatile("" ::: "memory");
}

template <int MODE>
__device__ __forceinline__ void p0_transpose_item8(const float* W, int N, unsigned char* WT8, int ldk, LAS float* scr, int item, int lane) {
    const int nblk = N / 32, kb = item / nblk, nb = item % nblk, k0 = 64 * kb, n0 = 32 * nb;
    { float wv[32];
#pragma unroll
      for (int i = 0; i < 32; ++i) { const int kk = 2 * i + (lane >> 5); wv[i] = W[(size_t)(k0 + kk) * N + n0 + (lane & 31)]; }
#pragma unroll
      for (int i = 0; i < 32; ++i) { const int kk = 2 * i + (lane >> 5); scr[kk * 33 + (lane & 31)] = wv[i]; } }
    LDS_WAIT(); asm volatile("" ::: "memory");
    const int c = lane & 7;
#pragma unroll
    for (int j = 0; j < 4; ++j) {
        const int nl = (lane >> 3) + 8 * j, n = n0 + nl; const LAS float* s = scr + (8 * c) * 33 + nl;
        const int np = (MODE == 2) ? 8 * (n >> 2) + (n & 3) : (MODE == 3) ? 8 * (n >> 2) + 4 + (n & 3) : n;
        u32x2 o; o.x = pk4_fp8(s[0 * 33] * 32.f, s[1 * 33] * 32.f, s[2 * 33] * 32.f, s[3 * 33] * 32.f); o.y = pk4_fp8(s[4 * 33] * 32.f, s[5 * 33] * 32.f, s[6 * 33] * 32.f, s[7 * 33] * 32.f);
        *(u32x2*)(WT8 + (size_t)np * ldk + k0 + 8 * c) = o;
    }
    LDS_WAIT(); asm volatile("" ::: "memory");
}
template <int MODE>
__device__ __forceinline__ void p0_transpose_pair8(const float* W, int N, unsigned char* WT8, int ldk, LAS float* scr, int item, int lane) {
    const int nblk = N / 32;
    float wa[32], wb[32];
    { const int kb = item / nblk, nb = item % nblk, k0 = 64 * kb, n0 = 32 * nb;
#pragma unroll
      for (int i = 0; i < 32; ++i) { const int kk = 2 * i + (lane >> 5); wa[i] = W[(size_t)(k0 + kk) * N + n0 + (lane & 31)]; } }
    { const int kb = (item + 1) / nblk, nb = (item + 1) % nblk, k0 = 64 * kb, n0 = 32 * nb;
#pragma unroll
      for (int i = 0; i < 32; ++i) { const int kk = 2 * i + (lane >> 5); wb[i] = W[(size_t)(k0 + kk) * N + n0 + (lane & 31)]; } }
#pragma unroll
    for (int h = 0; h < 2; ++h) {
        const int it = item + h, kb = it / nblk, nb = it % nblk, k0 = 64 * kb, n0 = 32 * nb;
#pragma unroll
        for (int i = 0; i < 32; ++i) { const int kk = 2 * i + (lane >> 5); scr[kk * 33 + (lane & 31)] = h ? wb[i] : wa[i]; }
        LDS_WAIT(); asm volatile("" ::: "memory");
        const int c = lane & 7;
#pragma unroll
        for (int j = 0; j < 4; ++j) {
            const int nl = (lane >> 3) + 8 * j, n = n0 + nl; const LAS float* sp = scr + (8 * c) * 33 + nl;
            const int np = (MODE == 2) ? 8 * (n >> 2) + (n & 3) : (MODE == 3) ? 8 * (n >> 2) + 4 + (n & 3) : n;
            u32x2 o; o.x = pk4_fp8(sp[0 * 33] * 32.f, sp[1 * 33] * 32.f, sp[2 * 33] * 32.f, sp[3 * 33] * 32.f); o.y = pk4_fp8(sp[4 * 33] * 32.f, sp[5 * 33] * 32.f, sp[6 * 33] * 32.f, sp[7 * 33] * 32.f);
            *(u32x2*)(WT8 + (size_t)np * ldk + k0 + 8 * c) = o;
        }
        LDS_WAIT(); asm volatile("" ::: "memory");
    }
}

__device__ __forceinline__ void p0_prologue(Frame& F) {
    F.lane = lane_now(); F.tid = F.wave * 64 + F.lane;
    float* mod = (float*)(F.ws + WS_MOD);
    LAS float* sc = (LAS float*)F.lds;
    for (int i = F.tid; i < NB * D; i += NTHR) { const float v = F.c[i]; sc[(i & 1023) * 8 + (i >> 10)] = v / (1.0f + __expf(-v)); }
    __syncthreads();
    LAS float* red = (LAS float*)(F.lds + 32768);
    for (int item = blockIdx.x; item < 192; item += F.G) {
        const int cl = F.tid & 31, kg = F.tid >> 5, col = item * 32 + cl;
        const float* wp = F.w_ada + (size_t)(kg * 64) * 6144 + col;
        float w[64];
#pragma unroll
        for (int k = 0; k < 64; ++k) w[k] = wp[(size_t)k * 6144];
        float a[8];
#pragma unroll
        for (int b = 0; b < 8; ++b) a[b] = 0.f;
#pragma unroll
        for (int k = 0; k < 64; ++k) { const f32x4 s0 = *(const LAS f32x4*)(sc + (kg * 64 + k) * 8), s1 = *(const LAS f32x4*)(sc + (kg * 64 + k) * 8 + 4);
            a[0] += s0.x * w[k]; a[1] += s0.y * w[k]; a[2] += s0.z * w[k]; a[3] += s0.w * w[k]; a[4] += s1.x * w[k]; a[5] += s1.y * w[k]; a[6] += s1.z * w[k]; a[7] += s1.w * w[k]; }
#pragma unroll
        for (int b = 0; b < 8; ++b) red[(kg * 8 + b) * 32 + cl] = a[b];
        __syncthreads();
        if (F.tid < 256) { const int b = F.tid >> 5; float s = 0.f;
#pragma unroll
          for (int g = 0; g < 16; ++g) s += red[(g * 8 + b) * 32 + cl];
          mod[(size_t)b * 6144 + col] = s + F.b_ada[col]; }
        __syncthreads();
    }
    if (blockIdx.x == 0 && F.wave == 0) {
        float s1 = F.lq1[F.lane] * F.lk1[F.lane] + F.lq1[F.lane + 64] * F.lk1[F.lane + 64], s2 = F.lq2[F.lane] * F.lk2[F.lane] + F.lq2[F.lane + 64] * F.lk2[F.lane + 64];
        s1 = wave_sum(s1); s2 = wave_sum(s2);
        if (F.lane == 0) *(float*)(F.ws + WS_MOD + 256 * 1024) = __expf(s1) - __expf(s2) + 0.2f;
    }
    { bf16_t* rth = (bf16_t*)(F.ws + WS_MOD + 512 * 1024); bf16_t* rtl = rth + 48 * D;
      for (int i = blockIdx.x * NTHR + F.tid; i < 48 * D; i += F.G * NTHR) { const int o = i >> 10, k = i & 1023; const float w = (o < 4) ? F.w_rg[k * 4 + o] : (o < 36) ? F.w_re[k * 32 + (o - 4)] : 0.f;
          const unsigned h = f2bf(w); rth[i] = (bf16_t)h; rtl[i] = (bf16_t)f2bf(w - __uint_as_float(h << 16)); } }
    __syncthreads();
    LAS float* scr = (LAS float*)(F.lds + F.wave * 16384);
    const int gw = launder_s(F.vcu * NWAVES + F.wave), NGW = F.G * NWAVES;
    constexpr int I_IN = 16 * 256, I_SQ = 16 * 32;
    constexpr int NITEMS = I_IN + 3 * I_SQ;
    bf16_t* Win = (bf16_t*)(F.ws + WS_WIN); bf16_t* Wmix = (bf16_t*)(F.ws + WS_WMIX); bf16_t* Wout = (bf16_t*)(F.ws + WS_WOUT);
    for (int it = gw; it < NITEMS; it += NGW) {
        int r = it;
        if (r < I_IN) { p0_transpose_item<1>(F.w_in, DIN, Win, 1024, 0, scr, r, F.lane); continue; } r -= I_IN;
        if (r < I_SQ) { p0_transpose_item<0>(F.w_ret_o, D, Wmix, 2048, 0, scr, r, F.lane); continue; } r -= I_SQ;
        if (r < I_SQ) { p0_transpose_item<0>(F.w_diff_o, D, Wmix, 2048, 1024, scr, r, F.lane); continue; } r -= I_SQ;
        p0_transpose_item<0>(F.w_out, D, Wout, 1024, 0, scr, r, F.lane);
    }
    float* cosT = (float*)(F.ws + WS_COS); float* sinT = (float*)(F.ws + WS_SIN);
    {
        constexpr int RIT = 16;
        const int stride = F.G * NTHR;
        for (int base = blockIdx.x * NTHR + F.tid; base < T * 64; base += stride * RIT) {
            int pos[RIT];
#pragma unroll
            for (int q = 0; q < RIT; ++q) { const int i = base + q * stride; pos[q] = (i < T * 64) ? F.positions[i >> 6] : 0; }
#pragma unroll
            for (int q = 0; q < RIT; ++q) {
                const int i = base + q * stride; if (i >= T * 64) break;
                const int j = i & 63;
                const float inv = __builtin_amdgcn_exp2f(-(float)j * (13.287712379549449f / 64.0f));
                const float ang = (float)pos[q] * inv;
                double rev = (double)ang * 0.15915494309189535; rev -= __builtin_rint(rev);
                const float rf = (float)rev;
                cosT[i] = __builtin_amdgcn_cosf(rf); sinT[i] = __builtin_amdgcn_sinf(rf);
            }
        }
    }
}

__device__ __forceinline__ void convert_experts(Frame& F) {
    constexpr int I_G = 32 * 256, NCH = (3 * I_G) / 32;
    unsigned* q2 = (unsigned*)(F.ws + WS_CTL) + CW_Q + 64 * 8;
    volatile LAS int* bc = (volatile LAS int*)(F.lds + LDSCTL_OFF + 64);
    LAS float* scr = (LAS float*)(F.lds + F.wave * 16384);
    unsigned char* Wgu = F.ws + WS_WGU; unsigned char* Wdn = F.ws + WS_WDN;
    const int lane = lane_now();
    for (;;) {
        __syncthreads();
        if (F.wave == 0 && lane_now() == 0) bc[0] = (int)__hip_atomic_fetch_add(q2, 1u, __ATOMIC_RELAXED, __HIP_MEMORY_SCOPE_AGENT);
        __syncthreads();
        const int c = bc[0];
        if (c >= NCH) break;
        for (int k = 0; k < 4; k += 2) {
            int r = c * 32 + F.wave * 4 + k;
            if (r < I_G) { const int e = r >> 8; p0_transpose_pair8<2>(F.w_eg + (size_t)e * D * DEXP, DEXP, Wgu + (size_t)e * 1024 * 1024, 1024, scr, r & 255, lane); continue; } r -= I_G;
            if (r < I_G) { const int e = r >> 8; p0_transpose_pair8<3>(F.w_eu + (size_t)e * D * DEXP, DEXP, Wgu + (size_t)e * 1024 * 1024, 1024, scr, r & 255, lane); continue; } r -= I_G;
            { const int e = r >> 8; p0_transpose_pair8<0>(F.w_ed + (size_t)e * DEXP * D, D, Wdn + (size_t)e * 1024 * 512, 512, scr, r & 255, lane); }
        }
    }
    __syncthreads();
}

__device__ __forceinline__ void p1_norm_mod(Frame& F) {
    F.lane = lane_now(); F.tid = F.wave * 64 + F.lane;
    const float* mod = (const float*)(F.ws + WS_MOD); bf16_t* H0 = (bf16_t*)(F.ws + WS_H); bf16_t* H1 = (bf16_t*)(F.out + (size_t)TH * D);
    const int gw = launder_s(F.vcu * NWAVES + F.wave), NGW = F.G * NWAVES;
    f32x4 v[4], vn[4];
    if (gw < T) { const f32x4* xr = (const f32x4*)(F.x + (size_t)gw * D) + F.lane;
#pragma unroll
        for (int j = 0; j < 4; ++j) v[j] = xr[64 * j]; }
    for (int t = gw; t < T; t += NGW) {
        const int b = t >> 12;
        f32x4 gs[4], sh[4];
#pragma unroll
        for (int j = 0; j < 4; ++j) { const int col = 4 * F.lane + 256 * j;
            const f32x4 g = *(const f32x4*)(F.norm_mix + col), sc = *(const f32x4*)(mod + (size_t)b * 6144 + 1024 + col); sh[j] = *(const f32x4*)(mod + (size_t)b * 6144 + col); gs[j] = g * (sc + 1.0f); }
        if (t + NGW < T) { const f32x4* xr = (const f32x4*)(F.x + (size_t)(t + NGW) * D) + F.lane;
#pragma unroll
            for (int j = 0; j < 4; ++j) vn[j] = xr[64 * j]; }
        float s = 0.f;
#pragma unroll
        for (int j = 0; j < 4; ++j) s += (v[j].x * v[j].x + v[j].y * v[j].y) + (v[j].z * v[j].z + v[j].w * v[j].w);
        const float rstd = 1.0f / sqrtf(wave_sum(s) * (1.0f / D) + EPS);
        u32x2* o8 = (u32x2*)((t < TH ? H0 : H1) + (size_t)(t & (TH - 1)) * D) + F.lane;
#pragma unroll
        for (int j = 0; j < 4; ++j) { const f32x4 y = (v[j] * rstd) * gs[j] + sh[j]; u32x2 w; w.x = cvt_pk_bf16(y.x, y.y); w.y = cvt_pk_bf16(y.z, y.w);
            o8[64 * j] = w; }
#pragma unroll
        for (int j = 0; j < 4; ++j) v[j] = vn[j];
    }
}

__device__ __forceinline__ void p3_mix(Frame& F, int hf) {
    F.lane = lane_now(); F.tid = F.wave * 64 + F.lane;
    MixArgs A; A.proj = (const bf16_t*)(F.ws + WS_PROJ); A.act = (bf16_t*)(F.ws + WS_ACT); A.diff_norm = F.diff_norm; A.ssq = (float*)(F.ws + WS_SSQ);
    A.lam = __uint_as_float(__builtin_amdgcn_readfirstlane(*(const unsigned*)(F.ws + WS_MOD + 256 * 1024)));
    unsigned* qbase = (unsigned*)(F.ws + WS_CTL) + CW_Q + 64 * 16 + 64 * 8 * hf;
    volatile LAS int* bc = (volatile LAS int*)(F.lds + LDSCTL_OFF + 64);
    const int x0 = (int)(xb_xcc_id() & 7u);
    int curk = 0; bool havepre = false;
    for (;;) {
        __syncthreads();
        if (F.wave == 0) {
            const int lane = lane_now();
            int u = -1, xq = (x0 + curk) & 7;
            for (int it = 0; it < 64; ++it) {
                int got = -1;
                if (havepre) got = bc[2];
                else if (lane == 0) got = (int)__hip_atomic_fetch_add(qbase + 64 * xq, 1u, __ATOMIC_RELAXED, __HIP_MEMORY_SCOPE_AGENT);
                havepre = false;
                got = __builtin_amdgcn_readfirstlane(got);
                if (got < 4 + 64) { u = got; break; }
                unsigned c = 4u + 64u;
                if (lane < 8) c = __hip_atomic_load(qbase + 64 * ((x0 + lane) & 7), __ATOMIC_RELAXED, __HIP_MEMORY_SCOPE_AGENT);
                const unsigned long long m = __builtin_amdgcn_ballot_w64(lane < 8 && c < 4u + 64u);
                if (m == 0ull) break;
                xq = (x0 + (int)__builtin_ctzll(m)) & 7;
            }
            curk = (xq - x0) & 7;
            if (lane == 0) { bc[0] = u; bc[1] = xq; }
        }
        __syncthreads();
        const int u = __builtin_amdgcn_readfirstlane(bc[0]), xq = __builtin_amdgcn_readfirstlane(bc[1]);
        if (u < 0) break;
#ifndef MIX_NO_RET
        if (u < 4) { const int bh = 2 * xq + (u >> 1); ret_unit(F.lds, F.wave, A, bh >> 2, bh & 3, u & 1); }
#endif
#ifndef MIX_NO_ATTN
        if (u >= 4) { const int v = u - 4, qb = 31 - (v >> 1), bh = 2 * xq + (v & 1);
            int pre = 0;
            if (F.wave == 0 && lane_now() == 0) pre = (int)__hip_atomic_fetch_add(qbase + 64 * xq, 1u, __ATOMIC_RELAXED, __HIP_MEMORY_SCOPE_AGENT);
            attn_unit(F.lds, F.wave, A, bh >> 2, bh & 3, qb, pre, bc + 2);
            havepre = true; }
#endif
    }
    convert_experts(F);
}

typedef float f32x4v __attribute__((ext_vector_type(4)));
__device__ __forceinline__ void p6_router(Frame& F, bool dummy) {
    F.lane = lane_now(); F.tid = F.wave * 64 + F.lane;
    const float* mod = (const float*)(F.ws + WS_MOD); const bf16_t* rth = (const bf16_t*)(F.ws + WS_MOD + 512 * 1024); const bf16_t* rtl = rth + 48 * D;
    unsigned char* H2 = F.ws + WS_H2; const float* x1 = F.x;
    const size_t rbase = dummy ? WS_EACT : WS_ROUT;
    int* tok_e = (int*)(F.ws + rbase); float* tok_w = (float*)(F.ws + rbase + 256 * 1024); int* tok_slot = (int*)(F.ws + rbase + 512 * 1024); int* list = (int*)(F.ws + rbase + 1024 * 1024);
    unsigned* cnt = (unsigned*)(F.ws + WS_CTL) + CW_CNT + (dummy ? 64 : 0);
    LAS int* hist = (LAS int*)(F.lds + LDSCTL_OFF + 256);
    constexpr int RSTR = 4112;
    LAS unsigned char* Xt = F.lds;
    LAS float* part = (LAS float*)(F.lds + 65792);
    LAS float* lgt = (LAS float*)(F.lds + 65792 + 24576);
    unsigned* ghist = (unsigned*)(F.ws + rbase + 768 * 1024);
    for (int tb = blockIdx.x; tb < T / 128; tb += F.G) {
        if (F.tid < 64) hist[F.tid] = 0;
        bf16x8 bwh[4][3], bwl[4][3];
        { const int ln = launder_i(F.lane), r = ln & 15, kq = ln >> 4, k0 = 128 * F.wave + 8 * kq;
#pragma unroll
          for (int g = 0; g < 4; ++g)
#pragma unroll
              for (int nb = 0; nb < 3; ++nb) { const unsigned wi = (unsigned)((16 * nb + r) * D + k0 + 32 * g); bwh[g][nb] = *(const bf16x8*)(rth + wi); bwl[g][nb] = *(const bf16x8*)(rtl + wi); } }
        f32x4 v[2][4]; u32x2 dv[2][4];
        const unsigned char* dbase = F.ws + delta_off(tb * 128);
#pragma unroll
        for (int q = 0; q < 2; ++q) { const f32x4* xr = (const f32x4*)(x1 + (size_t)(tb * 128 + 2 * F.wave + q) * D) + F.lane; const u32x2* dr = (const u32x2*)(dbase + (size_t)(2 * F.wave + q) * 2048) + F.lane;
#pragma unroll
            for (int j = 0; j < 4; ++j) { v[q][j] = xr[64 * j]; dv[q][j] = dr[64 * j]; } }
        LAS f32x4* gsl = (LAS f32x4*)(F.lds + 114944);
        if (F.wave == 0) { const int b = (tb * 128) >> 12;
#pragma unroll
          for (int j = 0; j < 4; ++j) { const int col = 4 * F.lane + 256 * j;
              const f32x4 g = *(const f32x4*)(F.norm_ffn + col), sc = *(const f32x4*)(mod + (size_t)b * 6144 + 4096 + col), sh = *(const f32x4*)(mod + (size_t)b * 6144 + 3072 + col);
              gsl[F.lane + 64 * j] = g * (sc + 1.0f); gsl[256 + F.lane + 64 * j] = sh; } }
        __syncthreads();
        for (int ps = 0; ps < 8; ++ps) {
#pragma unroll
            for (int q = 0; q < 2; ++q) {
                const int tk = 2 * F.wave + q, t = tb * 128 + ps * 16 + tk;
#pragma unroll
                for (int j = 0; j < 4; ++j) { const u32x2 d = dv[q][j]; v[q][j].x += bf_lo(d.x); v[q][j].y += bf_hi(d.x); v[q][j].z += bf_lo(d.y); v[q][j].w += bf_hi(d.y); }
                float s = 0.f;
#pragma unroll
                for (int j = 0; j < 4; ++j) s += (v[q][j].x * v[q][j].x + v[q][j].y * v[q][j].y) + (v[q][j].z * v[q][j].z + v[q][j].w * v[q][j].w);
                const float rstd = 1.0f / sqrtf(wave_sum(s) * (1.0f / D) + EPS);
                unsigned* o4 = (unsigned*)(H2 + (size_t)t * D) + F.lane;
#pragma unroll
                for (int j = 0; j < 4; ++j) {
                    const int col = 4 * F.lane + 256 * j;
                    const f32x4 y = (v[q][j] * rstd) * gsl[F.lane + 64 * j] + gsl[256 + F.lane + 64 * j];
                    o4[64 * j] = pk4_fp8(y.x, y.y, y.z, y.w);
                    *(LAS f32x4*)(Xt + tk * RSTR + col * 4) = y;
                }
            }
            if (ps + 1 < 8) {
#pragma unroll
                for (int q = 0; q < 2; ++q) { const f32x4* xr = (const f32x4*)(x1 + (size_t)(tb * 128 + (ps + 1) * 16 + 2 * F.wave + q) * D) + F.lane; const u32x2* dr = (const u32x2*)(dbase + (size_t)((ps + 1) * 16 + 2 * F.wave + q) * 2048) + F.lane;
#pragma unroll
                    for (int j = 0; j < 4; ++j) { v[q][j] = xr[64 * j]; dv[q][j] = dr[64 * j]; } }
            }
            __syncthreads();
            {
                const int r = F.lane & 15, kq = F.lane >> 4, k0 = 128 * F.wave + 8 * kq;
                f32x4v acc[3];
#pragma unroll
                for (int nb = 0; nb < 3; ++nb) acc[nb] = (f32x4v){0.f, 0.f, 0.f, 0.f};
#pragma unroll
                for (int g = 0; g < 4; ++g) {
                    const f32x4 a0 = *(const LAS f32x4*)(Xt + r * RSTR + (k0 + 32 * g) * 4), a1 = *(const LAS f32x4*)(Xt + r * RSTR + (k0 + 32 * g + 4) * 4);
                    unsigned hp[4], lp[4];
#pragma unroll
                    for (int q = 0; q < 4; ++q) { const float x0 = (q < 2) ? a0[2 * q] : a1[2 * q - 4], x1 = (q < 2) ? a0[2 * q + 1] : a1[2 * q - 3];
                        hp[q] = cvt_pk_bf16(x0, x1); lp[q] = cvt_pk_bf16(x0 - bf_lo(hp[q]), x1 - bf_hi(hp[q])); }
                    const bf16x8 ah = __builtin_bit_cast(bf16x8, (u32x4){hp[0], hp[1], hp[2], hp[3]}), al = __builtin_bit_cast(bf16x8, (u32x4){lp[0], lp[1], lp[2], lp[3]});
#pragma unroll
                    for (int nb = 0; nb < 3; ++nb) {
                        acc[nb] = __builtin_amdgcn_mfma_f32_16x16x32_bf16(ah, bwh[g][nb], acc[nb], 0, 0, 0);
                        acc[nb] = __builtin_amdgcn_mfma_f32_16x16x32_bf16(ah, bwl[g][nb], acc[nb], 0, 0, 0);
                        acc[nb] = __builtin_amdgcn_mfma_f32_16x16x32_bf16(al, bwh[g][nb], acc[nb], 0, 0, 0);
                    }
                }
#pragma unroll
                for (int nb = 0; nb < 3; ++nb)
#pragma unroll
                    for (int e = 0; e < 4; ++e) part[(F.wave * 16 + 4 * kq + e) * 48 + 16 * nb + r] = acc[nb][e];
            }
            __syncthreads();
            for (int idx = F.tid; idx < 16 * 36; idx += NTHR) { const int tk = idx / 36, o = idx - tk * 36; float s = 0.f;
#pragma unroll
                for (int w = 0; w < 8; ++w) s += part[(w * 16 + tk) * 48 + o];
                lgt[(ps * 16 + tk) * 48 + o] = s; }
        }
        __syncthreads();
        if (F.tid < 128) {
            const int t = tb * 128 + F.tid;
            float lg[36];
#pragma unroll
            for (int o = 0; o < 36; ++o) lg[o] = lgt[F.tid * 48 + o];
            float gl[4];
#pragma unroll
            for (int g = 0; g < 4; ++g) gl[g] = lg[g] + F.b_rg[g];
            int gs = 0; float gm = gl[0];
#pragma unroll
            for (int g = 1; g < 4; ++g) if (gl[g] > gm) { gm = gl[g]; gs = g; }
            float gden = 0.f;
#pragma unroll
            for (int g = 0; g < 4; ++g) gden += __expf(gl[g] - gm);
            const float gtop = 1.0f / gden;
            float el[8];
#pragma unroll
            for (int j = 0; j < 8; ++j) {
                const float v0 = lg[4 + j], v1 = lg[12 + j], v2 = lg[20 + j], v3 = lg[28 + j];
                el[j] = ((gs == 0) ? v0 : (gs == 1) ? v1 : (gs == 2) ? v2 : v3) + F.b_re[gs * 8 + j];
            }
            int e1 = 0; float m1 = el[0];
#pragma unroll
            for (int j = 1; j < 8; ++j) if (el[j] > m1) { m1 = el[j]; e1 = j; }
            int e2 = -1; float m2 = -INFINITY;
#pragma unroll
            for (int j = 0; j < 8; ++j) if (j != e1 && el[j] > m2) { m2 = el[j]; e2 = j; }
            const float w1 = 1.0f / (1.0f + __expf(m2 - m1)), w2 = 1.0f - w1;
            const int ea = gs * 8 + e1, eb = gs * 8 + e2;
            tok_e[2 * t] = ea; tok_e[2 * t + 1] = eb; tok_w[2 * t] = gtop * w1; tok_w[2 * t + 1] = gtop * w2;
            tok_slot[2 * t] = __hip_atomic_fetch_add(&hist[ea], 1, __ATOMIC_RELAXED, __HIP_MEMORY_SCOPE_WORKGROUP); tok_slot[2 * t + 1] = __hip_atomic_fetch_add(&hist[eb], 1, __ATOMIC_RELAXED, __HIP_MEMORY_SCOPE_WORKGROUP);
        }
        __syncthreads();
        if (F.tid < 32) ghist[tb * 32 + F.tid] = (unsigned)hist[F.tid];
        __syncthreads();
    }
}
__device__ __forceinline__ void p6b_lists(Frame& F) {
    F.lane = lane_now(); F.tid = F.wave * 64 + F.lane;
    const int* tok_e = (const int*)(F.ws + WS_ROUT); int* tok_slot = (int*)(F.ws + WS_ROUT + 512 * 1024); int* list = (int*)(F.ws + WS_ROUT + 1024 * 1024);
    const unsigned* ghist = (const unsigned*)(F.ws + WS_ROUT + 768 * 1024);
    unsigned* cnt = (unsigned*)(F.ws + WS_CTL) + CW_CNT;
    LAS int* red = (LAS int*)(F.lds + LDSCTL_OFF + 256);
    for (int tb = blockIdx.x; tb < T / 128; tb += F.G) {
        __syncthreads();
        { const int e = F.tid & 31, pt = F.tid >> 5; int s = 0, tot = 0;
          int cv[T / 128 / 16];
#pragma unroll
          for (int q = 0; q < T / 128 / 16; ++q) cv[q] = (int)ghist[(pt + 16 * q) * 32 + e];
#pragma unroll
          for (int q = 0; q < T / 128 / 16; ++q) { tot += cv[q]; if (pt + 16 * q < tb) s += cv[q]; }
          red[pt * 32 + e] = s; red[1024 + pt * 32 + e] = tot; }
        __syncthreads();
        if (F.tid < 32) { int s = 0, tot = 0;
#pragma unroll
            for (int pt = 0; pt < 16; ++pt) { s += red[pt * 32 + F.tid]; tot += red[1024 + pt * 32 + F.tid]; }
            red[512 + F.tid] = s; if (tb == 0) cnt[F.tid] = (unsigned)tot; }
        __syncthreads();
        if (F.tid < 256) {
            const int a = tb * 256 + F.tid, e = tok_e[a], slot = red[512 + e] + tok_slot[a];
            tok_slot[a] = slot; list[(size_t)e * T + slot] = a;
        }
    }
}

__device__ __forceinline__ void moe_table(Frame& F, LAS int* rbs) {
    F.lane = lane_now(); F.tid = F.wave * 64 + F.lane;
    const unsigned* cnt = (const unsigned*)(F.ws + WS_CTL) + CW_CNT;
    if (F.wave == 0) {
        const int e = F.lane;
        int c = 0;
        if (e < NEXP) { c = (int)__hip_atomic_load(cnt + e, __ATOMIC_RELAXED, __HIP_MEMORY_SCOPE_AGENT); rbs[64 + e] = c; }
        asm volatile("s_waitcnt lgkmcnt(0)" ::: "memory");
        if (e < NEXP) {
            int a = 0;
            for (int j = 0; j < e; ++j) a += (rbs[64 + j] + 255) >> 8;
            const int nb = (c + 255) >> 8;
            rbs[e] = a;
            for (int q = 0; q < nb; ++q) rbs[128 + a + q] = e;
            if (e == NEXP - 1) rbs[32] = a + nb;
        }
    }
    __syncthreads();
}

__device__ __forceinline__ void p9_final(Frame& F, const LAS int* rbs, bool dummy) {
    F.lane = lane_now(); F.tid = F.wave * 64 + F.lane;
    const float* mod = (const float*)(F.ws + WS_MOD); const unsigned char* Y = F.ws + WS_Y;
    const float* X = F.x;
    const int* tok_e = (const int*)(F.ws + WS_ROUT); const int* tok_slot = (const int*)(F.ws + WS_ROUT + 512 * 1024);
    const int gw = launder_s(F.vcu * NWAVES + F.wave), NGW = F.G * NWAVES;
    f32x4 ng[4];
#pragma unroll
    for (int j = 0; j < 4; ++j) ng[j] = *(const f32x4*)(F.norm_final + 4 * F.lane + 256 * j);
    f32x4 xv[4], xn[4]; unsigned ya[4], yb[4], yan[4], ybn[4]; u32x2 da[4], dn[4];
    int e0n = 0, e1n = 0, s0n = 0, s1n = 0;
    if (gw < T) {
        const int p0 = rbs[tok_e[2 * gw]] * 256 + tok_slot[2 * gw], p1 = rbs[tok_e[2 * gw + 1]] * 256 + tok_slot[2 * gw + 1];
        const f32x4* xr = (const f32x4*)(X + (size_t)gw * D) + F.lane; const unsigned* y0 = (const unsigned*)(Y + (size_t)p0 * D) + F.lane; const unsigned* y1 = (const unsigned*)(Y + (size_t)p1 * D) + F.lane;
        const u32x2* dr = (const u32x2*)(F.ws + delta_off(gw)) + F.lane;
#pragma unroll
        for (int j = 0; j < 4; ++j) { xv[j] = xr[64 * j]; ya[j] = y0[64 * j]; yb[j] = y1[64 * j]; da[j] = dr[64 * j]; }
        if (gw + NGW < T) { const int tn = gw + NGW; e0n = tok_e[2 * tn]; e1n = tok_e[2 * tn + 1]; s0n = tok_slot[2 * tn]; s1n = tok_slot[2 * tn + 1]; }
    }
    for (int t = gw; t < T; t += NGW) {
        const int b = t >> 12;
        f32x4 g2[4];
#pragma unroll
        for (int j = 0; j < 4; ++j) g2[j] = *(const f32x4*)(mod + (size_t)b * 6144 + 5120 + 4 * F.lane + 256 * j);
        if (t + NGW < T) {
            const int tn = t + NGW, p0 = rbs[e0n] * 256 + s0n, p1 = rbs[e1n] * 256 + s1n;
            const f32x4* xr = (const f32x4*)(X + (size_t)tn * D) + F.lane; const unsigned* y0 = (const unsigned*)(Y + (size_t)p0 * D) + F.lane; const unsigned* y1 = (const unsigned*)(Y + (size_t)p1 * D) + F.lane;
            const u32x2* dr = (const u32x2*)(F.ws + delta_off(tn)) + F.lane;
#pragma unroll
            for (int j = 0; j < 4; ++j) { xn[j] = xr[64 * j]; yan[j] = y0[64 * j]; ybn[j] = y1[64 * j]; dn[j] = dr[64 * j]; }
            if (tn + NGW < T) { const int t2 = tn + NGW; e0n = tok_e[2 * t2]; e1n = tok_e[2 * t2 + 1]; s0n = tok_slot[2 * t2]; s1n = tok_slot[2 * t2 + 1]; }
        }
        f32x4 v[4]; float s = 0.f;
#pragma unroll
        for (int j = 0; j < 4; ++j) {
            const int a = (int)ya[j], c = (int)yb[j];
            const f32x2 a0 = __builtin_amdgcn_cvt_pk_f32_fp8(a, false), a1 = __builtin_amdgcn_cvt_pk_f32_fp8(a, true), c0 = __builtin_amdgcn_cvt_pk_f32_fp8(c, false), c1 = __builtin_amdgcn_cvt_pk_f32_fp8(c, true);
            f32x4 y; y.x = (a0.x + c0.x) * 0.0625f; y.y = (a0.y + c0.y) * 0.0625f; y.z = (a1.x + c1.x) * 0.0625f; y.w = (a1.y + c1.y) * 0.0625f;
            const u32x2 dd = da[j]; const f32x4 dl = {bf_lo(dd.x), bf_hi(dd.x), bf_lo(dd.y), bf_hi(dd.y)};
            v[j] = (xv[j] + dl) + g2[j] * y;
            s += (v[j].x * v[j].x + v[j].y * v[j].y) + (v[j].z * v[j].z + v[j].w * v[j].w);
        }
        const float rstd = 1.0f / sqrtf(wave_sum(s) * (1.0f / D) + EPS);
        f32x4* xo = dummy ? (f32x4*)((float*)(F.ws + WS_H2) + (size_t)t * D) + F.lane : (f32x4*)(F.out + (size_t)t * D) + F.lane;
#pragma unroll
        for (int j = 0; j < 4; ++j) __builtin_nontemporal_store(v[j] * rstd * ng[j], xo + 64 * j);
#pragma unroll
        for (int j = 0; j < 4; ++j) { xv[j] = xn[j]; ya[j] = yan[j]; yb[j] = ybn[j]; da[j] = dn[j]; }
    }
}

constexpr int MOE_MAXU = 8;
__device__ __forceinline__ void moe_unit_tables(Frame& F, const LAS int* rbs, int nunits, bool weights) {
    const int tid = tid_now(F.wave);
    const int* list = (const int*)(F.ws + WS_ROUT + 1024 * 1024); const float* tokw = (const float*)(F.ws + WS_ROUT + 256 * 1024);
    LAS unsigned short* tokl = (LAS unsigned short*)(F.lds + LDSCTL_OFF + 4096); LAS float* wl = (LAS float*)(F.lds + LDSCTL_OFF + 8192);
    int av[MOE_MAXU / 2]; bool live[MOE_MAXU / 2], inr[MOE_MAXU / 2];
#pragma unroll
    for (int q = 0; q < MOE_MAXU / 2; ++q) {
        const int j = 2 * q + (tid >> 8), r = tid & 255, L = j * F.G + F.vcu;
        live[q] = L < nunits; inr[q] = false; av[q] = 0;
        if (live[q]) {
            const int rbi = L >> 2, e = rbs[128 + rbi], sl = (rbi - rbs[e]) * 256 + r, ce = rbs[64 + e];
            inr[q] = sl < ce;
            av[q] = list[(size_t)e * T + (inr[q] ? sl : 0)];
        }
    }
    float wv[MOE_MAXU / 2];
#pragma unroll
    for (int q = 0; q < MOE_MAXU / 2; ++q) wv[q] = (weights && live[q] && inr[q]) ? tokw[av[q]] * 0.5f : 0.f;
#pragma unroll
    for (int q = 0; q < MOE_MAXU / 2; ++q) {
        const int j = 2 * q + (tid >> 8), r = tid & 255;
        if (live[q]) { if (weights) wl[j * 256 + r] = wv[q]; else tokl[j * 256 + r] = (unsigned short)(av[q] >> 1); }
    }
    __syncthreads();
}

constexpr int N_PHASES = 16;
template <unsigned PHM>
__global__ void __launch_bounds__(NTHR, 2) fwd(Args args) {
    extern __shared__ __attribute__((aligned(16))) unsigned char lds_raw[];
    Frame F;
    F.lds = (LAS unsigned char*)lds_raw;
    F.tid = threadIdx.x; F.lane = F.tid & 63; F.wave = __builtin_amdgcn_readfirstlane(F.tid >> 6);
    F.G = gridDim.x; { const int bx = blockIdx.x; F.vcu = (F.G % 8 == 0) ? (bx % 8) * (F.G / 8) + bx / 8 : bx; }
    F.x = (const float*)args.in[0]; F.c = (const float*)args.in[1]; F.positions = (const int*)args.in[2]; F.w_ada = (const float*)args.in[3]; F.b_ada = (const float*)args.in[4];
    F.norm_mix = (const float*)args.in[5]; F.w_in = (const float*)args.in[6]; F.w_ret_o = (const float*)args.in[7]; F.w_diff_o = (const float*)args.in[8];
    F.lq1 = (const float*)args.in[9]; F.lk1 = (const float*)args.in[10]; F.lq2 = (const float*)args.in[11]; F.lk2 = (const float*)args.in[12]; F.diff_norm = (const float*)args.in[13];
    F.w_out = (const float*)args.in[14]; F.norm_ffn = (const float*)args.in[15]; F.w_rg = (const float*)args.in[16]; F.b_rg = (const float*)args.in[17]; F.w_re = (const float*)args.in[18]; F.b_re = (const float*)args.in[19];
    F.w_eg = (const float*)args.in[20]; F.w_eu = (const float*)args.in[21]; F.w_ed = (const float*)args.in[22]; F.norm_final = (const float*)args.in[23];
    F.out = args.out; F.ws = args.ws;
    for (int u = F.tid; u < (LDS_BYTES - LDSCTL_OFF) / 4; u += NTHR) ((LAS unsigned*)(F.lds + LDSCTL_OFF))[u] = 0u;
    __syncthreads();
    const int lo = args.ph_lo, hi = args.ph_hi;
    const bool use_bar = (hi - lo) > 1;
    XcdBarrier bar; bar.bar = (unsigned*)(F.ws + WS_CTL) + CW_BAR; bar.x = 0; bar.st = (volatile LAS unsigned*)(F.lds + LDSCTL_OFF);
    if (use_bar) bar = xcd_barrier_post((unsigned*)(F.ws + WS_CTL) + CW_BAR, (volatile LAS unsigned*)(F.lds + LDSCTL_OFF));
    bar.wave = F.wave;
#ifndef PROBE_DUP
#define PROBE_DUP 0u
#endif
#ifndef PROBE_MODE
#define PROBE_MODE 0
#endif
#define NREP(ty) ((((PROBE_DUP) >> (ty)) & 1u) ? 2 : 1)
#define INP(ty, k) ((((PHM) >> (ty)) & 1u) && lo <= (k) && (k) < hi)
#define INPL(ty, k) ((((PHM) >> (ty)) & 1u) && launder_s(lo) <= (k) && (k) < launder_s(hi))
#define IN(k) (lo <= (k) && (k) < hi)
#define SEAM(k) do { if (IN(k) && IN((k) + 1)) xcd_barrier(bar); } while (0)
    LAS int* rbs = (LAS int*)(F.lds + LDSCTL_OFF + 1024);

    if (INP(0, 0)) { for (int rep = 0; rep < NREP(0); ++rep) p0_prologue(F); SEAM(0); }
    for (int hf = 0; hf < 2; ++hf) {
        const int pb = 1 + 5 * hf;
        if (INP(1, pb) && hf == 0) { for (int rep = 0; rep < NREP(1); ++rep) p1_norm_mod(F); SEAM(pb); }
        if (INP(2, pb + 1)) {
            pg8::StaticOrder S; S.init(hf ? (const void*)(F.out + (size_t)TH * D) : (const void*)(F.ws + WS_H), F.ws + WS_WIN, TH, DIN, D, F.G, (int)blockIdx.x);
            pg8::EpiProj E{(bf16_t*)(F.ws + WS_PROJ), (const float*)(F.ws + WS_COS) + (size_t)hf * TH * 64, (const float*)(F.ws + WS_SIN) + (size_t)hf * TH * 64, 0};
            for (int rep = 0; rep < NREP(2); ++rep) { E.pmode = (rep + 1 < NREP(2)) ? PROBE_MODE : 0; pg8::gemm_phase<pg8::EpiProj, pg8::StaticOrder, true, false>(F.lds, F.wave, D, S, E); }
            SEAM(pb + 1);
        }
        if (INP(3, pb + 2)) { for (int rep = 0; rep < NREP(3); ++rep) p3_mix(F, hf + 2 * rep); SEAM(pb + 2); }
        if (INP(4, pb + 3)) {
            pg8::StaticOrder S; S.init(F.ws + WS_ACT, F.ws + WS_WMIX, TH, D, 2048, F.G, (int)blockIdx.x);
            LAS float* rst = (LAS float*)(F.lds + LDSCTL_OFF + 8192);
            for (int ui = 0; ; ++ui) {
                pg8::Unit u0; if (!S.next(ui, u0)) break;
                const int tl = tid_now(F.wave);
                { const float* sq = (const float*)(F.ws + WS_SSQ);
                  if (tl < 256) { float r[4];
#pragma unroll
                    for (int hd = 0; hd < 4; ++hd) { const f32x4* p = (const f32x4*)(sq + ((size_t)(u0.pm * 256 + tl) * 4 + hd) * 8); const f32x4 a = p[0], b = p[1];
                        r[hd] = 1.0f / sqrtf((((a.x + a.y) + (a.z + a.w)) + ((b.x + b.y) + (b.z + b.w))) * (1.0f / 256.0f) + EPS); }
                    rst[tl] = r[0] / r[1]; rst[256 + tl] = r[1] / r[2]; rst[512 + tl] = r[2] / r[3]; rst[768 + tl] = r[3]; } }
                __syncthreads();
                pg8::EpiMerged E{(const bf16_t*)(F.ws + WS_PROJ), (bf16_t*)(F.ws + WS_H), (const LAS float*)rst};
                pg8::OneUnit<pg8::StaticOrder> S1{S, ui};
                for (int rep = 0; rep < NREP(4); ++rep) pg8::gemm_phase<pg8::EpiMerged, pg8::OneUnit<pg8::StaticOrder>, false, false>(F.lds, F.wave, 2048, S1, E);
                __syncthreads();
            }
            SEAM(pb + 3);
        }
        if (INP(5, pb + 4)) {
            pg8::StaticOrder S; S.init(F.ws + WS_H, F.ws + WS_WOUT, TH, D, D, F.G, (int)blockIdx.x);
            pg8::EpiWout E{F.ws, (const float*)(F.ws + WS_MOD), hf * TH};
            for (int rep = 0; rep < NREP(5); ++rep) pg8::gemm_phase<pg8::EpiWout, pg8::StaticOrder, false, false>(F.lds, F.wave, D, S, E);
            if (hf == 1) SEAM(pb + 4);
        }
    }
    if (INPL(6, 11)) { for (int rep = 0; rep < NREP(6); ++rep) p6_router(F, rep + 1 < NREP(6)); SEAM(11); }
    if (INPL(10, 12)) { convert_experts(F); p6b_lists(F); SEAM(12); }
    if (INPL(7, 13)) {
        moe_table(F, rbs);
        const int nunits = __builtin_amdgcn_readfirstlane(rbs[32]) * 4;
        moe_unit_tables(F, rbs, nunits, false);
        pg8::MoeOrder S{F.G, F.vcu, 512, nunits, 1, rbs, (const LAS unsigned short*)(F.lds + LDSCTL_OFF + 4096), (const char*)(F.ws + WS_H2), (const char*)(F.ws + WS_WGU), (size_t)1024 * 1024};
        pg8::EpiGU E{F.ws + WS_EACT};
        for (int rep = 0; rep < NREP(7); ++rep) pg8::gemm_phase<pg8::EpiGU, pg8::MoeOrder, true, true, true>(F.lds, F.wave, launder_s(512), S, E);
        SEAM(13);
    }
    if (INPL(8, 14)) {
        moe_table(F, rbs);
        const int nunits = __builtin_amdgcn_readfirstlane(rbs[32]) * 4;
        moe_unit_tables(F, rbs, nunits, true);
        pg8::MoeOrder S{F.G, F.vcu, 256, nunits, 0, rbs, (const LAS unsigned short*)(F.lds + LDSCTL_OFF + 4096), (const char*)(F.ws + WS_EACT), (const char*)(F.ws + WS_WDN), (size_t)1024 * 512};
        pg8::EpiDown E{F.ws + WS_Y, (const LAS float*)(F.lds + LDSCTL_OFF + 8192)};
        for (int rep = 0; rep < NREP(8); ++rep) pg8::gemm_phase<pg8::EpiDown, pg8::MoeOrder, true, false, true>(F.lds, F.wave, launder_s(256), S, E);
        SEAM(14);
    }
    if (INPL(9, 15)) { moe_table(F, rbs); for (int rep = 0; rep < NREP(9); ++rep) p9_final(F, rbs, rep + 1 < NREP(9)); }
#undef IN
#undef INP
#undef INPL
#undef SEAM
}

#ifndef MK_ONE_LAUNCH
#define MK_ONE_LAUNCH 1
#endif
#if !MK_ONE_LAUNCH
typedef void (*KernFn)(Args);
static KernFn phase_kernel(int p) {
    const int ty = (p == 0) ? 0 : (p <= 10) ? 1 + (p - 1) % 5 : (p == 11) ? 6 : (p == 12) ? 10 : p - 6;
    switch (ty) {
        case 0: return fwd<1u << 0>; case 1: return fwd<1u << 1>; case 2: return fwd<1u << 2>; case 3: return fwd<1u << 3>; case 4: return fwd<1u << 4>;
        case 5: return fwd<1u << 5>; case 6: return fwd<1u << 6>; case 7: return fwd<1u << 7>; case 8: return fwd<1u << 8>; case 9: return fwd<1u << 9>; default: return fwd<1u << 10>;
    }
}
#endif
extern "C" void kernel_launch(void* const* d_in, const int* in_sizes, int n_in, void* d_out, int out_size, void* d_ws, size_t ws_size, hipStream_t stream) {
    static int grid = 0;
    if (grid == 0) {
        if (n_in != 24 || out_size != T * D || ws_size < WS_END) { fprintf(stderr, "kernel_launch: unexpected problem (n_in %d, out %d, ws %zu < %zu); nothing launched\n", n_in, out_size, ws_size, (size_t)WS_END); grid = -1; return; }
        int dev = 0, cus = 0;
        if (hipGetDevice(&dev) != hipSuccess || hipDeviceGetAttribute(&cus, hipDeviceAttributeMultiprocessorCount, dev) != hipSuccess) { grid = -1; return; }
#if MK_ONE_LAUNCH
        if (hipFuncSetAttribute((const void*)fwd<0x7FFu>, hipFuncAttributeMaxDynamicSharedMemorySize, LDS_BYTES) != hipSuccess) { grid = -1; return; }
#else
        for (int p = 0; p < N_PHASES; ++p)
            if (hipFuncSetAttribute((const void*)phase_kernel(p), hipFuncAttributeMaxDynamicSharedMemorySize, LDS_BYTES) != hipSuccess) { fprintf(stderr, "kernel_launch: hipFuncSetAttribute failed\n"); grid = -1; return; }
#endif
        (void)hipGetLastError();
        grid = cus;
    }
    if (grid < 0) return;
    (void)hipMemsetAsync((char*)d_ws + WS_CTL, 0, CTL_ZERO_BYTES, stream);
    Args a{};
    for (int i = 0; i < 24; ++i) a.in[i] = d_in[i];
    a.out = (float*)d_out; a.ws = (unsigned char*)d_ws;
#if MK_ONE_LAUNCH
    a.ph_lo = 0; a.ph_hi = N_PHASES;
    hipLaunchKernelGGL(fwd<0x7FFu>, dim3(grid), dim3(NTHR), LDS_BYTES, stream, a);
#else
    for (int p = 0; p < N_PHASES; ++p) { a.ph_lo = p; a.ph_hi = p + 1; hipLaunchKernelGGL(phase_kernel(p), dim3(grid), dim3(NTHR), LDS_BYTES, stream, a); }
#endif
}
```

```cpp
#include <hip/hip_runtime.h>
#include <cstdio>
#include <cstdint>

#define GAS __attribute__((address_space(1)))
#define LAS __attribute__((address_space(3)))
typedef unsigned short bf16_t;
typedef short bf16x8 __attribute__((ext_vector_type(8)));
typedef short s16x4 __attribute__((ext_vector_type(4)));
typedef float f32x4 __attribute__((ext_vector_type(4)));
typedef float f32x2 __attribute__((ext_vector_type(2)));
typedef float f32x16 __attribute__((ext_vector_type(16)));
typedef unsigned u32x4 __attribute__((ext_vector_type(4)));
typedef unsigned u32x2 __attribute__((ext_vector_type(2)));

constexpr int T = 32768, D = 1024, SEQ = 4096, NB = 8, DIN = 8192, TH = 16384, NWAVES = 8, NTHR = 512;
constexpr int NEXP = 32, DEXP = 512;
constexpr float EPS = 1e-6f;
constexpr int PROW_MAX = 65536 + NEXP * 256;

constexpr size_t MiB = 1u << 20;
constexpr size_t WS_CTL = 0, CTL_ZERO_BYTES = 64 * 1024;
constexpr size_t WS_MOD = 1 * MiB;
constexpr size_t WS_COS = 2 * MiB, WS_SIN = 10 * MiB;
constexpr size_t WS_WIN = 18 * MiB;
constexpr size_t WS_WMIX = 34 * MiB;
constexpr size_t WS_WOUT = 38 * MiB;
constexpr size_t WS_WGU = 40 * MiB;
constexpr size_t WS_WDN = 104 * MiB;
constexpr size_t WS_H = 136 * MiB;
constexpr size_t WS_ACT = 168 * MiB;
constexpr size_t WS_PROJ = 232 * MiB;
constexpr size_t WS_H2 = 168 * MiB;
constexpr size_t WS_EACT = 232 * MiB;
constexpr size_t WS_Y = 304 * MiB;
constexpr size_t WS_ROUT = 488 * MiB;
constexpr size_t WS_SSQ = 494 * MiB;
constexpr size_t WS_DELTA_A = 72 * MiB, WS_DELTA_B = 120 * MiB, WS_DELTA_C = 496 * MiB;
constexpr size_t WS_WLIST = WS_WIN;
constexpr size_t WS_END = 512 * MiB;
constexpr int CW_BAR = 0;
constexpr int CW_CNT = 4096;
constexpr int CW_Q = 4224;

constexpr int RING_BYTES = 131072;
constexpr int LDSCTL_OFF = RING_BYTES;
constexpr int LDS_BYTES = 147456;

__device__ __forceinline__ unsigned cvt_pk_bf16(float lo, float hi) { unsigned r; asm("v_cvt_pk_bf16_f32 %0, %1, %2" : "=v"(r) : "v"(lo), "v"(hi)); return r; }
__device__ __forceinline__ unsigned pk4_fp8(float a, float b, float c, float d) {
    a = __builtin_amdgcn_fmed3f(a, -448.f, 448.f); b = __builtin_amdgcn_fmed3f(b, -448.f, 448.f); c = __builtin_amdgcn_fmed3f(c, -448.f, 448.f); d = __builtin_amdgcn_fmed3f(d, -448.f, 448.f);
    int w = __builtin_amdgcn_cvt_pk_fp8_f32(a, b, 0, false); w = __builtin_amdgcn_cvt_pk_fp8_f32(c, d, w, true); return (unsigned)w;
}
__device__ __forceinline__ float bf_lo(unsigned w) { return __uint_as_float(w << 16); }
__device__ __forceinline__ float bf_hi(unsigned w) { return __uint_as_float(w & 0xffff0000u); }
__device__ __forceinline__ float xor32_sum(float v) { const unsigned u = __builtin_bit_cast(unsigned, v); const auto r = __builtin_amdgcn_permlane32_swap(u, u, false, false);
    return __builtin_bit_cast(float, (unsigned)r[0]) + __builtin_bit_cast(float, (unsigned)r[1]); }
__device__ __forceinline__ float xor32_max(float v) { const unsigned u = __builtin_bit_cast(unsigned, v); const auto r = __builtin_amdgcn_permlane32_swap(u, u, false, false);
    return fmaxf(__builtin_bit_cast(float, (unsigned)r[0]), __builtin_bit_cast(float, (unsigned)r[1])); }
template <int O> __device__ __forceinline__ float swz_xor(float v) { return __builtin_bit_cast(float, __builtin_amdgcn_ds_swizzle(__builtin_bit_cast(int, v), 0x1F | (O << 10))); }
__device__ __forceinline__ float wave_sum(float v) { v += swz_xor<1>(v); v += swz_xor<2>(v); v += swz_xor<4>(v); v += swz_xor<8>(v); v += swz_xor<16>(v); return xor32_sum(v); }
__device__ __forceinline__ size_t delta_off(int t) { return (t < 16384) ? WS_DELTA_A + (size_t)t * 2048 : (t < 24576) ? WS_DELTA_B + (size_t)(t - 16384) * 2048 : WS_DELTA_C + (size_t)(t - 24576) * 2048; }
__device__ __forceinline__ float fast_sigmoid(float v) { return __builtin_amdgcn_rcpf(1.0f + __builtin_amdgcn_exp2f(-1.4426950408889634f * v)); }
__device__ __forceinline__ int launder_i(int v) { asm volatile("" : "+v"(v)); return v; }
__device__ __forceinline__ int launder_s(int v) { asm volatile("" : "+s"(v)); return v; }
__device__ __forceinline__ int lane_now() { int l; asm volatile("v_mbcnt_lo_u32_b32 %0, -1, 0\n\tv_mbcnt_hi_u32_b32 %0, -1, %0" : "=v"(l)); return l; }
__device__ __forceinline__ int tid_now(int wave) { return wave * 64 + lane_now(); }
#define LDS_WAIT() asm volatile("s_waitcnt lgkmcnt(0)" ::: "memory")
#define VM_WAIT() asm volatile("s_waitcnt vmcnt(0)" ::: "memory")

#define XB_TMO      128
#define XB_XCNT(j)  (256  + 64 * (j))
#define XB_XSUB(j)  (1280 + 64 * (j))
#define XB_XGEN(j)  (2304 + 64 * (j))
#define XB_TOP      3328
#define XB_TOPGEN   3392
#define XCD_BAR_WORDS 3456
#define XB_SPIN_CAP (1u << 18)
__device__ __forceinline__ unsigned xb_ld(unsigned* p)              { return __hip_atomic_load(p, __ATOMIC_RELAXED, __HIP_MEMORY_SCOPE_AGENT); }
__device__ __forceinline__ unsigned xb_add(unsigned* p, unsigned v) { return __hip_atomic_fetch_add(p, v, __ATOMIC_RELAXED, __HIP_MEMORY_SCOPE_AGENT); }
__device__ __forceinline__ unsigned xb_xcc_id() { return (unsigned)__builtin_amdgcn_s_getreg((3 << 11) | 20) & 0xFu; }
#define XB_SPIN(cond, bar) do { unsigned _sp = 0; while (cond) { __builtin_amdgcn_s_sleep(1); \
    if ((++_sp & 255u) == 0u) { if (xb_ld(&(bar)[XB_TMO])) break; if (_sp > XB_SPIN_CAP) { atomicAdd(&(bar)[XB_TMO], 1u); break; } } } } while (0)
struct XcdBarrier { unsigned* bar; unsigned x; volatile LAS unsigned* st; int wave; };
__device__ __forceinline__ XcdBarrier xcd_barrier_post(unsigned* bar, volatile LAS unsigned* st) {
    XcdBarrier b; b.bar = bar; b.x = xb_xcc_id(); b.st = st; b.wave = 0;
    if (threadIdx.x == 0) (void)xb_add(&bar[XB_XCNT(b.x)], 1u);
    return b;
}
__device__ __forceinline__ void xcd_barrier_complete(unsigned* bar, unsigned x, unsigned& nloc, unsigned& nx) {
    const unsigned G = gridDim.x * gridDim.y * gridDim.z;
    unsigned sum, cnt, mine, sp = 0u;
    for (;;) {
        sum = 0u; cnt = 0u; mine = 0u;
#pragma unroll
        for (unsigned j = 0; j < 16; ++j) { const unsigned c = xb_ld(&bar[XB_XCNT(j)]); sum += c; cnt += (c > 0u) ? 1u : 0u; mine = (j == x) ? c : mine; }
        if (sum == G) break;
        __builtin_amdgcn_s_sleep(1);
        if ((++sp & 255u) == 0u) { if (xb_ld(&bar[XB_TMO])) break; if (sp > XB_SPIN_CAP) { atomicAdd(&bar[XB_TMO], 1u); break; } }
    }
    nloc = mine > 0u ? mine : 1u; nx = cnt > 0u ? cnt : 1u;
}
__device__ __forceinline__ void xcd_barrier(const XcdBarrier& b) {
    asm volatile("s_waitcnt vmcnt(0)" ::: "memory");
    __syncthreads();
    if (b.wave == 0 && lane_now() == 0) {
        unsigned* bar = b.bar;
        __builtin_amdgcn_s_waitcnt(0);
        unsigned nloc = b.st[0], nx = b.st[1];
        if (nloc == 0u) { xcd_barrier_complete(bar, b.x, nloc, nx); b.st[0] = nloc; b.st[1] = nx; }
        const unsigned old = xb_add(&bar[XB_XSUB(b.x)], 1u);
        const unsigned gen = old / nloc;
        if (old + 1u == (gen + 1u) * nloc) {
            __builtin_amdgcn_fence(__ATOMIC_RELEASE, "agent");
            asm volatile("s_waitcnt vmcnt(0)" ::: "memory");
            const unsigned og = xb_add(&bar[XB_TOP], 1u);
            asm volatile("buffer_inv sc1" ::: "memory");
            const unsigned tgt = (og / nx + 1u) * nx;
            asm volatile("s_waitcnt vmcnt(0)" ::: "memory");
            if (og + 1u != tgt) XB_SPIN(xb_ld(&bar[XB_TOP]) < tgt, bar);
            xb_add(&bar[XB_XGEN(b.x)], 1u);
        } else {
            asm volatile("buffer_inv sc0" ::: "memory");
            XB_SPIN(xb_ld(&bar[XB_XGEN(b.x)]) == gen, bar);
            asm volatile("s_waitcnt vmcnt(0)" ::: "memory");
        }
    }
    __syncthreads();
}

namespace pg8 {
constexpr int BM = 256, BK = 64, HALF = 128, HTB = HALF * BK * 2, STAGE_BYTES = 8 * HTB, NXCD = 8, WGM = 8;
__host__ __device__ __forceinline__ int lds_byte(int r, int c) { const int st = (r >> 4) * 2 + (c >> 5), rr = r & 15, cc = c & 31, ob = rr * 64 + cc * 2; return st * 1024 + (ob ^ (((ob >> 9) & 1) << 5)); }
__host__ __device__ __forceinline__ void stage_rc(int b, int& R, int& C) { const int st = b / 1024, sb = b % 1024, swz = sb ^ (((sb >> 9) & 1) << 5); R = (st >> 1) * 16 + swz / 64; C = (st & 1) * 32 + (swz % 64) / 2; }
__host__ __device__ __forceinline__ int perm32(int rho) { const int n = rho >> 4, i = rho & 15; return 8 * (i >> 2) + 4 * n + (i & 3); }

struct Unit { int pm, pn, e, rb, idx; const char* A; const char* B; };

struct StaticOrder {
    int nM, nN, nwg, G, c, K; const char* A; const char* Bt;
    __device__ __forceinline__ void init(const void* A_, const void* Bt_, int M, int N, int K_, int G_, int c_) { A = (const char*)A_; Bt = (const char*)Bt_; K = K_; nM = M / BM; nN = N / BM; nwg = nM * nN; G = G_; c = c_; }
    __device__ __forceinline__ bool next(int i, Unit& u) const {
        const int L = i * G + c; if (L >= nwg) return false;
        int wgid = L; { const int q = nwg / NXCD, r = nwg % NXCD, xcd = wgid % NXCD, off = wgid / NXCD; wgid = (xcd < r ? xcd * (q + 1) : r * (q + 1) + (xcd - r) * q) + off; }
        const int nig = WGM * nN, gid = wgid / nig, fm = gid * WGM, gsz = (nM - fm) < WGM ? (nM - fm) : WGM;
        u.pm = fm + ((wgid % nig) % gsz); u.pn = (wgid % nig) / gsz; u.e = 0; u.rb = 0; u.idx = i;
        u.A = A + (size_t)u.pm * BM * K * 2; u.B = Bt + (size_t)u.pn * BM * K * 2; return true;
    }
    __device__ __forceinline__ int tok(const Unit&, int) const { return 0; }
};
template <class Sched> struct OneUnit {
    const Sched& S; int i;
    __device__ __forceinline__ bool next(int j, Unit& u) const { return j == 0 ? S.next(i, u) : false; }
    __device__ __forceinline__ int tok(const Unit& u, int r) const { return S.tok(u, r); }
};
struct MoeOrder {
    int G, vcu, K, nunits, gather; const LAS int* rbs; const LAS unsigned short* tokl; const char* A; const char* Bt; size_t bstride;
    __device__ __forceinline__ bool next(int i, Unit& u) const {
        const int L = i * G + vcu; if (L >= nunits) return false;
        const int rbi = L >> 2; const int e = __builtin_amdgcn_readfirstlane(rbs[128 + rbi]);
        u.pm = rbi; u.pn = L & 3; u.e = e; u.rb = rbi - __builtin_amdgcn_readfirstlane(rbs[e]); u.idx = i;
        u.A = gather ? A : A + (size_t)rbi * BM * K * 2; u.B = Bt + (size_t)e * bstride + (size_t)u.pn * BM * K * 2; return true;
    }
    __device__ __forceinline__ int tok(const Unit& u, int r) const { return (int)tokl[u.idx * 256 + r]; }
};

typedef f32x4 Acc[2][2][4][2];
typedef int v8i32 __attribute__((ext_vector_type(8)));
__device__ __forceinline__ v8i32 cat8(const bf16x8& a, const bf16x8& b) { const u32x4 x = __builtin_bit_cast(u32x4, a), y = __builtin_bit_cast(u32x4, b); return (v8i32){(int)x.x, (int)x.y, (int)x.z, (int)x.w, (int)y.x, (int)y.y, (int)y.z, (int)y.w}; }

template <class Epi, class Sched, bool ALIGN_EPI, bool GATHER, bool F8 = false>
__device__ __forceinline__ void gemm_phase(LAS unsigned char* lds, const int wid, const int K, const Sched& S, const Epi& E) {
    const int lane = lane_now(), tid = wid * 64 + lane, wr = wid >> 2, wc = wid & 3, fr = lane & 15, fq = lane >> 4;
    const int nt = K / BK;
    unsigned voffA[2], voffB[2];
#pragma unroll
    for (int i = 0; i < 2; ++i) { int R, C; stage_rc(tid * 16 + i * 8192, R, C); const int Rb = (R & ~31) + perm32(R & 31);
        voffA[i] = GATHER ? (unsigned)(C * 2) : (unsigned)(R * K + C) * 2u; voffB[i] = (unsigned)(Rb * K + C) * 2u; }
    unsigned gAc[2] = {0u, 0u};
    const unsigned K2 = (unsigned)(K * 2);
    const size_t kstep = (size_t)(BK * 2);
    const size_t hstep = (size_t)HALF * K * 2;
    const unsigned ldsw = (unsigned)wid * 1024u;
    const int aoff = lds_byte(wr * 64 + fr, fq * 8), boff = lds_byte(wc * 32 + fr, fq * 8);
    const LAS unsigned char* ldsB = lds + 4 * HTB + boff; asm volatile("" : "+v"(ldsB));
#define PG8_SA(b, h) (((b) * 2 + (h)) * HTB)
#define PG8_SB(b, h) ((4 + (b) * 2 + (h)) * HTB)
#define PG8_STAGEB(bufoff, gbase) do { _Pragma("unroll") for (int _i = 0; _i < 2; ++_i) { asm volatile("" : "+v"(voffB[_i])); \
        __builtin_amdgcn_global_load_lds((const unsigned*)((const char*)(gbase) + voffB[_i]), (LAS unsigned*)(lds + (bufoff) + ldsw + _i * 8192), 16, 0, 0); } } while (0)
#define PG8_STAGEA(bufoff, gbase, h, nx) do { _Pragma("unroll") for (int _i = 0; _i < 2; ++_i) { \
        unsigned _o; if constexpr (GATHER) { unsigned _pk = gAc[h]; asm volatile("" : "+v"(_pk)); _o = __umul24((_pk >> (16 * _i)) & 0xffffu, K2) + voffA[0]; } else { asm volatile("" : "+v"(voffA[_i])); _o = voffA[_i]; } \
        const char* _p = GATHER ? (const char*)(gbase) + _o : (const char*)(gbase) + (h) * hstep + _o; \
        __builtin_amdgcn_global_load_lds((const unsigned*)_p, (LAS unsigned*)(lds + (bufoff) + ldsw + _i * 8192), 16, 0, 0); } } while (0)
#define PG8_LDA(dst, b, h) do { _Pragma("unroll") for (int m = 0; m < 4; ++m) { \
        if constexpr (F8) { const u32x4 x_ = *(const LAS u32x4*)(lds + PG8_SA(b, h) + aoff + m * 2048), y_ = *(const LAS u32x4*)(lds + PG8_SA(b, h) + aoff + m * 2048 + 1024); \
            dst##8[m] = (v8i32){(int)x_.x, (int)x_.y, (int)x_.z, (int)x_.w, (int)y_.x, (int)y_.y, (int)y_.z, (int)y_.w}; } \
        else { _Pragma("unroll") for (int k = 0; k < 2; ++k) dst[m][k] = *(const LAS bf16x8*)(lds + PG8_SA(b, h) + aoff + m * 2048 + k * 1024); } } } while (0)
#define PG8_LDB(dst, b, h) do { _Pragma("unroll") for (int n = 0; n < 2; ++n) { \
        if constexpr (F8) { const u32x4 x_ = *(const LAS u32x4*)(ldsB + (PG8_SB(b, h) - 4 * HTB) + n * 2048), y_ = *(const LAS u32x4*)(ldsB + (PG8_SB(b, h) - 4 * HTB) + n * 2048 + 1024); \
            dst##8[n] = (v8i32){(int)x_.x, (int)x_.y, (int)x_.z, (int)x_.w, (int)y_.x, (int)y_.y, (int)y_.z, (int)y_.w}; } \
        else { _Pragma("unroll") for (int k = 0; k < 2; ++k) dst[n][k] = *(const LAS bf16x8*)(ldsB + (PG8_SB(b, h) - 4 * HTB) + n * 2048 + k * 1024); } } } while (0)
#define PG8_MMA(ai, bj, At, Bt) do { __builtin_amdgcn_s_setprio(1); \
        if constexpr (F8) { _Pragma("unroll") for (int m = 0; m < 4; ++m) _Pragma("unroll") for (int n = 0; n < 2; ++n) \
            acc[ai][bj][m][n] = __builtin_amdgcn_mfma_scale_f32_16x16x128_f8f6f4(Bt##8[n], At##8[m], acc[ai][bj][m][n], 0, 0, 0, 0x7F7F7F7F, 0, 0x7F7F7F7F); } \
        else { _Pragma("unroll") for (int m = 0; m < 4; ++m) _Pragma("unroll") for (int n = 0; n < 2; ++n) _Pragma("unroll") for (int k = 0; k < 2; ++k) \
            acc[ai][bj][m][n] = __builtin_amdgcn_mfma_f32_16x16x32_bf16(Bt[n][k], At[m][k], acc[ai][bj][m][n], 0, 0, 0); } __builtin_amdgcn_s_setprio(0); } while (0)
#define PG8_WAIT_V(n) asm volatile("s_waitcnt vmcnt(" #n ")" ::: "memory")
#define PG8_WAIT_L(n) asm volatile("s_waitcnt lgkmcnt(" #n ")" ::: "memory")
#define PG8_BAR __builtin_amdgcn_s_barrier()
#define PG8_SCHED __builtin_amdgcn_sched_barrier(0)
    Unit cur, nxt; int ui = 0;
    if (!S.next(0, cur)) return;
    if constexpr (GATHER) {
        int R0, C0; stage_rc(tid * 16, R0, C0);
#pragma unroll
        for (int h = 0; h < 2; ++h) gAc[h] = (unsigned)S.tok(cur, h * HALF + R0) | ((unsigned)S.tok(cur, h * HALF + R0 + 64) << 16);
    }
    Acc acc;
#pragma unroll
    for (int a = 0; a < 2; ++a)
#pragma unroll
        for (int b = 0; b < 2; ++b)
#pragma unroll
            for (int m = 0; m < 4; ++m)
#pragma unroll
                for (int n = 0; n < 2; ++n) acc[a][b][m][n] = (f32x4){0.f, 0.f, 0.f, 0.f};
    bf16x8 At[4][2], B0[2][2], B1[2][2]; v8i32 At8[4], B08[2], B18[2];
    const char* cA = cur.A; const char* cB = cur.B;
    PG8_STAGEB(PG8_SB(0, 0), cB); PG8_STAGEB(PG8_SB(0, 1), cB + hstep); PG8_STAGEA(PG8_SA(0, 0), cA, 0, false); PG8_STAGEA(PG8_SA(0, 1), cA, 1, false);
    if (wr == 1) PG8_BAR;
    PG8_WAIT_V(2); PG8_BAR;
    PG8_STAGEB(PG8_SB(1, 0), cB + kstep); PG8_STAGEA(PG8_SA(1, 0), cA + kstep, 0, false); PG8_STAGEB(PG8_SB(1, 1), cB + hstep + kstep);
    PG8_WAIT_V(6); PG8_BAR;
    for (;;) {
        const bool has_next = S.next(ui + 1, nxt);
        const char* nA = has_next ? nxt.A : cA; const char* nB = has_next ? nxt.B : cB;
        for (int t = 0; t < nt; t += 2) {
            const bool last = (t == nt - 2);
            if constexpr (Epi::MID) { if (E.mid_at(t)) { const int l_ = lane_now(); E.mid(acc, cur, t, wr, wc, l_ & 15, l_ >> 4); } }
            const char* a1 = cA + (size_t)(t + 1) * kstep;
            const char* a2 = last ? nA : cA + (size_t)(t + 2) * kstep; const char* b2 = last ? nB : cB + (size_t)(t + 2) * kstep;
            const char* a3 = a2 + kstep; const char* b3 = b2 + kstep;
            PG8_LDB(B0, 0, 0); PG8_LDB(B1, 0, 1); PG8_SCHED; PG8_LDA(At, 0, 0); PG8_STAGEA(PG8_SA(1, 1), a1, 1, false);
            if constexpr (GATHER) { if (last && has_next) {
                int R0, C0; stage_rc((wid * 64 + lane_now()) * 16, R0, C0);
#pragma unroll
                for (int h = 0; h < 2; ++h) gAc[h] = (unsigned)S.tok(nxt, h * HALF + R0) | ((unsigned)S.tok(nxt, h * HALF + R0 + 64) << 16); } }
            PG8_WAIT_V(8); PG8_WAIT_L(0); PG8_BAR; PG8_MMA(0, 0, At, B0); PG8_MMA(0, 1, At, B1); PG8_BAR; PG8_SCHED;
            PG8_LDA(At, 0, 1); PG8_STAGEB(PG8_SB(0, 0), b2); PG8_STAGEB(PG8_SB(0, 1), b2 + hstep); PG8_STAGEA(PG8_SA(0, 0), a2, 0, last);
            PG8_WAIT_V(8); PG8_WAIT_L(0); PG8_BAR; PG8_MMA(1, 0, At, B0); PG8_MMA(1, 1, At, B1); PG8_BAR; PG8_SCHED;
            PG8_LDB(B0, 1, 0); PG8_LDB(B1, 1, 1); PG8_SCHED; PG8_LDA(At, 1, 0); PG8_STAGEA(PG8_SA(0, 1), a2, 1, last);
            PG8_WAIT_V(8); PG8_WAIT_L(0); PG8_BAR; PG8_MMA(0, 0, At, B0); PG8_MMA(0, 1, At, B1); PG8_BAR; PG8_SCHED;
            PG8_LDA(At, 1, 1); PG8_STAGEB(PG8_SB(1, 0), b3); PG8_STAGEB(PG8_SB(1, 1), b3 + hstep); PG8_STAGEA(PG8_SA(1, 0), a3, 0, last);
            PG8_WAIT_V(8); PG8_WAIT_L(0); PG8_BAR; PG8_MMA(1, 0, At, B0); PG8_MMA(1, 1, At, B1); PG8_BAR; PG8_SCHED;
        }
        if constexpr (ALIGN_EPI) { if (wr == 0) PG8_BAR; }
        { const int l_ = lane_now(); E(acc, cur, wr, wc, l_ & 15, l_ >> 4); }
        if (!has_next) break;
#pragma unroll
        for (int a = 0; a < 2; ++a)
#pragma unroll
            for (int b = 0; b < 2; ++b)
#pragma unroll
                for (int m = 0; m < 4; ++m)
#pragma unroll
                    for (int n = 0; n < 2; ++n) acc[a][b][m][n] = (f32x4){0.f, 0.f, 0.f, 0.f};
        cur = nxt; cA = nA; cB = nB; ++ui;
        if constexpr (ALIGN_EPI) { if (wr == 1) PG8_BAR; }
    }
    PG8_WAIT_V(0);
    if constexpr (!ALIGN_EPI) { if (wr == 0) PG8_BAR; }
    PG8_BAR;
#undef PG8_SA
#undef PG8_SB
#undef PG8_STAGEA
#undef PG8_STAGEB
#undef PG8_LDA
#undef PG8_LDB
#undef PG8_MMA
#undef PG8_WAIT_V
#undef PG8_WAIT_L
#undef PG8_BAR
#undef PG8_SCHED
}

__device__ __forceinline__ void store8(bf16_t* p, const f32x4& v0, const f32x4& v1) {
    u32x4 w; w.x = cvt_pk_bf16(v0[0], v0[1]); w.y = cvt_pk_bf16(v0[2], v0[3]); w.z = cvt_pk_bf16(v1[0], v1[1]); w.w = cvt_pk_bf16(v1[2], v1[3]);
    *(u32x4*)p = w;
}
struct EpiProj {
    static constexpr bool MID = false;
    bf16_t* O; const float* cosT; const float* sinT; int pmode;
    __device__ __forceinline__ bool mid_at(int) const { return false; }
    __device__ __forceinline__ void mid(Acc&, const Unit&, int, int, int, int, int) const {}
    __device__ __forceinline__ void operator()(Acc& acc, const Unit& u, int wr, int wc, int fr, int fq) const {
        if (pmode == 3) return;
        const int pn = u.pn; fr = launder_i(fr); fq = launder_i(fq);
        const int mode = (pn < 4) ? 1 : (pn < 8) ? 0 : (pn < 12) ? 2 : (pn < 20) ? 1 : (pn < 24) ? 0 : 3;
        const int row0 = u.pm * BM + wr * 64 + fr, col0 = pn * BM + wc * 32 + 8 * fq;
        if (mode == 1) {
            const int q4 = 4 * (4 * wc + fq);
            f32x4 cs[2][4], sn[2][4];
#pragma unroll
            for (int ai = 0; ai < 2; ++ai)
#pragma unroll
                for (int m = 0; m < 4; ++m) { const size_t ro = (size_t)(row0 + ai * HALF + m * 16) * 64 + q4; cs[ai][m] = *(const f32x4*)(cosT + ro); sn[ai][m] = *(const f32x4*)(sinT + ro); }
            asm volatile("" ::: "memory");
#pragma unroll
            for (int ai = 0; ai < 2; ++ai)
#pragma unroll
                for (int m = 0; m < 4; ++m) {
                    bf16_t* rowp = O + (size_t)(row0 + ai * HALF + m * 16) * DIN + col0;
                    const int ic = (wr * 64 + m * 16 + fr) & 127;
#pragma unroll
                    for (int bj = 0; bj < 2; ++bj) {
                        float f = 1.f;
                        if (pn < 4) { const int hd = (2 * pn + bj) & 3; const float lg = __builtin_amdgcn_logf(1.0f - __builtin_amdgcn_exp2f(-5.0f - (float)hd));
                            f = __builtin_amdgcn_exp2f(lg * (pn < 2 ? (float)(ic + 1) : (float)(127 - ic))); }
                        const f32x4 t1 = acc[ai][bj][m][0], t2 = acc[ai][bj][m][1];
                        const f32x4 o1 = (t1 * cs[ai][m] - t2 * sn[ai][m]) * f, o2 = (t2 * cs[ai][m] + t1 * sn[ai][m]) * f;
                        if (pmode != 1) store8(rowp + bj * HALF, o1, o2);
                    }
                }
        } else {
#pragma unroll
            for (int ai = 0; ai < 2; ++ai)
#pragma unroll
                for (int m = 0; m < 4; ++m) {
                    bf16_t* rowp = O + (size_t)(row0 + ai * HALF + m * 16) * DIN + col0;
#pragma unroll
                    for (int bj = 0; bj < 2; ++bj) {
                        f32x4 v0 = acc[ai][bj][m][0], v1 = acc[ai][bj][m][1];
                        if (mode == 2) {
#pragma unroll
                            for (int e = 0; e < 4; ++e) { v0[e] = v0[e] * fast_sigmoid(v0[e]); v1[e] = v1[e] * fast_sigmoid(v1[e]); }
                        } else if (mode == 3) {
#pragma unroll
                            for (int e = 0; e < 4; ++e) { v0[e] = fast_sigmoid(v0[e]); v1[e] = fast_sigmoid(v1[e]); }
                        }
                        if (pmode != 1) store8(rowp + bj * HALF, v0, v1);
                    }
                }
        }
        asm volatile("" ::: "memory");
    }
};
struct EpiMerged {
    static constexpr bool MID = true;
    const bf16_t* proj; bf16_t* O; const LAS float* rst;
    __device__ __forceinline__ bool mid_at(int t) const { return t == 4 || t == 8 || t == 12 || t == 16; }
    __device__ __forceinline__ void mid(Acc& acc, const Unit& u, int t, int wr, int wc, int fr, int fq) const {
        fr = launder_i(fr); fq = launder_i(fq);
        const LAS float* rq = (const LAS float*)rst + ((t >> 2) - 1) * 256 + wr * 64 + fr;
#pragma unroll
        for (int ai = 0; ai < 2; ++ai)
#pragma unroll
            for (int m = 0; m < 4; ++m) {
                const float f = rq[ai * HALF + m * 16];
#pragma unroll
                for (int bj = 0; bj < 2; ++bj) { acc[ai][bj][m][0] = acc[ai][bj][m][0] * f; acc[ai][bj][m][1] = acc[ai][bj][m][1] * f; }
            }
        if (t == 16) {
            const int row0 = u.pm * BM + wr * 64 + fr, col0 = u.pn * BM + wc * 32 + 8 * fq;
#pragma unroll
            for (int ai = 0; ai < 2; ++ai) {
                u32x4 g[4][2], d[4][2];
#pragma unroll
                for (int m = 0; m < 4; ++m) { const bf16_t* gp = proj + (size_t)(row0 + ai * HALF + m * 16) * DIN + 6144 + col0;
#pragma unroll
                    for (int bj = 0; bj < 2; ++bj) { g[m][bj] = *(const u32x4*)(gp + bj * HALF); d[m][bj] = *(const u32x4*)(gp + 1024 + bj * HALF); } }
                asm volatile("" ::: "memory");
#pragma unroll
                for (int m = 0; m < 4; ++m)
#pragma unroll
                    for (int bj = 0; bj < 2; ++bj) {
                        const u32x4 gg = g[m][bj], dd = d[m][bj];
                        f32x4 q0, q1;
                        q0[0] = bf_lo(gg.x) * __builtin_amdgcn_rcpf(bf_lo(dd.x)); q0[1] = bf_hi(gg.x) * __builtin_amdgcn_rcpf(bf_hi(dd.x));
                        q0[2] = bf_lo(gg.y) * __builtin_amdgcn_rcpf(bf_lo(dd.y)); q0[3] = bf_hi(gg.y) * __builtin_amdgcn_rcpf(bf_hi(dd.y));
                        q1[0] = bf_lo(gg.z) * __builtin_amdgcn_rcpf(bf_lo(dd.z)); q1[1] = bf_hi(gg.z) * __builtin_amdgcn_rcpf(bf_hi(dd.z));
                        q1[2] = bf_lo(gg.w) * __builtin_amdgcn_rcpf(bf_lo(dd.w)); q1[3] = bf_hi(gg.w) * __builtin_amdgcn_rcpf(bf_hi(dd.w));
                        acc[ai][bj][m][0] = acc[ai][bj][m][0] * q0; acc[ai][bj][m][1] = acc[ai][bj][m][1] * q1;
                    }
                asm volatile("" ::: "memory");
            }
        }
    }
    __device__ __forceinline__ void operator()(Acc& acc, const Unit& u, int wr, int wc, int fr, int fq) const {
        fr = launder_i(fr); fq = launder_i(fq);
        const int row0 = u.pm * BM + wr * 64 + fr, col0 = u.pn * BM + wc * 32 + 8 * fq;
        u32x4 d[2][4][2];
#pragma unroll
        for (int ai = 0; ai < 2; ++ai)
#pragma unroll
            for (int m = 0; m < 4; ++m) { const bf16_t* gp = proj + (size_t)(row0 + ai * HALF + m * 16) * DIN + 7168 + col0;
#pragma unroll
                for (int bj = 0; bj < 2; ++bj) d[ai][m][bj] = *(const u32x4*)(gp + bj * HALF); }
        asm volatile("" ::: "memory");
#pragma unroll
        for (int ai = 0; ai < 2; ++ai)
#pragma unroll
            for (int m = 0; m < 4; ++m) {
                const int row = row0 + ai * HALF + m * 16;
#pragma unroll
                for (int bj = 0; bj < 2; ++bj) {
                    const u32x4 dd = d[ai][m][bj];
                    f32x4 s0, s1; s0[0] = bf_lo(dd.x); s0[1] = bf_hi(dd.x); s0[2] = bf_lo(dd.y); s0[3] = bf_hi(dd.y); s1[0] = bf_lo(dd.z); s1[1] = bf_hi(dd.z); s1[2] = bf_lo(dd.w); s1[3] = bf_hi(dd.w);
                    store8(O + (size_t)row * D + col0 + bj * HALF, acc[ai][bj][m][0] * s0, acc[ai][bj][m][1] * s1);
                }
            }
        asm volatile("" ::: "memory");
    }
};
struct EpiWout {
    static constexpr bool MID = false;
    unsigned char* ws; const float* mod; int tbase;
    __device__ __forceinline__ bool mid_at(int) const { return false; }
    __device__ __forceinline__ void mid(Acc&, const Unit&, int, int, int, int, int) const {}
    __device__ __forceinline__ void operator()(Acc& acc, const Unit& u, int wr, int wc, int fr, int fq) const {
        fr = launder_i(fr); fq = launder_i(fq);
        const int row0 = tbase + u.pm * BM + wr * 64 + fr, col0 = u.pn * BM + wc * 32 + 8 * fq;
        const float* g1 = mod + (size_t)(row0 >> 12) * 6144 + 2048 + col0;
        f32x4 g[2][2];
#pragma unroll
        for (int bj = 0; bj < 2; ++bj) { g[bj][0] = *(const f32x4*)(g1 + bj * HALF); g[bj][1] = *(const f32x4*)(g1 + bj * HALF + 4); }
        bf16_t* base = (bf16_t*)(ws + delta_off(tbase + u.pm * BM)) + (size_t)(wr * 64 + fr) * D + col0;
#pragma unroll
        for (int ai = 0; ai < 2; ++ai)
#pragma unroll
            for (int m = 0; m < 4; ++m) {
                bf16_t* rowp = base + (size_t)(ai * HALF + m * 16) * D;
#pragma unroll
                for (int bj = 0; bj < 2; ++bj) store8(rowp + bj * HALF, g[bj][0] * acc[ai][bj][m][0], g[bj][1] * acc[ai][bj][m][1]);
            }
        asm volatile("" ::: "memory");
    }
};
struct EpiGU {
    static constexpr bool MID = false;
    unsigned char* act;
    __device__ __forceinline__ bool mid_at(int) const { return false; }
    __device__ __forceinline__ void mid(Acc&, const Unit&, int, int, int, int, int) const {}
    __device__ __forceinline__ void operator()(Acc& acc, const Unit& u, int wr, int wc, int fr, int fq) const {
        fr = launder_i(fr); fq = launder_i(fq);
        const int row0 = u.pm * BM + wr * 64 + fr, col0 = u.pn * 128 + wc * 16 + 4 * fq;
#pragma unroll
        for (int ai = 0; ai < 2; ++ai)
#pragma unroll
            for (int m = 0; m < 4; ++m) {
                unsigned char* rowp = act + (size_t)(row0 + ai * HALF + m * 16) * DEXP + col0;
#pragma unroll
                for (int bj = 0; bj < 2; ++bj) {
                    const f32x4 G = acc[ai][bj][m][0], U = acc[ai][bj][m][1]; f32x4 a;
#pragma unroll
                    for (int e = 0; e < 4; e += 2) {
                        const f32x2 g2 = {G[e], G[e + 1]}, u2 = {U[e], U[e + 1]};
                        const f32x2 t = g2 * (f32x2){-1.4426950408889634f * 0.03125f, -1.4426950408889634f * 0.03125f};
                        const f32x2 d = (f32x2){__builtin_amdgcn_exp2f(t.x), __builtin_amdgcn_exp2f(t.y)} + (f32x2){1.0f, 1.0f};
                        const f32x2 r = {__builtin_amdgcn_rcpf(d.x), __builtin_amdgcn_rcpf(d.y)};
                        const f32x2 o = ((g2 * u2) * r) * (f32x2){0.0009765625f, 0.0009765625f};
                        a[e] = o.x; a[e + 1] = o.y;
                    }
                    *(unsigned*)(rowp + bj * 64) = pk4_fp8(a[0], a[1], a[2], a[3]);
                }
            }
        asm volatile("" ::: "memory");
    }
};
struct EpiDown {
    static constexpr bool MID = false;
    unsigned char* y; const LAS float* wl;
    __device__ __forceinline__ bool mid_at(int) const { return false; }
    __device__ __forceinline__ void mid(Acc&, const Unit&, int, int, int, int, int) const {}
    __device__ __forceinline__ void operator()(Acc& acc, const Unit& u, int wr, int wc, int fr, int fq) const {
        fr = launder_i(fr); fq = launder_i(fq);
        const int r0 = wr * 64 + fr, col0 = u.pn * BM + wc * 32 + 8 * fq;
        const int colw = u.pn * BM + wc * 32 + 16 * (fq >> 1), odd = fq & 1;
#pragma unroll
        for (int ai = 0; ai < 2; ++ai)
#pragma unroll
            for (int mp = 0; mp < 2; ++mp) {
                unsigned char* rowp = y + (size_t)(u.pm * BM + r0 + ai * HALF + (2 * mp + odd) * 16) * D + colw;
                const float wA = wl[u.idx * 256 + r0 + ai * HALF + (2 * mp) * 16], wB = wl[u.idx * 256 + r0 + ai * HALF + (2 * mp + 1) * 16];
#pragma unroll
                for (int bj = 0; bj < 2; ++bj) {
                    u32x2 pa, pb;
                    { const int m = 2 * mp; const f32x4 v0 = acc[ai][bj][m][0] * wA, v1 = acc[ai][bj][m][1] * wA; pa.x = pk4_fp8(v0[0], v0[1], v0[2], v0[3]); pa.y = pk4_fp8(v1[0], v1[1], v1[2], v1[3]); }
                    { const int m = 2 * mp + 1; const f32x4 v0 = acc[ai][bj][m][0] * wB, v1 = acc[ai][bj][m][1] * wB; pb.x = pk4_fp8(v0[0], v0[1], v0[2], v0[3]); pb.y = pk4_fp8(v1[0], v1[1], v1[2], v1[3]); }
                    const auto sx = __builtin_amdgcn_permlane16_swap(pa.x, pb.x, false, false), sy = __builtin_amdgcn_permlane16_swap(pa.y, pb.y, false, false);
                    *(u32x4*)(rowp + bj * HALF) = (u32x4){(unsigned)sx[0], (unsigned)sy[0], (unsigned)sx[1], (unsigned)sy[1]};
                    asm volatile("" ::: "memory");
                }
            }
        asm volatile("" ::: "memory");
    }
};
}

__device__ __forceinline__ unsigned off_b(unsigned row, unsigned ch) { return 256u * row + 16u * (ch ^ (((row & 3u) << 2) | ((row >> 2) & 3u))); }
__device__ __forceinline__ int lds_addr(const LAS unsigned char* p) { return (int)(unsigned)(size_t)p; }
__device__ __forceinline__ int crow(int r, int hi) { return (r & 3) + 8 * (r >> 2) + 4 * hi; }
__device__ __forceinline__ s16x4 tr_read(const LAS unsigned char* p) { return __builtin_amdgcn_ds_read_tr16_b64_v4i16((LAS s16x4*)p); }
__device__ __forceinline__ bf16x8 tr_frag(const LAS unsigned char* tile, int r0, int r1, int c, int lane) {
    const int blk = (lane >> 4) & 1, q = (lane & 15) >> 2, p = lane & 3;
    const s16x4 a = tr_read(tile + off_b(r0 + q, 4 * c + 2 * blk + (p >> 1)) + 8 * (p & 1));
    const s16x4 b = tr_read(tile + off_b(r1 + q, 4 * c + 2 * blk + (p >> 1)) + 8 * (p & 1));
    return (bf16x8){a[0], a[1], a[2], a[3], b[0], b[1], b[2], b[3]};
}
__device__ __forceinline__ bf16x8 pack8(const f32x16& v, int base) {
    u32x4 w; w.x = cvt_pk_bf16(v[base + 0], v[base + 1]); w.y = cvt_pk_bf16(v[base + 2], v[base + 3]); w.z = cvt_pk_bf16(v[base + 4], v[base + 5]); w.w = cvt_pk_bf16(v[base + 6], v[base + 7]);
    return __builtin_bit_cast(bf16x8, w);
}
__device__ __forceinline__ int launder(int v) { asm volatile("" : "+v"(v)); return v; }
#define MFMA32(a, b, c) __builtin_amdgcn_mfma_f32_32x32x16_bf16(a, b, c, 0, 0, 0)

struct MixArgs { const bf16_t* proj; bf16_t* act; const float* diff_norm; float lam; float* ssq; };

template <int IMM> __device__ __forceinline__ void tr8_issue(s16x4 (&x)[8], const int (&ad)[8]) {
    asm volatile("ds_read_b64_tr_b16 %0, %8 offset:%16\n\tds_read_b64_tr_b16 %1, %9 offset:%16\n\tds_read_b64_tr_b16 %2, %10 offset:%16\n\tds_read_b64_tr_b16 %3, %11 offset:%16\n\t"
                 "ds_read_b64_tr_b16 %4, %12 offset:%16\n\tds_read_b64_tr_b16 %5, %13 offset:%16\n\tds_read_b64_tr_b16 %6, %14 offset:%16\n\tds_read_b64_tr_b16 %7, %15 offset:%16"
                 : "=&v"(x[0]), "=&v"(x[1]), "=&v"(x[2]), "=&v"(x[3]), "=&v"(x[4]), "=&v"(x[5]), "=&v"(x[6]), "=&v"(x[7])
                 : "v"(ad[0]), "v"(ad[1]), "v"(ad[2]), "v"(ad[3]), "v"(ad[4]), "v"(ad[5]), "v"(ad[6]), "v"(ad[7]), "n"(IMM) : "memory");
}
__device__ __forceinline__ void tr8_wait(s16x4 (&x)[8]) {
    asm volatile("s_waitcnt lgkmcnt(0)" : "+v"(x[0]), "+v"(x[1]), "+v"(x[2]), "+v"(x[3]), "+v"(x[4]), "+v"(x[5]), "+v"(x[6]), "+v"(x[7]) :: "memory");
}
template <int N> __device__ __forceinline__ void tr8_wait_n(s16x4 (&x)[8]) {
    asm volatile("s_waitcnt lgkmcnt(%8)" : "+v"(x[0]), "+v"(x[1]), "+v"(x[2]), "+v"(x[3]), "+v"(x[4]), "+v"(x[5]), "+v"(x[6]), "+v"(x[7]) : "n"(N) : "memory");
}
__device__ __forceinline__ void pv_mma(f32x16 (&O)[8], int ob, const s16x4 (&x)[8], const bf16x8& pf) {
    __builtin_amdgcn_s_setprio(2);
#pragma unroll
    for (int c = 0; c < 4; ++c) { const bf16x8 vf = {x[2 * c][0], x[2 * c][1], x[2 * c][2], x[2 * c][3], x[2 * c + 1][0], x[2 * c + 1][1], x[2 * c + 1][2], x[2 * c + 1][3]}; O[ob + c] = MFMA32(vf, pf, O[ob + c]); }
    __builtin_amdgcn_s_setprio(1);
}
template <int IMM> __device__ __forceinline__ void k4_issue(bf16x8 (&k)[4], int a0, int a1, int a2, int a3) {
    asm volatile("ds_read_b128 %0, %4 offset:%8\n\tds_read_b128 %1, %5 offset:%8\n\tds_read_b128 %2, %6 offset:%8\n\tds_read_b128 %3, %7 offset:%8"
                 : "=&v"(k[0]), "=&v"(k[1]), "=&v"(k[2]), "=&v"(k[3]) : "v"(a0), "v"(a1), "v"(a2), "v"(a3), "n"(IMM) : "memory");
}
__device__ __forceinline__ void tr4_issue(s16x4 (&x)[4], int a0, int a1, int a2, int a3) {
    asm volatile("ds_read_b64_tr_b16 %0, %4\n\tds_read_b64_tr_b16 %1, %5\n\tds_read_b64_tr_b16 %2, %6\n\tds_read_b64_tr_b16 %3, %7"
                 : "=&v"(x[0]), "=&v"(x[1]), "=&v"(x[2]), "=&v"(x[3]) : "v"(a0), "v"(a1), "v"(a2), "v"(a3) : "memory");
}
__device__ __forceinline__ void tr4_wait(s16x4 (&x)[4]) { asm volatile("s_waitcnt lgkmcnt(0)" : "+v"(x[0]), "+v"(x[1]), "+v"(x[2]), "+v"(x[3]) :: "memory"); }
__device__ __forceinline__ int tr_addr(const LAS unsigned char* tile, int r, int c, int lane) {
    const int blk = (lane >> 4) & 1, q = (lane & 15) >> 2, p = lane & 3;
    return lds_addr(tile) + (int)off_b(r + q, 4 * c + 2 * blk + (p >> 1)) + 8 * (p & 1);
}
__device__ __forceinline__ bf16x8 cat4(const s16x4& a, const s16x4& b) { return (bf16x8){a[0], a[1], a[2], a[3], b[0], b[1], b[2], b[3]}; }
template <int N> __device__ __forceinline__ void k4_wait(bf16x8 (&k)[4]) {
    asm volatile("s_waitcnt lgkmcnt(%4)" : "+v"(k[0]), "+v"(k[1]), "+v"(k[2]), "+v"(k[3]) : "n"(N) : "memory");
}
#define FENCE() __builtin_amdgcn_sched_barrier(0)
__device__ __forceinline__ bf16x8 lds_b128(int addr) { return *(const LAS bf16x8*)(size_t)(unsigned)addr; }
__device__ __forceinline__ s16x4 lds_tr(int addr) { return __builtin_amdgcn_ds_read_tr16_b64_v4i16((LAS s16x4*)(size_t)(unsigned)addr); }
template <int IMM> __device__ __forceinline__ s16x4 lds_tr_i(int addr) { return __builtin_amdgcn_ds_read_tr16_b64_v4i16((LAS s16x4*)((LAS unsigned char*)(size_t)(unsigned)addr + IMM)); }
__device__ __forceinline__ void dma16(const void* gptr, unsigned lds_base) {
    asm volatile("s_mov_b32 m0, %1\n\ts_nop 0\n\tglobal_load_lds_dwordx4 %0, off" :: "v"(gptr), "s"(lds_base) : "memory", "m0");
}
__device__ __forceinline__ void dma16s(unsigned long long sbase, unsigned voff, unsigned lds_base) {
    asm volatile("s_mov_b32 m0, %2\n\ts_nop 0\n\tglobal_load_lds_dwordx4 %0, %1" :: "v"(voff), "s"(sbase), "s"(lds_base) : "memory", "m0");
}
__device__ __forceinline__ unsigned attn_voff(int lane) { const int r4 = lane >> 4; return (unsigned)(r4 * DIN * 2 + (((lane & 15) ^ (r4 << 2)) * 16)); }
__device__ __forceinline__ void attn_issue(LAS unsigned char* buf, const bf16_t* proj, size_t trow0, int kcol0, int vcol0, int wid, unsigned voff0) {
    const int ti = wid >> 1;
    const int col = (ti < 2) ? kcol0 + ti * 128 : vcol0 + (ti - 2) * 128;
    const unsigned long long sb = (unsigned long long)(size_t)(proj + (trow0 + 32 * (wid & 1)) * DIN + col);
#pragma unroll
    for (int i = 0; i < 8; ++i)
        dma16s(sb + (unsigned long long)(4 * i) * DIN * 2, voff0 ^ (unsigned)(16 * (i & 3)), (unsigned)__builtin_amdgcn_readfirstlane(lds_addr(buf) + ti * 16384 + ((wid & 1) * 8 + i) * 1024));
}
__device__ __forceinline__ void attn_unit(LAS unsigned char* lds, const int wid, const MixArgs& A, int bl, int h, int qb, int pre, volatile LAS int* bcn) {
    const int lane0 = lane_now(), comp = wid >> 2, ri = wid & 3;
    const size_t tb = (size_t)bl * SEQ;
    const int kcol0 = 4096 + (2 * h) * 128, vcol0 = 5120 + h * 256;
    const int ntiles = 2 * (qb + 1);
    f32x16 O[8]; float mrun = -1e30f, lrun = 0.f;
    {
    const int lane = lane0, hh = lane >> 5, li = lane & 31;
    const unsigned voff0 = attn_voff(lane);
    attn_issue(lds, A.proj, tb, kcol0, vcol0, wid, voff0);
    const bf16_t* qrow = A.proj + (tb + qb * 128 + ri * 32 + li) * DIN + 3072 + (2 * h + comp) * 128;
    bf16x8 qf[8];
#pragma unroll
    for (int s = 0; s < 8; ++s) qf[s] = *(const bf16x8*)(qrow + 16 * s + 8 * hh);
    asm volatile("s_waitcnt vmcnt(0)" : "+v"(qf[0]), "+v"(qf[1]), "+v"(qf[2]), "+v"(qf[3]), "+v"(qf[4]), "+v"(qf[5]), "+v"(qf[6]), "+v"(qf[7]), "+v"(pre) :: "memory");
    if (wid == 0 && lane == 0) bcn[0] = pre;
#pragma unroll
    for (int i = 0; i < 8; ++i)
#pragma unroll
        for (int r = 0; r < 16; ++r) O[i][r] = 0.f;
    const int kadr = 256 * li + 16 * (hh ^ (((li & 3) << 2) | ((li >> 2) & 3)));
    const int blk = (lane >> 4) & 1, q = (lane & 15) >> 2, p = lane & 3, lo1 = (2 * blk + (p >> 1)) ^ hh;
    const int vb1 = 256 * (4 * hh + q) + 64 * q + 16 * lo1 + 8 * (p & 1), vb2 = 256 * (4 * hh + q + 8) + 64 * q + 16 * (lo1 ^ 2) + 8 * (p & 1);
    for (int kt = 0; kt < ntiles; ++kt) {
        asm volatile("s_waitcnt vmcnt(0)" ::: "memory");
        __builtin_amdgcn_s_barrier();
        asm volatile("" ::: "memory");
        if (kt + 1 < ntiles) attn_issue(lds + ((kt + 1) & 1) * 65536, A.proj, tb + (size_t)(kt + 1) * 64, kcol0, vcol0, wid, voff0);
        const int krel0 = (kt - 2 * qb) * 64;
        if (krel0 > ri * 32 + 31) continue;
        const LAS unsigned char* Kt = lds + (kt & 1) * 65536 + comp * 16384;
        const LAS unsigned char* Vt = lds + (kt & 1) * 65536 + 32768;
        f32x16 sc[2];
#pragma unroll
        for (int kb = 0; kb < 2; ++kb)
#pragma unroll
            for (int r = 0; r < 16; ++r) sc[kb][r] = 0.f;
        __builtin_amdgcn_s_setprio(1);
        {
            const int kbase = lds_addr(Kt);
            bf16x8 ka[2][4];
#pragma unroll
            for (int s = 0; s < 4; ++s) ka[0][s] = lds_b128(kbase + (kadr ^ (32 * s)));
#pragma unroll
            for (int grp = 0; grp < 4; ++grp) {
                const int s0 = 4 * (grp >> 1), kb = grp & 1;
                if (grp + 1 < 4) { const int s1 = 4 * ((grp + 1) >> 1), kb1 = (grp + 1) & 1;
#pragma unroll
                    for (int s = 0; s < 4; ++s) ka[(grp + 1) & 1][s] = lds_b128(kbase + 8192 * kb1 + (kadr ^ (32 * (s1 + s)))); }
                FENCE();
                __builtin_amdgcn_s_setprio(2);
#pragma unroll
                for (int s = 0; s < 4; ++s) sc[kb] = MFMA32(ka[grp & 1][s], qf[s0 + s], sc[kb]);
                __builtin_amdgcn_s_setprio(1);
                FENCE();
            }
        }
        __builtin_amdgcn_s_setprio(0);
        if (krel0 >= 0) {
            const int qrel = ri * 32 + li;
#pragma unroll
            for (int kb = 0; kb < 2; ++kb)
#pragma unroll
                for (int r = 0; r < 16; ++r) if (krel0 + 32 * kb + crow(r, hh) > qrel) sc[kb][r] = -INFINITY;
        }
        float pmax = sc[0][0];
#pragma unroll
        for (int r = 1; r < 16; ++r) pmax = fmaxf(pmax, sc[0][r]);
#pragma unroll
        for (int r = 0; r < 16; ++r) pmax = fmaxf(pmax, sc[1][r]);
        pmax = xor32_max(pmax);
        if (!__all(pmax <= mrun + 11.0f)) {
            const float mn = fmaxf(mrun, pmax), alpha = __builtin_amdgcn_exp2f(mrun - mn);
            mrun = mn; lrun *= alpha;
#pragma unroll
            for (int i = 0; i < 8; ++i)
#pragma unroll
                for (int r = 0; r < 16; ++r) O[i][r] *= alpha;
        }
        float ps = 0.f;
#pragma unroll
        for (int kb = 0; kb < 2; ++kb)
#pragma unroll
            for (int r = 0; r < 16; ++r) { const float pe = __builtin_amdgcn_exp2f(sc[kb][r] - mrun); sc[kb][r] = pe; ps += pe; }
        lrun += ps;
        {
            const int vbase = (int)(unsigned)(size_t)Vt;
            int ad[8];
#pragma unroll
            for (int c = 0; c < 4; ++c) { ad[2 * c] = vbase + (vb1 ^ (64 * c)); ad[2 * c + 1] = vbase + (vb2 ^ (64 * c)); }
            const bf16x8 pf0 = pack8(sc[0], 0), pf1 = pack8(sc[0], 8), pf2 = pack8(sc[1], 0), pf3 = pack8(sc[1], 8);
            s16x4 xa[8], xb[8];
            __builtin_amdgcn_s_setprio(1);
#define PV_LOAD(x, IMM) do { _Pragma("unroll") for (int c = 0; c < 8; ++c) x[c] = lds_tr_i<(IMM)>(ad[c]); } while (0)
            PV_LOAD(xa, 256 * 0);
            PV_LOAD(xb, 256 * 0 + 16384);  FENCE(); pv_mma(O, 0, xa, pf0); FENCE();
            PV_LOAD(xa, 256 * 16);         FENCE(); pv_mma(O, 4, xb, pf0); FENCE();
            PV_LOAD(xb, 256 * 16 + 16384); FENCE(); pv_mma(O, 0, xa, pf1); FENCE();
            PV_LOAD(xa, 256 * 32);         FENCE(); pv_mma(O, 4, xb, pf1); FENCE();
            PV_LOAD(xb, 256 * 32 + 16384); FENCE(); pv_mma(O, 0, xa, pf2); FENCE();
            PV_LOAD(xa, 256 * 48);         FENCE(); pv_mma(O, 4, xb, pf2); FENCE();
            PV_LOAD(xb, 256 * 48 + 16384); FENCE(); pv_mma(O, 0, xa, pf3); FENCE();
                                                    pv_mma(O, 4, xb, pf3);
            __builtin_amdgcn_s_setprio(0);
#undef PV_LOAD
        }
    }
    }
    __syncthreads();
    const float inv = 1.0f / xor32_sum(lrun);
    LAS f32x4* X = (LAS f32x4*)lds;
    const int lane = lane_now(), hh = lane >> 5, li = lane & 31;
    if (comp == 1) {
#pragma unroll
        for (int dvb = 0; dvb < 8; ++dvb)
#pragma unroll
            for (int g = 0; g < 4; ++g) X[((ri * 8 + dvb) * 4 + g) * 64 + lane] = (f32x4){O[dvb][4 * g] * inv, O[dvb][4 * g + 1] * inv, O[dvb][4 * g + 2] * inv, O[dvb][4 * g + 3] * inv};
    }
    __syncthreads();
    if (comp == 0) {
        float ss = 0.f;
#pragma unroll
        for (int dvb = 0; dvb < 8; ++dvb)
#pragma unroll
            for (int g = 0; g < 4; ++g) {
                const f32x4 o2 = X[((ri * 8 + dvb) * 4 + g) * 64 + lane];
#pragma unroll
                for (int e = 0; e < 4; ++e) { float d = O[dvb][4 * g + e] * inv - A.lam * o2[e]; asm volatile("" : "+v"(d)); O[dvb][4 * g + e] = d; ss += d * d; }
            }
        ss = xor32_sum(ss);
        const float rstd = 0.8f / sqrtf(ss * (1.0f / 256.0f) + EPS);
        LAS unsigned char* stg = lds + ri * 32768;
#pragma unroll
        for (int dh = 0; dh < 2; ++dh) {
            asm volatile("" ::: "memory");
            f32x4 gn[4][4];
#pragma unroll
            for (int d4 = 0; d4 < 4; ++d4)
#pragma unroll
                for (int g = 0; g < 4; ++g) gn[d4][g] = *(const f32x4*)(A.diff_norm + 32 * (4 * dh + d4) + 8 * g + 4 * hh);
            asm volatile("" ::: "memory");
#pragma unroll
            for (int d4 = 0; d4 < 4; ++d4) {
                const int dvb = 4 * dh + d4;
#pragma unroll
                for (int g = 0; g < 4; ++g) {
                    u32x2 w; w.x = cvt_pk_bf16(O[dvb][4 * g] * rstd * gn[d4][g][0], O[dvb][4 * g + 1] * rstd * gn[d4][g][1]); w.y = cvt_pk_bf16(O[dvb][4 * g + 2] * rstd * gn[d4][g][2], O[dvb][4 * g + 3] * rstd * gn[d4][g][3]);
                    *(LAS u32x2*)(stg + li * 528 + 64 * dvb + 16 * g + 8 * hh) = w;
                }
            }
        }
        asm volatile("s_waitcnt lgkmcnt(0)" ::: "memory");
        bf16_t* obase = A.act + (tb + qb * 128 + ri * 32 + hh) * 2048 + 1024 + h * 256 + 8 * li;
#pragma unroll
        for (int i4 = 0; i4 < 4; ++i4) {
            u32x4 v[4];
#pragma unroll
            for (int q = 0; q < 4; ++q) v[q] = *(const LAS u32x4*)(stg + (2 * (4 * i4 + q) + hh) * 528 + 16 * li);
#pragma unroll
            for (int q = 0; q < 4; ++q) *(u32x4*)(obase + (size_t)(2 * (4 * i4 + q)) * 2048) = v[q];
        }
    }
    __syncthreads();
}

#define MFMA_DEP(acc, zs) (__builtin_amdgcn_readfirstlane(__float_as_int((acc)[15])) & (zs))
#define MFMA_DEP2(a, b, zs) ((__builtin_amdgcn_readfirstlane(__float_as_int((a)[15])) | __builtin_amdgcn_readfirstlane(__float_as_int((b)[15]))) & (zs))
#define MFMA_DEP4(a, b, c, d, zs) ((__builtin_amdgcn_readfirstlane(__float_as_int((a)[15])) | __builtin_amdgcn_readfirstlane(__float_as_int((b)[15])) | __builtin_amdgcn_readfirstlane(__float_as_int((c)[15])) | __builtin_amdgcn_readfirstlane(__float_as_int((d)[15]))) & (zs))
#define RET_BAR() do { asm volatile("s_waitcnt lgkmcnt(0)" ::: "memory"); __builtin_amdgcn_s_barrier(); asm volatile("" ::: "memory"); } while (0)
template <int J2> __device__ __forceinline__ void ret_step34(f32x16 (&Oa)[2], f32x16 (&St)[2], const int (&tv)[2], const int (&tk)[2][2], int pa0, int pa1, int pb0, int pb1, int ib0, int ib1) {
    constexpr int R = 256 * 32 * J2;
    s16x4 xv[4], xk0[4], xk1[4]; bf16x8 pp[4];
    xv[0] = lds_tr_i<R>(tv[0]); xv[1] = lds_tr_i<R + 1024>(tv[1]); xv[2] = lds_tr_i<R + 4096>(tv[0]); xv[3] = lds_tr_i<R + 5120>(tv[1]);
    xk0[0] = lds_tr_i<R>(tk[0][0]); xk0[1] = lds_tr_i<R + 1024>(tk[0][1]); xk0[2] = lds_tr_i<R + 4096>(tk[0][0]); xk0[3] = lds_tr_i<R + 5120>(tk[0][1]);
    xk1[0] = lds_tr_i<R>(tk[1][0]); xk1[1] = lds_tr_i<R + 1024>(tk[1][1]); xk1[2] = lds_tr_i<R + 4096>(tk[1][0]); xk1[3] = lds_tr_i<R + 5120>(tk[1][1]);
    pp[0] = lds_b128(pa0); pp[1] = lds_b128(pb0); pp[2] = lds_b128(pa1); pp[3] = lds_b128(pb1);
    FENCE();
    const bf16x8 z = {0, 0, 0, 0, 0, 0, 0, 0};
#pragma unroll
    for (int q = 0; q < 2; ++q) {
        const bf16x8 vf = cat4(xv[2 * q], xv[2 * q + 1]);
        Oa[0] = MFMA32(vf, (J2 <= ib0) ? pp[2 * q] : z, Oa[0]); Oa[1] = MFMA32(vf, (J2 <= ib1) ? pp[2 * q + 1] : z, Oa[1]);
        St[0] = MFMA32(cat4(xk0[2 * q], xk0[2 * q + 1]), vf, St[0]); St[1] = MFMA32(cat4(xk1[2 * q], xk1[2 * q + 1]), vf, St[1]);
    }
    FENCE();
}
__device__ __forceinline__ void ret_unit(LAS unsigned char* lds, const int wid, const MixArgs& A, int bl, int h, int dvh) {
    const int lane = lane_now(), tid = wid * 64 + lane, eb = wid & 3, hf = wid >> 2;
    const int ib0 = hf ? 1 : 0, ib1 = hf ? 2 : 3, li = lane & 31, hh = lane >> 5;
    const size_t tb = (size_t)bl * SEQ;
    const float gamma = 1.0f - __builtin_amdgcn_exp2f(-5.0f - (float)h), lg = __builtin_amdgcn_logf(gamma);
    const float cdecay = __builtin_amdgcn_exp2f(128.0f * lg), cinv = __builtin_amdgcn_exp2f(-128.0f * lg);
    const int L0 = lds_addr(lds), X = ((li & 3) << 2) | ((li >> 2) & 3);
    int rb[8];
#pragma unroll
    for (int s = 0; s < 8; ++s) rb[s] = L0 + 256 * li + 16 * ((2 * s + hh) ^ X);
    int wb[4];
#pragma unroll
    for (int g = 0; g < 4; ++g) wb[g] = L0 + 256 * li + 16 * (g ^ (X & 3)) + 8 * hh;
    const int xh = X >> 2;
    const int tq = (lane & 15) >> 2, tp = lane & 3, tblk = (lane >> 4) & 1;
    int tv[2], tk[2][2];
#pragma unroll
    for (int t = 0; t < 2; ++t) {
        const int lp = 2048 * hh + 256 * tq + 16 * ((2 * tblk + (tp >> 1)) ^ (2 * hh + t)) + 8 * (tp & 1);
        tv[t] = L0 + 65536 + lp + 64 * (eb ^ tq);
#pragma unroll
        for (int k = 0; k < 2; ++k) tk[k][t] = L0 + 32768 + lp + 64 * ((2 * hf + k) ^ tq);
    }
    const int sS0 = 98304 + 8192 * eb, sA0 = 8192 * ib0, sB0 = 8192 * ib1;
    const int sw = 256 * (tid >> 4) + 16 * ((tid & 15) ^ ((((tid >> 4) & 3) << 2) | ((tid >> 6) & 3)));
    const unsigned gq = (unsigned)(((tid >> 4) * DIN + (tid & 15) * 8) * 2);
    const unsigned colb[3] = {(unsigned)(h * 128 * 2), (unsigned)((512 + h * 128) * 2), (unsigned)((1024 + h * 256 + dvh * 128) * 2)};
    const unsigned go0 = (unsigned)(((32 * ib0 + li) * DIN + 4 * hh) * 2), go1 = (unsigned)(((32 * ib1 + li) * DIN + 4 * hh) * 2);
    const unsigned oo0 = (unsigned)(((32 * ib0 + li) * 2048 + 4 * hh) * 2), oo1 = (unsigned)(((32 * ib1 + li) * 2048 + 4 * hh) * 2);
    f32x16 St[2];
#pragma unroll
    for (int i = 0; i < 2; ++i)
#pragma unroll
        for (int r = 0; r < 16; ++r) St[i][r] = 0.f;
    u32x4 pre[12];
    {
        const char* cb = (const char*)(A.proj + tb * DIN);
#pragma unroll
        for (int i = 0; i < 12; ++i) pre[i] = *(const u32x4*)(cb + (size_t)(i & 3) * 32 * DIN * 2 + (gq + colb[i >> 2]));
#pragma unroll
        for (int i = 0; i < 12; ++i) *(LAS u32x4*)(lds + (i >> 2) * 32768 + (i & 3) * 8192 + sw) = pre[i];
    }
    RET_BAR();
    for (int n = 0; n < 32; ++n) {
        const size_t t0 = tb + (size_t)n * 128;
        int sS = sS0, sA = sA0, sB = sB0, wl = wid;
        asm volatile("" : "+s"(sS), "+s"(sA), "+s"(sB), "+s"(wl));
        if (n + 1 < 32) {
            const char* cb = (const char*)(A.proj + (t0 + 128) * DIN);
#pragma unroll
            for (int i = 0; i < 12; ++i) pre[i] = *(const u32x4*)(cb + (size_t)(i & 3) * 32 * DIN * 2 + (gq + colb[i >> 2]));
        }
        f32x16 Oa[2];
#pragma unroll
        for (int i = 0; i < 2; ++i)
#pragma unroll
            for (int r = 0; r < 16; ++r) Oa[i][r] = 0.f;
        if (n > 0) {
#pragma unroll
            for (int s4 = 0; s4 < 2; ++s4) {
                bf16x8 sa[4], qa[4], qb[4];
#pragma unroll
                for (int s = 0; s < 4; ++s) { sa[s] = lds_b128(rb[4 * s4 + s] + sS); qa[s] = lds_b128(rb[4 * s4 + s] + sA); qb[s] = lds_b128(rb[4 * s4 + s] + sB); }
                FENCE();
#pragma unroll
                for (int s = 0; s < 4; ++s) { Oa[0] = MFMA32(sa[s], qa[s], Oa[0]); Oa[1] = MFMA32(sa[s], qb[s], Oa[1]); }
                FENCE();
            }
        }
        f32x16 sb[2]; int jbs[2], ibs[2];
#pragma unroll
        for (int u = 0; u < 2; ++u) {
            const int id = wl + 8 * u;
            const int ib = (id >= 6) ? 3 : (id >= 3) ? 2 : (id >= 1) ? 1 : 0, jb = id - (ib * (ib + 1)) / 2;
            ibs[u] = ib; jbs[u] = jb;
#pragma unroll
            for (int r = 0; r < 16; ++r) sb[u][r] = 0.f;
            if (id < 10) {
                bf16x8 fa[4], fb[4];
                const int ok = 32768 + 8192 * jb, oq = 8192 * ib;
#pragma unroll
                for (int h2 = 0; h2 < 2; ++h2) {
#pragma unroll
                    for (int s = 0; s < 4; ++s) { fa[s] = lds_b128(rb[4 * h2 + s] + ok); fb[s] = lds_b128(rb[4 * h2 + s] + oq); }
                    FENCE();
#pragma unroll
                    for (int s = 0; s < 4; ++s) sb[u] = MFMA32(fa[s], fb[s], sb[u]);
                    FENCE();
                }
            }
        }
        RET_BAR();
#pragma unroll
        for (int u = 0; u < 2; ++u) {
            const int id = wl + 8 * u;
            if (id < 10) {
                const int ib = ibs[u], jb = jbs[u], wo = 8192 * ib + 64 * (jb ^ xh);
#pragma unroll
                for (int g = 0; g < 4; ++g) {
                    float p[4];
#pragma unroll
                    for (int e = 0; e < 4; ++e) { const int j = 8 * g + 4 * hh + e; p[e] = (ib == jb && j > li) ? 0.f : sb[u][4 * g + e] * cinv; }
                    u32x2 w; w.x = cvt_pk_bf16(p[0], p[1]); w.y = cvt_pk_bf16(p[2], p[3]);
                    *(LAS u32x2*)(size_t)(unsigned)(wb[g] + wo) = w;
                }
            }
        }
        RET_BAR();
        u32x2 gg[2][4];
        { const char* gbp = (const char*)(A.proj + t0 * DIN + 2048 + h * 256 + dvh * 128 + 32 * eb);
#pragma unroll
          for (int g = 0; g < 4; ++g) { gg[0][g] = *(const u32x2*)(gbp + go0 + 16 * g); gg[1][g] = *(const u32x2*)(gbp + go1 + 16 * g); } }
#pragma unroll
        for (int k = 0; k < 2; ++k)
#pragma unroll
            for (int r = 0; r < 16; ++r) St[k][r] *= cdecay;
        ret_step34<0>(Oa, St, tv, tk, rb[0] + sA, rb[1] + sA, rb[0] + sB, rb[1] + sB, ib0, ib1);
        ret_step34<1>(Oa, St, tv, tk, rb[2] + sA, rb[3] + sA, rb[2] + sB, rb[3] + sB, ib0, ib1);
        ret_step34<2>(Oa, St, tv, tk, rb[4] + sA, rb[5] + sA, rb[4] + sB, rb[5] + sB, ib0, ib1);
        ret_step34<3>(Oa, St, tv, tk, rb[6] + sA, rb[7] + sA, rb[6] + sB, rb[7] + sB, ib0, ib1);
        RET_BAR();
#pragma unroll
        for (int k = 0; k < 2; ++k) {
            const int so = sS + 64 * ((2 * (wl >> 2) + k) ^ xh);
#pragma unroll
            for (int g = 0; g < 4; ++g) {
                u32x2 w; w.x = cvt_pk_bf16(St[k][4 * g], St[k][4 * g + 1]); w.y = cvt_pk_bf16(St[k][4 * g + 2], St[k][4 * g + 3]);
                *(LAS u32x2*)(size_t)(unsigned)(wb[g] + so) = w;
            }
        }
        if (n + 1 < 32) {
#pragma unroll
            for (int i = 0; i < 12; ++i) *(LAS u32x4*)(lds + (i >> 2) * 32768 + (i & 3) * 8192 + sw) = pre[i];
        }
        {
            char* obp = (char*)(A.act + t0 * 2048 + h * 256 + dvh * 128 + 32 * eb);
            float* sqp = A.ssq + (t0 * 4 + h) * 8 + dvh * 4 + eb;
#pragma unroll
            for (int k = 0; k < 2; ++k) {
                float sq = 0.f;
#pragma unroll
                for (int r = 0; r < 16; ++r) sq += Oa[k][r] * Oa[k][r];
                sq = xor32_sum(sq);
                if (hh == 0) sqp[(size_t)(32 * (k ? ib1 : ib0) + li) * 32] = sq;
                const unsigned oo = k ? oo1 : oo0;
                u32x2 w[4];
#pragma unroll
                for (int g = 0; g < 4; ++g) {
                    const u32x2 gv = gg[k][g];
                    w[g].x = cvt_pk_bf16(Oa[k][4 * g] * bf_lo(gv.x), Oa[k][4 * g + 1] * bf_hi(gv.x)); w[g].y = cvt_pk_bf16(Oa[k][4 * g + 2] * bf_lo(gv.y), Oa[k][4 * g + 3] * bf_hi(gv.y));
                }
#pragma unroll
                for (int g = 0; g < 4; g += 2) {
                    const auto sx = __builtin_amdgcn_permlane32_swap(w[g].x, w[g + 1].x, false, false), sy = __builtin_amdgcn_permlane32_swap(w[g].y, w[g + 1].y, false, false);
                    *(u32x4*)(obp + (oo - 8 * hh) + 16 * (g + hh)) = (u32x4){(unsigned)sx[0], (unsigned)sy[0], (unsigned)sx[1], (unsigned)sy[1]};
                }
            }
        }
        RET_BAR();
    }
    __syncthreads();
}

struct Args { const void* in[24]; float* out; unsigned char* ws; int ph_lo, ph_hi; };
struct Frame {
    LAS unsigned char* lds; int tid, lane, wave, G, vcu;
    const float *x, *c, *w_ada, *b_ada, *norm_mix, *w_in, *w_ret_o, *w_diff_o, *lq1, *lk1, *lq2, *lk2, *diff_norm, *w_out, *norm_ffn, *w_rg, *b_rg, *w_re, *b_re, *w_eg, *w_eu, *w_ed, *norm_final;
    const int* positions; float* out; unsigned char* ws;
};
__device__ __forceinline__ unsigned f2bf(float f) { unsigned u = __builtin_bit_cast(unsigned, f); return (u + 0x7fffu + ((u >> 16) & 1u)) >> 16; }
__device__ __forceinline__ unsigned pk2(float lo, float hi) { return f2bf(lo) | (f2bf(hi) << 16); }

template <int MODE>
__device__ __forceinline__ void p0_transpose_item(const float* W, int N, bf16_t* WT, int ldk, int koff, LAS float* scr, int item, int lane) {
    const int nblk = N / 32, kb = item / nblk, nb = item % nblk, k0 = 64 * kb, n0 = 32 * nb;
    { float wv[32];
#pragma unroll
      for (int i = 0; i < 32; ++i) { const int kk = 2 * i + (lane >> 5); wv[i] = W[(size_t)(k0 + kk) * N + n0 + (lane & 31)]; }
#pragma unroll
      for (int i = 0; i < 32; ++i) { const int kk = 2 * i + (lane >> 5); scr[kk * 33 + (lane & 31)] = wv[i]; } }
    LDS_WAIT(); asm volatile("" ::: "memory");
    const int c = lane & 7;
#pragma unroll
    for (int j = 0; j < 4; ++j) {
        const int nl = (lane >> 3) + 8 * j, n = n0 + nl; const LAS float* s = scr + (8 * c) * 33 + nl;
        int np = n; float sc = 1.f;
        if (MODE == 1) {
            const bool rope = (n < 1024) || (n >= 3072 && n < 5120);
            if (rope) { const int f = n & 127; np = (n & ~127) + 8 * ((f & 63) >> 2) + 4 * (f >> 6) + (f & 3); }
            if ((n >= 512 && n < 1024) || (n >= 4096 && n < 5120)) sc = 0.08838834764831845f;
            else if (n >= 3072 && n < 4096) sc = 1.4426950408889634f;
        } else if (MODE == 2) np = 8 * (n >> 2) + (n & 3);
        else if (MODE == 3) np = 8 * (n >> 2) + 4 + (n & 3);
        u32x4 o; o.x = pk2(s[0 * 33] * sc, s[1 * 33] * sc); o.y = pk2(s[2 * 33] * sc, s[3 * 33] * sc); o.z = pk2(s[4 * 33] * sc, s[5 * 33] * sc); o.w = pk2(s[6 * 33] * sc, s[7 * 33] * sc);
        *(u32x4*)(WT + (size_t)np * ldk + koff + k0 + 8 * c) = o;
    }
    LDS_WAIT(); asm volatile("" ::: "memory");
}

template <int MODE>
__device__ __forceinline__ void p0_transpose_item8(const float* W, int N, unsigned char* WT8, int ldk, LAS float* scr, int item, int lane) {
    const int nblk = N / 32, kb = item / nblk, nb = item % nblk, k0 = 64 * kb, n0 = 32 * nb;
    { float wv[32];
#pragma unroll
      for (int i = 0; i < 32; ++i) { const int kk = 2 * i + (lane >> 5); wv[i] = W[(size_t)(k0 + kk) * N + n0 + (lane & 31)]; }
#pragma unroll
      for (int i = 0; i < 32; ++i) { const int kk = 2 * i + (lane >> 5); scr[kk * 33 + (lane & 31)] = wv[i]; } }
    LDS_WAIT(); asm volatile("" ::: "memory");
    const int c = lane & 7;
#pragma unroll
    for (int j = 0; j < 4; ++j) {
        const int nl = (lane >> 3) + 8 * j, n = n0 + nl; const LAS float* s = scr + (8 * c) * 33 + nl;
        const int np = (MODE == 2) ? 8 * (n >> 2) + (n & 3) : (MODE == 3) ? 8 * (n >> 2) + 4 + (n & 3) : n;
        u32x2 o; o.x = pk4_fp8(s[0 * 33] * 32.f, s[1 * 33] * 32.f, s[2 * 33] * 32.f, s[3 * 33] * 32.f); o.y = pk4_fp8(s[4 * 33] * 32.f, s[5 * 33] * 32.f, s[6 * 33] * 32.f, s[7 * 33] * 32.f);
        *(u32x2*)(WT8 + (size_t)np * ldk + k0 + 8 * c) = o;
    }
    LDS_WAIT(); asm volatile("" ::: "memory");
}
template <int MODE>
__device__ __forceinline__ void p0_transpose_pair8(const float* W, int N, unsigned char* WT8, int ldk, LAS float* scr, int item, int lane) {
    const int nblk = N / 32;
    float wa[32], wb[32];
    { const int kb = item / nblk, nb = item % nblk, k0 = 64 * kb, n0 = 32 * nb;
#pragma unroll
      for (int i = 0; i < 32; ++i) { const int kk = 2 * i + (lane >> 5); wa[i] = W[(size_t)(k0 + kk) * N + n0 + (lane & 31)]; } }
    { const int kb = (item + 1) / nblk, nb = (item + 1) % nblk, k0 = 64 * kb, n0 = 32 * nb;
#pragma unroll
      for (int i = 0; i < 32; ++i) { const int kk = 2 * i + (lane >> 5); wb[i] = W[(size_t)(k0 + kk) * N + n0 + (lane & 31)]; } }
#pragma unroll
    for (int h = 0; h < 2; ++h) {
        const int it = item + h, kb = it / nblk, nb = it % nblk, k0 = 64 * kb, n0 = 32 * nb;
#pragma unroll
        for (int i = 0; i < 32; ++i) { const int kk = 2 * i + (lane >> 5); scr[kk * 33 + (lane & 31)] = h ? wb[i] : wa[i]; }
        LDS_WAIT(); asm volatile("" ::: "memory");
        const int c = lane & 7;
#pragma unroll
        for (int j = 0; j < 4; ++j) {
            const int nl = (lane >> 3) + 8 * j, n = n0 + nl; const LAS float* sp = scr + (8 * c) * 33 + nl;
            const int np = (MODE == 2) ? 8 * (n >> 2) + (n & 3) : (MODE == 3) ? 8 * (n >> 2) + 4 + (n & 3) : n;
            u32x2 o; o.x = pk4_fp8(sp[0 * 33] * 32.f, sp[1 * 33] * 32.f, sp[2 * 33] * 32.f, sp[3 * 33] * 32.f); o.y = pk4_fp8(sp[4 * 33] * 32.f, sp[5 * 33] * 32.f, sp[6 * 33] * 32.f, sp[7 * 33] * 32.f);
            *(u32x2*)(WT8 + (size_t)np * ldk + k0 + 8 * c) = o;
        }
        LDS_WAIT(); asm volatile("" ::: "memory");
    }
}

__device__ __forceinline__ void p0_prologue(Frame& F) {
    F.lane = lane_now(); F.tid = F.wave * 64 + F.lane;
    float* mod = (float*)(F.ws + WS_MOD);
    LAS float* sc = (LAS float*)F.lds;
    for (int i = F.tid; i < NB * D; i += NTHR) { const float v = F.c[i]; sc[(i & 1023) * 8 + (i >> 10)] = v / (1.0f + __expf(-v)); }
    __syncthreads();
    LAS float* red = (LAS float*)(F.lds + 32768);
    for (int item = blockIdx.x; item < 192; item += F.G) {
        const int cl = F.tid & 31, kg = F.tid >> 5, col = item * 32 + cl;
        const float* wp = F.w_ada + (size_t)(kg * 64) * 6144 + col;
        float w[64];
#pragma unroll
        for (int k = 0; k < 64; ++k) w[k] = wp[(size_t)k * 6144];
        float a[8];
#pragma unroll
        for (int b = 0; b < 8; ++b) a[b] = 0.f;
#pragma unroll
        for (int k = 0; k < 64; ++k) { const f32x4 s0 = *(const LAS f32x4*)(sc + (kg * 64 + k) * 8), s1 = *(const LAS f32x4*)(sc + (kg * 64 + k) * 8 + 4);
            a[0] += s0.x * w[k]; a[1] += s0.y * w[k]; a[2] += s0.z * w[k]; a[3] += s0.w * w[k]; a[4] += s1.x * w[k]; a[5] += s1.y * w[k]; a[6] += s1.z * w[k]; a[7] += s1.w * w[k]; }
#pragma unroll
        for (int b = 0; b < 8; ++b) red[(kg * 8 + b) * 32 + cl] = a[b];
        __syncthreads();
        if (F.tid < 256) { const int b = F.tid >> 5; float s = 0.f;
#pragma unroll
          for (int g = 0; g < 16; ++g) s += red[(g * 8 + b) * 32 + cl];
          mod[(size_t)b * 6144 + col] = s + F.b_ada[col]; }
        __syncthreads();
    }
    if (blockIdx.x == 0 && F.wave == 0) {
        float s1 = F.lq1[F.lane] * F.lk1[F.lane] + F.lq1[F.lane + 64] * F.lk1[F.lane + 64], s2 = F.lq2[F.lane] * F.lk2[F.lane] + F.lq2[F.lane + 64] * F.lk2[F.lane + 64];
        s1 = wave_sum(s1); s2 = wave_sum(s2);
        if (F.lane == 0) *(float*)(F.ws + WS_MOD + 256 * 1024) = __expf(s1) - __expf(s2) + 0.2f;
    }
    { bf16_t* rth = (bf16_t*)(F.ws + WS_MOD + 512 * 1024); bf16_t* rtl = rth + 48 * D;
      for (int i = blockIdx.x * NTHR + F.tid; i < 48 * D; i += F.G * NTHR) { const int o = i >> 10, k = i & 1023; const float w = (o < 4) ? F.w_rg[k * 4 + o] : (o < 36) ? F.w_re[k * 32 + (o - 4)] : 0.f;
          const unsigned h = f2bf(w); rth[i] = (bf16_t)h; rtl[i] = (bf16_t)f2bf(w - __uint_as_float(h << 16)); } }
    __syncthreads();
    LAS float* scr = (LAS float*)(F.lds + F.wave * 16384);
    const int gw = launder_s(F.vcu * NWAVES + F.wave), NGW = F.G * NWAVES;
    constexpr int I_IN = 16 * 256, I_SQ = 16 * 32;
    constexpr int NITEMS = I_IN + 3 * I_SQ;
    bf16_t* Win = (bf16_t*)(F.ws + WS_WIN); bf16_t* Wmix = (bf16_t*)(F.ws + WS_WMIX); bf16_t* Wout = (bf16_t*)(F.ws + WS_WOUT);
    for (int it = gw; it < NITEMS; it += NGW) {
        int r = it;
        if (r < I_IN) { p0_transpose_item<1>(F.w_in, DIN, Win, 1024, 0, scr, r, F.lane); continue; } r -= I_IN;
        if (r < I_SQ) { p0_transpose_item<0>(F.w_ret_o, D, Wmix, 2048, 0, scr, r, F.lane); continue; } r -= I_SQ;
        if (r < I_SQ) { p0_transpose_item<0>(F.w_diff_o, D, Wmix, 2048, 1024, scr, r, F.lane); continue; } r -= I_SQ;
        p0_transpose_item<0>(F.w_out, D, Wout, 1024, 0, scr, r, F.lane);
    }
    float* cosT = (float*)(F.ws + WS_COS); float* sinT = (float*)(F.ws + WS_SIN);
    {
        constexpr int RIT = 16;
        const int stride = F.G * NTHR;
        for (int base = blockIdx.x * NTHR + F.tid; base < T * 64; base += stride * RIT) {
            int pos[RIT];
#pragma unroll
            for (int q = 0; q < RIT; ++q) { const int i = base + q * stride; pos[q] = (i < T * 64) ? F.positions[i >> 6] : 0; }
#pragma unroll
            for (int q = 0; q < RIT; ++q) {
                const int i = base + q * stride; if (i >= T * 64) break;
                const int j = i & 63;
                const float inv = __builtin_amdgcn_exp2f(-(float)j * (13.287712379549449f / 64.0f));
                const float ang = (float)pos[q] * inv;
                double rev = (double)ang * 0.15915494309189535; rev -= __builtin_rint(rev);
                const float rf = (float)rev;
                cosT[i] = __builtin_amdgcn_cosf(rf); sinT[i] = __builtin_amdgcn_sinf(rf);
            }
        }
    }
}

__device__ __forceinline__ void convert_experts(Frame& F) {
    constexpr int I_G = 32 * 256, NCH = (3 * I_G) / 32;
    unsigned* q2 = (unsigned*)(F.ws + WS_CTL) + CW_Q + 64 * 8;
    volatile LAS int* bc = (volatile LAS int*)(F.lds + LDSCTL_OFF + 64);
    LAS float* scr = (LAS float*)(F.lds + F.wave * 16384);
    unsigned char* Wgu = F.ws + WS_WGU; unsigned char* Wdn = F.ws + WS_WDN;
    const int lane = lane_now();
    int nxt = 0;
    if (F.wave == 0 && lane == 0) nxt = (int)__hip_atomic_fetch_add(q2, 1u, __ATOMIC_RELAXED, __HIP_MEMORY_SCOPE_AGENT);
    for (;;) {
        __syncthreads();
        if (F.wave == 0 && lane_now() == 0) { bc[0] = nxt; nxt = (int)__hip_atomic_fetch_add(q2, 1u, __ATOMIC_RELAXED, __HIP_MEMORY_SCOPE_AGENT); }
        __syncthreads();
        const int c = bc[0];
        if (c >= NCH) break;
        for (int k = 0; k < 4; k += 2) {
            int r = c * 32 + F.wave * 4 + k;
            if (r < I_G) { const int e = r >> 8; p0_transpose_pair8<2>(F.w_eg + (size_t)e * D * DEXP, DEXP, Wgu + (size_t)e * 1024 * 1024, 1024, scr, r & 255, lane); continue; } r -= I_G;
            if (r < I_G) { const int e = r >> 8; p0_transpose_pair8<3>(F.w_eu + (size_t)e * D * DEXP, DEXP, Wgu + (size_t)e * 1024 * 1024, 1024, scr, r & 255, lane); continue; } r -= I_G;
            { const int e = r >> 8; p0_transpose_pair8<0>(F.w_ed + (size_t)e * DEXP * D, D, Wdn + (size_t)e * 1024 * 512, 512, scr, r & 255, lane); }
        }
    }
    __syncthreads();
}

__device__ __forceinline__ void p1_norm_mod(Frame& F) {
    F.lane = lane_now(); F.tid = F.wave * 64 + F.lane;
    const float* mod = (const float*)(F.ws + WS_MOD); bf16_t* H0 = (bf16_t*)(F.ws + WS_H); bf16_t* H1 = (bf16_t*)(F.out + (size_t)TH * D);
    const int gw = launder_s(F.vcu * NWAVES + F.wave), NGW = F.G * NWAVES;
    f32x4 v[4], vn[4];
    if (gw < T) { const f32x4* xr = (const f32x4*)(F.x + (size_t)gw * D) + F.lane;
#pragma unroll
        for (int j = 0; j < 4; ++j) v[j] = xr[64 * j]; }
    for (int t = gw; t < T; t += NGW) {
        const int b = t >> 12;
        f32x4 gs[4], sh[4];
#pragma unroll
        for (int j = 0; j < 4; ++j) { const int col = 4 * F.lane + 256 * j;
            const f32x4 g = *(const f32x4*)(F.norm_mix + col), sc = *(const f32x4*)(mod + (size_t)b * 6144 + 1024 + col); sh[j] = *(const f32x4*)(mod + (size_t)b * 6144 + col); gs[j] = g * (sc + 1.0f); }
        if (t + NGW < T) { const f32x4* xr = (const f32x4*)(F.x + (size_t)(t + NGW) * D) + F.lane;
#pragma unroll
            for (int j = 0; j < 4; ++j) vn[j] = xr[64 * j]; }
        float s = 0.f;
#pragma unroll
        for (int j = 0; j < 4; ++j) s += (v[j].x * v[j].x + v[j].y * v[j].y) + (v[j].z * v[j].z + v[j].w * v[j].w);
        const float rstd = 1.0f / sqrtf(wave_sum(s) * (1.0f / D) + EPS);
        u32x2* o8 = (u32x2*)((t < TH ? H0 : H1) + (size_t)(t & (TH - 1)) * D) + F.lane;
#pragma unroll
        for (int j = 0; j < 4; ++j) { const f32x4 y = (v[j] * rstd) * gs[j] + sh[j]; u32x2 w; w.x = cvt_pk_bf16(y.x, y.y); w.y = cvt_pk_bf16(y.z, y.w);
            o8[64 * j] = w; }
#pragma unroll
        for (int j = 0; j < 4; ++j) v[j] = vn[j];
    }
}

__device__ __forceinline__ void p3_mix(Frame& F, int hf, bool conv) {
    F.lane = lane_now(); F.tid = F.wave * 64 + F.lane;
    MixArgs A; A.proj = (const bf16_t*)(F.ws + WS_PROJ); A.act = (bf16_t*)(F.ws + WS_ACT); A.diff_norm = F.diff_norm; A.ssq = (float*)(F.ws + WS_SSQ);
    A.lam = __uint_as_float(__builtin_amdgcn_readfirstlane(*(const unsigned*)(F.ws + WS_MOD + 256 * 1024)));
    unsigned* qbase = (unsigned*)(F.ws + WS_CTL) + CW_Q + 64 * 16 + 64 * 8 * hf;
    volatile LAS int* bc = (volatile LAS int*)(F.lds + LDSCTL_OFF + 64);
    const int x0 = (int)(xb_xcc_id() & 7u);
    int curk = 0; bool havepre = false;
    for (;;) {
        __syncthreads();
        if (F.wave == 0) {
            const int lane = lane_now();
            int u = -1, xq = (x0 + curk) & 7;
            for (int it = 0; it < 64; ++it) {
                int got = -1;
                if (havepre) got = bc[2];
                else if (lane == 0) got = (int)__hip_atomic_fetch_add(qbase + 64 * xq, 1u, __ATOMIC_RELAXED, __HIP_MEMORY_SCOPE_AGENT);
                havepre = false;
                got = __builtin_amdgcn_readfirstlane(got);
                if (got < 4 + 64) { u = got; break; }
                unsigned c = 4u + 64u;
                if (lane < 8) c = __hip_atomic_load(qbase + 64 * ((x0 + lane) & 7), __ATOMIC_RELAXED, __HIP_MEMORY_SCOPE_AGENT);
                const unsigned long long m = __builtin_amdgcn_ballot_w64(lane < 8 && c < 4u + 64u);
                if (m == 0ull) break;
                xq = (x0 + (int)__builtin_ctzll(m)) & 7;
            }
            curk = (xq - x0) & 7;
            if (lane == 0) { bc[0] = u; bc[1] = xq; }
        }
        __syncthreads();
        const int u = __builtin_amdgcn_readfirstlane(bc[0]), xq = __builtin_amdgcn_readfirstlane(bc[1]);
        if (u < 0) break;
#ifndef MIX_NO_RET
        if (u < 4) { const int bh = 2 * xq + (u >> 1); ret_unit(F.lds, F.wave, A, bh >> 2, bh & 3, u & 1); }
#endif
#ifndef MIX_NO_ATTN
        if (u >= 4) { const int v = u - 4, qb = 31 - (v >> 1), bh = 2 * xq + (v & 1);
            int pre = 0;
            if (F.wave == 0 && lane_now() == 0) pre = (int)__hip_atomic_fetch_add(qbase + 64 * xq, 1u, __ATOMIC_RELAXED, __HIP_MEMORY_SCOPE_AGENT);
            attn_unit(F.lds, F.wave, A, bh >> 2, bh & 3, qb, pre, bc + 2);
            havepre = true; }
#endif
    }
    if (conv) convert_experts(F);
}

typedef float f32x4v __attribute__((ext_vector_type(4)));
__device__ __forceinline__ void p6_router(Frame& F, bool dummy) {
    F.lane = lane_now(); F.tid = F.wave * 64 + F.lane;
    const float* mod = (const float*)(F.ws + WS_MOD); const bf16_t* rth = (const bf16_t*)(F.ws + WS_MOD + 512 * 1024); const bf16_t* rtl = rth + 48 * D;
    unsigned char* H2 = F.ws + WS_H2; const float* x1 = F.x;
    const size_t rbase = dummy ? WS_EACT : WS_ROUT;
    int* tok_e = (int*)(F.ws + rbase); float* tok_w = (float*)(F.ws + rbase + 256 * 1024); int* tok_slot = (int*)(F.ws + rbase + 512 * 1024); int* list = (int*)(F.ws + rbase + 1024 * 1024);
    unsigned* cnt = (unsigned*)(F.ws + WS_CTL) + CW_CNT + (dummy ? 64 : 0);
    LAS int* hist = (LAS int*)(F.lds + LDSCTL_OFF + 256);
    constexpr int RSTR = 4112;
    LAS unsigned char* Xt = F.lds;
    LAS float* part = (LAS float*)(F.lds + 65792);
    LAS float* lgt = (LAS float*)(F.lds + 65792 + 24576);
    unsigned* ghist = (unsigned*)(F.ws + rbase + 768 * 1024);
    for (int tb = blockIdx.x; tb < T / 128; tb += F.G) {
        if (F.tid < 64) hist[F.tid] = 0;
        bf16x8 bwh[4][3], bwl[4][3];
        { const int ln = launder_i(F.lane), r = ln & 15, kq = ln >> 4, k0 = 128 * F.wave + 8 * kq;
#pragma unroll
          for (int g = 0; g < 4; ++g)
#pragma unroll
              for (int nb = 0; nb < 3; ++nb) { const unsigned wi = (unsigned)((16 * nb + r) * D + k0 + 32 * g); bwh[g][nb] = *(const bf16x8*)(rth + wi); bwl[g][nb] = *(const bf16x8*)(rtl + wi); } }
        f32x4 v[2][4]; u32x2 dv[2][4];
        const unsigned char* dbase = F.ws + delta_off(tb * 128);
#pragma unroll
        for (int q = 0; q < 2; ++q) { const f32x4* xr = (const f32x4*)(x1 + (size_t)(tb * 128 + 2 * F.wave + q) * D) + F.lane; const u32x2* dr = (const u32x2*)(dbase + (size_t)(2 * F.wave + q) * 2048) + F.lane;
#pragma unroll
            for (int j = 0; j < 4; ++j) { v[q][j] = xr[64 * j]; dv[q][j] = dr[64 * j]; } }
        LAS f32x4* gsl = (LAS f32x4*)(F.lds + 114944);
        if (F.wave == 0) { const int b = (tb * 128) >> 12;
#pragma unroll
          for (int j = 0; j < 4; ++j) { const int col = 4 * F.lane + 256 * j;
              const f32x4 g = *(const f32x4*)(F.norm_ffn + col), sc = *(const f32x4*)(mod + (size_t)b * 6144 + 4096 + col), sh = *(const f32x4*)(mod + (size_t)b * 6144 + 3072 + col);
              gsl[F.lane + 64 * j] = g * (sc + 1.0f); gsl[256 + F.lane + 64 * j] = sh; } }
        __syncthreads();
        for (int ps = 0; ps < 8; ++ps) {
#pragma unroll
            for (int q = 0; q < 2; ++q) {
                const int tk = 2 * F.wave + q, t = tb * 128 + ps * 16 + tk;
#pragma unroll
                for (int j = 0; j < 4; ++j) { const u32x2 d = dv[q][j]; v[q][j].x += bf_lo(d.x); v[q][j].y += bf_hi(d.x); v[q][j].z += bf_lo(d.y); v[q][j].w += bf_hi(d.y); }
                float s = 0.f;
#pragma unroll
                for (int j = 0; j < 4; ++j) s += (v[q][j].x * v[q][j].x + v[q][j].y * v[q][j].y) + (v[q][j].z * v[q][j].z + v[q][j].w * v[q][j].w);
                const float rstd = 1.0f / sqrtf(wave_sum(s) * (1.0f / D) + EPS);
                unsigned* o4 = (unsigned*)(H2 + (size_t)t * D) + F.lane;
#pragma unroll
                for (int j = 0; j < 4; ++j) {
                    const int col = 4 * F.lane + 256 * j;
                    const f32x4 y = (v[q][j] * rstd) * gsl[F.lane + 64 * j] + gsl[256 + F.lane + 64 * j];
                    o4[64 * j] = pk4_fp8(y.x, y.y, y.z, y.w);
                    *(LAS f32x4*)(Xt + tk * RSTR + col * 4) = y;
                }
            }
            if (ps + 1 < 8) {
#pragma unroll
                for (int q = 0; q < 2; ++q) { const f32x4* xr = (const f32x4*)(x1 + (size_t)(tb * 128 + (ps + 1) * 16 + 2 * F.wave + q) * D) + F.lane; const u32x2* dr = (const u32x2*)(dbase + (size_t)((ps + 1) * 16 + 2 * F.wave + q) * 2048) + F.lane;
#pragma unroll
                    for (int j = 0; j < 4; ++j) { v[q][j] = xr[64 * j]; dv[q][j] = dr[64 * j]; } }
            }
            __syncthreads();
            {
                const int r = F.lane & 15, kq = F.lane >> 4, k0 = 128 * F.wave + 8 * kq;
                f32x4v acc[3];
#pragma unroll
                for (int nb = 0; nb < 3; ++nb) acc[nb] = (f32x4v){0.f, 0.f, 0.f, 0.f};
#pragma unroll
                for (int g = 0; g < 4; ++g) {
                    const f32x4 a0 = *(const LAS f32x4*)(Xt + r * RSTR + (k0 + 32 * g) * 4), a1 = *(const LAS f32x4*)(Xt + r * RSTR + (k0 + 32 * g + 4) * 4);
                    unsigned hp[4], lp[4];
#pragma unroll
                    for (int q = 0; q < 4; ++q) { const float x0 = (q < 2) ? a0[2 * q] : a1[2 * q - 4], x1 = (q < 2) ? a0[2 * q + 1] : a1[2 * q - 3];
                        hp[q] = cvt_pk_bf16(x0, x1); lp[q] = cvt_pk_bf16(x0 - bf_lo(hp[q]), x1 - bf_hi(hp[q])); }
                    const bf16x8 ah = __builtin_bit_cast(bf16x8, (u32x4){hp[0], hp[1], hp[2], hp[3]}), al = __builtin_bit_cast(bf16x8, (u32x4){lp[0], lp[1], lp[2], lp[3]});
#pragma unroll
                    for (int nb = 0; nb < 3; ++nb) {
                        acc[nb] = __builtin_amdgcn_mfma_f32_16x16x32_bf16(ah, bwh[g][nb], acc[nb], 0, 0, 0);
                        acc[nb] = __builtin_amdgcn_mfma_f32_16x16x32_bf16(ah, bwl[g][nb], acc[nb], 0, 0, 0);
                        acc[nb] = __builtin_amdgcn_mfma_f32_16x16x32_bf16(al, bwh[g][nb], acc[nb], 0, 0, 0);
                    }
                }
#pragma unroll
                for (int nb = 0; nb < 3; ++nb)
#pragma unroll
                    for (int e = 0; e < 4; ++e) part[(F.wave * 16 + 4 * kq + e) * 48 + 16 * nb + r] = acc[nb][e];
            }
            __syncthreads();
            for (int idx = F.tid; idx < 16 * 36; idx += NTHR) { const int tk = idx / 36, o = idx - tk * 36; float s = 0.f;
#pragma unroll
                for (int w = 0; w < 8; ++w) s += part[(w * 16 + tk) * 48 + o];
                lgt[(ps * 16 + tk) * 48 + o] = s; }
        }
        __syncthreads();
        if (F.tid < 128) {
            const int t = tb * 128 + F.tid;
            float lg[36];
#pragma unroll
            for (int o = 0; o < 36; ++o) lg[o] = lgt[F.tid * 48 + o];
            float gl[4];
#pragma unroll
            for (int g = 0; g < 4; ++g) gl[g] = lg[g] + F.b_rg[g];
            int gs = 0; float gm = gl[0];
#pragma unroll
            for (int g = 1; g < 4; ++g) if (gl[g] > gm) { gm = gl[g]; gs = g; }
            float gden = 0.f;
#pragma unroll
            for (int g = 0; g < 4; ++g) gden += __expf(gl[g] - gm);
            const float gtop = 1.0f / gden;
            float el[8];
#pragma unroll
            for (int j = 0; j < 8; ++j) {
                const float v0 = lg[4 + j], v1 = lg[12 + j], v2 = lg[20 + j], v3 = lg[28 + j];
                el[j] = ((gs == 0) ? v0 : (gs == 1) ? v1 : (gs == 2) ? v2 : v3) + F.b_re[gs * 8 + j];
            }
            int e1 = 0; float m1 = el[0];
#pragma unroll
            for (int j = 1; j < 8; ++j) if (el[j] > m1) { m1 = el[j]; e1 = j; }
            int e2 = -1; float m2 = -INFINITY;
#pragma unroll
            for (int j = 0; j < 8; ++j) if (j != e1 && el[j] > m2) { m2 = el[j]; e2 = j; }
            const float w1 = 1.0f / (1.0f + __expf(m2 - m1)), w2 = 1.0f - w1;
            const int ea = gs * 8 + e1, eb = gs * 8 + e2;
            tok_e[2 * t] = ea; tok_e[2 * t + 1] = eb; tok_w[2 * t] = gtop * w1; tok_w[2 * t + 1] = gtop * w2;
            tok_slot[2 * t] = __hip_atomic_fetch_add(&hist[ea], 1, __ATOMIC_RELAXED, __HIP_MEMORY_SCOPE_WORKGROUP); tok_slot[2 * t + 1] = __hip_atomic_fetch_add(&hist[eb], 1, __ATOMIC_RELAXED, __HIP_MEMORY_SCOPE_WORKGROUP);
        }
        __syncthreads();
        if (F.tid < 32) ghist[tb * 32 + F.tid] = (unsigned)hist[F.tid];
        __syncthreads();
    }
}
__device__ __forceinline__ int p6b_lists(Frame& F) {
    F.lane = lane_now(); F.tid = F.wave * 64 + F.lane;
    const int* tok_e = (const int*)(F.ws + WS_ROUT); int* tok_slot = (int*)(F.ws + WS_ROUT + 512 * 1024); int* list = (int*)(F.ws + WS_ROUT + 1024 * 1024);
    const unsigned* ghist = (const unsigned*)(F.ws + WS_ROUT + 768 * 1024);
    const float* tok_w = (const float*)(F.ws + WS_ROUT + 256 * 1024); float* wlist = (float*)(F.ws + WS_WLIST);
    unsigned* cnt = (unsigned*)(F.ws + WS_CTL) + CW_CNT;
    LAS int* red = (LAS int*)(F.lds + LDSCTL_OFF + 256);
    int mytot = 0;
    for (int tb = blockIdx.x; tb < T / 128; tb += F.G) {
        __syncthreads();
        { const int e = F.tid & 31, pt = F.tid >> 5; int s = 0, tot = 0;
          int cv[T / 128 / 16];
#pragma unroll
          for (int q = 0; q < T / 128 / 16; ++q) cv[q] = (int)ghist[(pt + 16 * q) * 32 + e];
#pragma unroll
          for (int q = 0; q < T / 128 / 16; ++q) { tot += cv[q]; if (pt + 16 * q < tb) s += cv[q]; }
          red[pt * 32 + e] = s; red[1024 + pt * 32 + e] = tot; }
        __syncthreads();
        if (F.tid < 32) { int s = 0, tot = 0;
#pragma unroll
            for (int pt = 0; pt < 16; ++pt) { s += red[pt * 32 + F.tid]; tot += red[1024 + pt * 32 + F.tid]; }
            red[512 + F.tid] = s; mytot = tot; if (tb == 0) cnt[F.tid] = (unsigned)tot; }
        __syncthreads();
        if (F.tid < 256) {
            const int a = tb * 256 + F.tid, e = tok_e[a], slot = red[512 + e] + tok_slot[a]; const float w = tok_w[a];
            tok_slot[a] = slot; list[(size_t)e * T + slot] = a; wlist[(size_t)e * T + slot] = w;
        }
    }
    return mytot;
}

__device__ __forceinline__ void moe_table(Frame& F, LAS int* rbs, bool have = false, int havec = 0) {
    F.lane = lane_now(); F.tid = F.wave * 64 + F.lane;
    const unsigned* cnt = (const unsigned*)(F.ws + WS_CTL) + CW_CNT;
    if (F.wave == 0) {
        const int e = F.lane;
        int c = havec;
        if (e < NEXP) { if (!have) c = (int)__hip_atomic_load(cnt + e, __ATOMIC_RELAXED, __HIP_MEMORY_SCOPE_AGENT); rbs[64 + e] = c; }
        asm volatile("s_waitcnt lgkmcnt(0)" ::: "memory");
        if (e < NEXP) {
            int a = 0;
            for (int j = 0; j < e; ++j) a += (rbs[64 + j] + 255) >> 8;
            const int nb = (c + 255) >> 8;
            rbs[e] = a;
            for (int q = 0; q < nb; ++q) rbs[128 + a + q] = e;
            if (e == NEXP - 1) rbs[32] = a + nb;
        }
    }
    __syncthreads();
}

__device__ __forceinline__ void p9_final(Frame& F, const LAS int* rbs, bool dummy) {
    F.lane = lane_now(); F.tid = F.wave * 64 + F.lane;
    const float* mod = (const float*)(F.ws + WS_MOD); const unsigned char* Y = F.ws + WS_Y;
    const float* X = F.x;
    const int* tok_e = (const int*)(F.ws + WS_ROUT); const int* tok_slot = (const int*)(F.ws + WS_ROUT + 512 * 1024);
    const int gw = launder_s(F.vcu * NWAVES + F.wave), NGW = F.G * NWAVES;
    f32x4 ng[4];
#pragma unroll
    for (int j = 0; j < 4; ++j) ng[j] = *(const f32x4*)(F.norm_final + 4 * F.lane + 256 * j);
    f32x4 xv[4], xn[4]; unsigned ya[4], yb[4], yan[4], ybn[4]; u32x2 da[4], dn[4];
    int e0n = 0, e1n = 0, s0n = 0, s1n = 0;
    if (gw < T) {
        const int p0 = rbs[tok_e[2 * gw]] * 256 + tok_slot[2 * gw], p1 = rbs[tok_e[2 * gw + 1]] * 256 + tok_slot[2 * gw + 1];
        const f32x4* xr = (const f32x4*)(X + (size_t)gw * D) + F.lane; const unsigned* y0 = (const unsigned*)(Y + (size_t)p0 * D) + F.lane; const unsigned* y1 = (const unsigned*)(Y + (size_t)p1 * D) + F.lane;
        const u32x2* dr = (const u32x2*)(F.ws + delta_off(gw)) + F.lane;
#pragma unroll
        for (int j = 0; j < 4; ++j) { xv[j] = xr[64 * j]; ya[j] = y0[64 * j]; yb[j] = y1[64 * j]; da[j] = dr[64 * j]; }
        if (gw + NGW < T) { const int tn = gw + NGW; e0n = tok_e[2 * tn]; e1n = tok_e[2 * tn + 1]; s0n = tok_slot[2 * tn]; s1n = tok_slot[2 * tn + 1]; }
    }
    for (int t = gw; t < T; t += NGW) {
        const int b = t >> 12;
        f32x4 g2[4];
#pragma unroll
        for (int j = 0; j < 4; ++j) g2[j] = *(const f32x4*)(mod + (size_t)b * 6144 + 5120 + 4 * F.lane + 256 * j);
        if (t + NGW < T) {
            const int tn = t + NGW, p0 = rbs[e0n] * 256 + s0n, p1 = rbs[e1n] * 256 + s1n;
            const f32x4* xr = (const f32x4*)(X + (size_t)tn * D) + F.lane; const unsigned* y0 = (const unsigned*)(Y + (size_t)p0 * D) + F.lane; const unsigned* y1 = (const unsigned*)(Y + (size_t)p1 * D) + F.lane;
            const u32x2* dr = (const u32x2*)(F.ws + delta_off(tn)) + F.lane;
#pragma unroll
            for (int j = 0; j < 4; ++j) { xn[j] = xr[64 * j]; yan[j] = y0[64 * j]; ybn[j] = y1[64 * j]; dn[j] = dr[64 * j]; }
            if (tn + NGW < T) { const int t2 = tn + NGW; e0n = tok_e[2 * t2]; e1n = tok_e[2 * t2 + 1]; s0n = tok_slot[2 * t2]; s1n = tok_slot[2 * t2 + 1]; }
        }
        f32x4 v[4]; float s = 0.f;
#pragma unroll
        for (int j = 0; j < 4; ++j) {
            const int a = (int)ya[j], c = (int)yb[j];
            const f32x2 a0 = __builtin_amdgcn_cvt_pk_f32_fp8(a, false), a1 = __builtin_amdgcn_cvt_pk_f32_fp8(a, true), c0 = __builtin_amdgcn_cvt_pk_f32_fp8(c, false), c1 = __builtin_amdgcn_cvt_pk_f32_fp8(c, true);
            f32x4 y; y.x = (a0.x + c0.x) * 0.0625f; y.y = (a0.y + c0.y) * 0.0625f; y.z = (a1.x + c1.x) * 0.0625f; y.w = (a1.y + c1.y) * 0.0625f;
            const u32x2 dd = da[j]; const f32x4 dl = {bf_lo(dd.x), bf_hi(dd.x), bf_lo(dd.y), bf_hi(dd.y)};
            v[j] = (xv[j] + dl) + g2[j] * y;
            s += (v[j].x * v[j].x + v[j].y * v[j].y) + (v[j].z * v[j].z + v[j].w * v[j].w);
        }
        const float rstd = 1.0f / sqrtf(wave_sum(s) * (1.0f / D) + EPS);
        f32x4* xo = dummy ? (f32x4*)((float*)(F.ws + WS_H2) + (size_t)t * D) + F.lane : (f32x4*)(F.out + (size_t)t * D) + F.lane;
#pragma unroll
        for (int j = 0; j < 4; ++j) __builtin_nontemporal_store(v[j] * rstd * ng[j], xo + 64 * j);
#pragma unroll
        for (int j = 0; j < 4; ++j) { xv[j] = xn[j]; ya[j] = yan[j]; yb[j] = ybn[j]; da[j] = dn[j]; }
    }
}

constexpr int MOE_MAXU = 8;
__device__ __forceinline__ void moe_unit_tables(Frame& F, const LAS int* rbs, int nunits) {
    const int tid = tid_now(F.wave);
    const int* list = (const int*)(F.ws + WS_ROUT + 1024 * 1024); const float* wlist = (const float*)(F.ws + WS_WLIST);
    LAS unsigned short* tokl = (LAS unsigned short*)(F.lds + LDSCTL_OFF + 4096); LAS float* wl = (LAS float*)(F.lds + LDSCTL_OFF + 8192);
    int av[MOE_MAXU / 2]; float wv[MOE_MAXU / 2]; bool live[MOE_MAXU / 2], inr[MOE_MAXU / 2];
#pragma unroll
    for (int q = 0; q < MOE_MAXU / 2; ++q) {
        const int j = 2 * q + (tid >> 8), r = tid & 255, L = j * F.G + F.vcu;
        live[q] = L < nunits; inr[q] = false; av[q] = 0; wv[q] = 0.f;
        if (live[q]) {
            const int rbi = L >> 2, e = rbs[128 + rbi], sl = (rbi - rbs[e]) * 256 + r, ce = rbs[64 + e];
            inr[q] = sl < ce;
            av[q] = list[(size_t)e * T + (inr[q] ? sl : 0)]; wv[q] = wlist[(size_t)e * T + (inr[q] ? sl : 0)];
        }
    }
#pragma unroll
    for (int q = 0; q < MOE_MAXU / 2; ++q) {
        const int j = 2 * q + (tid >> 8), r = tid & 255;
        if (live[q]) { wl[j * 256 + r] = inr[q] ? wv[q] * 0.5f : 0.f; tokl[j * 256 + r] = (unsigned short)(av[q] >> 1); }
    }
    __syncthreads();
}

constexpr int N_PHASES = 16;
template <unsigned PHM>
__global__ void __launch_bounds__(NTHR, 2) fwd(Args args) {
    extern __shared__ __attribute__((aligned(16))) unsigned char lds_raw[];
    Frame F;
    F.lds = (LAS unsigned char*)lds_raw;
    F.tid = threadIdx.x; F.lane = F.tid & 63; F.wave = __builtin_amdgcn_readfirstlane(F.tid >> 6);
    F.G = gridDim.x; { const int bx = blockIdx.x; F.vcu = (F.G % 8 == 0) ? (bx % 8) * (F.G / 8) + bx / 8 : bx; }
    F.x = (const float*)args.in[0]; F.c = (const float*)args.in[1]; F.positions = (const int*)args.in[2]; F.w_ada = (const float*)args.in[3]; F.b_ada = (const float*)args.in[4];
    F.norm_mix = (const float*)args.in[5]; F.w_in = (const float*)args.in[6]; F.w_ret_o = (const float*)args.in[7]; F.w_diff_o = (const float*)args.in[8];
    F.lq1 = (const float*)args.in[9]; F.lk1 = (const float*)args.in[10]; F.lq2 = (const float*)args.in[11]; F.lk2 = (const float*)args.in[12]; F.diff_norm = (const float*)args.in[13];
    F.w_out = (const float*)args.in[14]; F.norm_ffn = (const float*)args.in[15]; F.w_rg = (const float*)args.in[16]; F.b_rg = (const float*)args.in[17]; F.w_re = (const float*)args.in[18]; F.b_re = (const float*)args.in[19];
    F.w_eg = (const float*)args.in[20]; F.w_eu = (const float*)args.in[21]; F.w_ed = (const float*)args.in[22]; F.norm_final = (const float*)args.in[23];
    F.out = args.out; F.ws = args.ws;
    for (int u = F.tid; u < (LDS_BYTES - LDSCTL_OFF) / 4; u += NTHR) ((LAS unsigned*)(F.lds + LDSCTL_OFF))[u] = 0u;
    __syncthreads();
    const int lo = args.ph_lo, hi = args.ph_hi;
    const bool use_bar = (hi - lo) > 1;
    XcdBarrier bar; bar.bar = (unsigned*)(F.ws + WS_CTL) + CW_BAR; bar.x = 0; bar.st = (volatile LAS unsigned*)(F.lds + LDSCTL_OFF);
    if (use_bar) bar = xcd_barrier_post((unsigned*)(F.ws + WS_CTL) + CW_BAR, (volatile LAS unsigned*)(F.lds + LDSCTL_OFF));
    bar.wave = F.wave;
#ifndef PROBE_DUP
#define PROBE_DUP 0u
#endif
#ifndef PROBE_MODE
#define PROBE_MODE 0
#endif
#define NREP(ty) ((((PROBE_DUP) >> (ty)) & 1u) ? 2 : 1)
#define INP(ty, k) ((((PHM) >> (ty)) & 1u) && lo <= (k) && (k) < hi)
#define INPL(ty, k) ((((PHM) >> (ty)) & 1u) && launder_s(lo) <= (k) && (k) < launder_s(hi))
#define IN(k) (lo <= (k) && (k) < hi)
#define SEAM(k) do { if (IN(k) && IN((k) + 1)) xcd_barrier(bar); } while (0)
    LAS int* rbs = (LAS int*)(F.lds + LDSCTL_OFF + 1024);

    if (INP(0, 0)) { for (int rep = 0; rep < NREP(0); ++rep) p0_prologue(F); SEAM(0); }
    for (int hf = 0; hf < 2; ++hf) {
        const int pb = 1 + 5 * hf;
        if (INP(1, pb) && hf == 0) { for (int rep = 0; rep < NREP(1); ++rep) p1_norm_mod(F); SEAM(pb); }
        if (INP(2, pb + 1)) {
            pg8::StaticOrder S; S.init(hf ? (const void*)(F.out + (size_t)TH * D) : (const void*)(F.ws + WS_H), F.ws + WS_WIN, TH, DIN, D, F.G, (int)blockIdx.x);
            pg8::EpiProj E{(bf16_t*)(F.ws + WS_PROJ), (const float*)(F.ws + WS_COS) + (size_t)hf * TH * 64, (const float*)(F.ws + WS_SIN) + (size_t)hf * TH * 64, 0};
            for (int rep = 0; rep < NREP(2); ++rep) { E.pmode = (rep + 1 < NREP(2)) ? PROBE_MODE : 0; pg8::gemm_phase<pg8::EpiProj, pg8::StaticOrder, true, false>(F.lds, F.wave, D, S, E); }
            SEAM(pb + 1);
        }
        if (INP(3, pb + 2)) { for (int rep = 0; rep < NREP(3); ++rep) p3_mix(F, hf + 2 * rep, hf == 0 || !(lo <= 3 && 3 < hi)); SEAM(pb + 2); }
        if (INP(4, pb + 3)) {
            pg8::StaticOrder S; S.init(F.ws + WS_ACT, F.ws + WS_WMIX, TH, D, 2048, F.G, (int)blockIdx.x);
            LAS float* rst = (LAS float*)(F.lds + LDSCTL_OFF + 8192);
            for (int ui = 0; ; ++ui) {
                pg8::Unit u0; if (!S.next(ui, u0)) break;
                const int tl = tid_now(F.wave);
                { const float* sq = (const float*)(F.ws + WS_SSQ);
                  if (tl < 256) { float r[4];
#pragma unroll
                    for (int hd = 0; hd < 4; ++hd) { const f32x4* p = (const f32x4*)(sq + ((size_t)(u0.pm * 256 + tl) * 4 + hd) * 8); const f32x4 a = p[0], b = p[1];
                        r[hd] = 1.0f / sqrtf((((a.x + a.y) + (a.z + a.w)) + ((b.x + b.y) + (b.z + b.w))) * (1.0f / 256.0f) + EPS); }
                    rst[tl] = r[0] / r[1]; rst[256 + tl] = r[1] / r[2]; rst[512 + tl] = r[2] / r[3]; rst[768 + tl] = r[3]; } }
                __syncthreads();
                pg8::EpiMerged E{(const bf16_t*)(F.ws + WS_PROJ), (bf16_t*)(F.ws + WS_H), (const LAS float*)rst};
                pg8::OneUnit<pg8::StaticOrder> S1{S, ui};
                for (int rep = 0; rep < NREP(4); ++rep) pg8::gemm_phase<pg8::EpiMerged, pg8::OneUnit<pg8::StaticOrder>, false, false>(F.lds, F.wave, 2048, S1, E);
                __syncthreads();
            }
            SEAM(pb + 3);
        }
        if (INP(5, pb + 4)) {
            pg8::StaticOrder S; S.init(F.ws + WS_H, F.ws + WS_WOUT, TH, D, D, F.G, (int)blockIdx.x);
            pg8::EpiWout E{F.ws, (const float*)(F.ws + WS_MOD), hf * TH};
            for (int rep = 0; rep < NREP(5); ++rep) pg8::gemm_phase<pg8::EpiWout, pg8::StaticOrder, false, false>(F.lds, F.wave, D, S, E);
            if (hf == 1) SEAM(pb + 4);
        }
    }
    if (INPL(6, 11)) { for (int rep = 0; rep < NREP(6); ++rep) p6_router(F, rep + 1 < NREP(6)); SEAM(11); }
    bool have_rbs = false, have_tabs = false;
    if (INPL(10, 12)) {
        if (!(launder_s(lo) <= 3 && 3 < launder_s(hi) && ((PHM >> 3) & 1u))) convert_experts(F);
        const int tot = p6b_lists(F);
        if ((int)blockIdx.x < T / 128) { __syncthreads(); moe_table(F, rbs, true, tot); have_rbs = true; }
        SEAM(12); }
    if (INPL(7, 13)) {
        if (!have_rbs) { moe_table(F, rbs); have_rbs = true; }
        const int nunits = __builtin_amdgcn_readfirstlane(rbs[32]) * 4;
        moe_unit_tables(F, rbs, nunits); have_tabs = true;
        pg8::MoeOrder S{F.G, F.vcu, 512, nunits, 1, rbs, (const LAS unsigned short*)(F.lds + LDSCTL_OFF + 4096), (const char*)(F.ws + WS_H2), (const char*)(F.ws + WS_WGU), (size_t)1024 * 1024};
        pg8::EpiGU E{F.ws + WS_EACT};
        for (int rep = 0; rep < NREP(7); ++rep) pg8::gemm_phase<pg8::EpiGU, pg8::MoeOrder, true, true, true>(F.lds, F.wave, launder_s(512), S, E);
        SEAM(13);
    }
    if (INPL(8, 14)) {
        if (!have_rbs) { moe_table(F, rbs); have_rbs = true; }
        const int nunits = __builtin_amdgcn_readfirstlane(rbs[32]) * 4;
        if (!have_tabs) moe_unit_tables(F, rbs, nunits);
        pg8::MoeOrder S{F.G, F.vcu, 256, nunits, 0, rbs, (const LAS unsigned short*)(F.lds + LDSCTL_OFF + 4096), (const char*)(F.ws + WS_EACT), (const char*)(F.ws + WS_WDN), (size_t)1024 * 512};
        pg8::EpiDown E{F.ws + WS_Y, (const LAS float*)(F.lds + LDSCTL_OFF + 8192)};
        for (int rep = 0; rep < NREP(8); ++rep) pg8::gemm_phase<pg8::EpiDown, pg8::MoeOrder, true, false, true>(F.lds, F.wave, launder_s(256), S, E);
        SEAM(14);
    }
    if (INPL(9, 15)) { if (!have_rbs) moe_table(F, rbs); for (int rep = 0; rep < NREP(9); ++rep) p9_final(F, rbs, rep + 1 < NREP(9)); }
#undef IN
#undef INP
#undef INPL
#undef SEAM
}

#ifndef MK_ONE_LAUNCH
#define MK_ONE_LAUNCH 1
#endif
#if !MK_ONE_LAUNCH
typedef void (*KernFn)(Args);
static KernFn phase_kernel(int p) {
    const int ty = (p == 0) ? 0 : (p <= 10) ? 1 + (p - 1) % 5 : (p == 11) ? 6 : (p == 12) ? 10 : p - 6;
    switch (ty) {
        case 0: return fwd<1u << 0>; case 1: return fwd<1u << 1>; case 2: return fwd<1u << 2>; case 3: return fwd<1u << 3>; case 4: return fwd<1u << 4>;
        case 5: return fwd<1u << 5>; case 6: return fwd<1u << 6>; case 7: return fwd<1u << 7>; case 8: return fwd<1u << 8>; case 9: return fwd<1u << 9>; default: return fwd<1u << 10>;
    }
}
#endif
extern "C" void kernel_launch(void* const* d_in, const int* in_sizes, int n_in, void* d_out, int out_size, void* d_ws, size_t ws_size, hipStream_t stream) {
    static int grid = 0;
    if (grid == 0) {
        if (n_in != 24 || out_size != T * D || ws_size < WS_END) { fprintf(stderr, "kernel_launch: unexpected problem (n_in %d, out %d, ws %zu < %zu); nothing launched\n", n_in, out_size, ws_size, (size_t)WS_END); grid = -1; return; }
        int dev = 0, cus = 0;
        if (hipGetDevice(&dev) != hipSuccess || hipDeviceGetAttribute(&cus, hipDeviceAttributeMultiprocessorCount, dev) != hipSuccess) { grid = -1; return; }
#if MK_ONE_LAUNCH
        if (hipFuncSetAttribute((const void*)fwd<0x7FFu>, hipFuncAttributeMaxDynamicSharedMemorySize, LDS_BYTES) != hipSuccess) { grid = -1; return; }
#else
        for (int p = 0; p < N_PHASES; ++p)
            if (hipFuncSetAttribute((const void*)phase_kernel(p), hipFuncAttributeMaxDynamicSharedMemorySize, LDS_BYTES) != hipSuccess) { fprintf(stderr, "kernel_launch: hipFuncSetAttribute failed\n"); grid = -1; return; }
#endif
        (void)hipGetLastError();
        grid = cus;
    }
    if (grid < 0) return;
    (void)hipMemsetAsync((char*)d_ws + WS_CTL, 0, CTL_ZERO_BYTES, stream);
    Args a{};
    for (int i = 0; i < 24; ++i) a.in[i] = d_in[i];
    a.out = (float*)d_out; a.ws = (unsigned char*)d_ws;
#if MK_ONE_LAUNCH
    a.ph_lo = 0; a.ph_hi = N_PHASES;
    hipLaunchKernelGGL(fwd<0x7FFu>, dim3(grid), dim3(NTHR), LDS_BYTES, stream, a);
#else
    for (int p = 0; p < N_PHASES; ++p) { a.ph_lo = p; a.ph_hi = p + 1; hipLaunchKernelGGL(phase_kernel(p), dim3(grid), dim3(NTHR), LDS_BYTES, stream, a); }
#endif
}
```
